# Optimizing an MI355X kernel written in HIP

```python
import jax, jax.numpy as jnp
from jax import lax
import numpy as np

D_MODEL = 1024
BATCH = 16
SEQ = 2048
DEPTH = 1

PLE_DIM = 256
CONV_DIM = 512
CONV_WIDTH = 31
POOL_DIM = 512
POOL_WINDOWS = (2, 4, 8, 16)
POOL_GROUPS = len(POOL_WINDOWS)
POOL_GROUP_DIM = POOL_DIM // POOL_GROUPS
POOL_OUT_GROUP_DIM = D_MODEL // POOL_GROUPS
N_BRANCHES = 2
IN_COLS = 2 * CONV_DIM + POOL_DIM + N_BRANCHES * D_MODEL
N_EXPERTS = 16
EXPERT_FF = 1024
CAPACITY_FACTOR = 2
EPS = 1e-6

kernel_name = "hybrid_conv_pool_ec_moe_encoder_block"


def rms_norm(x, g):
    xf = x.astype(jnp.float32)
    y = xf * lax.rsqrt(jnp.mean(xf * xf, axis=-1, keepdims=True) + EPS)
    return (y * g.astype(jnp.float32)).astype(x.dtype)


def layer_norm(x, g, b):
    xf = x.astype(jnp.float32)
    mu = jnp.mean(xf, axis=-1, keepdims=True)
    xc = xf - mu
    var = jnp.mean(xc * xc, axis=-1, keepdims=True)
    y = xc * lax.rsqrt(var + EPS) * g.astype(jnp.float32) + b.astype(jnp.float32)
    return y.astype(x.dtype)


def conformer_conv(a, gate, conv_w, conv_b, ln_g, ln_b, w_out):
    v = a * jax.nn.sigmoid(gate)
    half = CONV_WIDTH // 2
    v = lax.conv_general_dilated(
        v, conv_w[:, None, :].astype(v.dtype), window_strides=(1,),
        padding=[(half, half)], dimension_numbers=("NWC", "WIO", "NWC"),
        feature_group_count=CONV_DIM) + conv_b
    v = jax.nn.silu(layer_norm(v, ln_g, ln_b))
    return jnp.einsum("bsc,cd->bsd", v, w_out)


def multiscale_pool(u, w_pool, scale):
    b, s, _ = u.shape
    ug = u.astype(jnp.float32).reshape(b, s, POOL_GROUPS, POOL_GROUP_DIM)
    c = jnp.concatenate(
        [jnp.zeros((b, 1, POOL_GROUPS, POOL_GROUP_DIM), jnp.float32),
         jnp.cumsum(ug, axis=1)], axis=1)
    t = jnp.arange(s)
    outs = []
    for g, w in enumerate(POOL_WINDOWS):
        lo = jnp.clip(t - w // 2, 0, s - 1)
        hi = jnp.clip(t + (w - w // 2) - 1, 0, s - 1)
        cnt = (hi - lo + 1).astype(jnp.float32)[None, :, None]
        mean = (c[:, hi + 1, g] - c[:, lo, g]) / cnt
        outs.append(mean - ug[:, :, g])
    d = jnp.stack(outs, axis=2).astype(u.dtype)
    y = jnp.einsum("bsgc,gce->bsge", d, w_pool).reshape(b, s, D_MODEL)
    return y * scale


def expert_choice_ffn(h, w_router, w_gate, w_up, w_down):
    b, s, d = h.shape
    cap = max(1, CAPACITY_FACTOR * s // N_EXPERTS)
    aff = jax.nn.softmax(jnp.einsum("bsd,de->bse", h, w_router).astype(jnp.float32), axis=-1)
    top_val, top_idx = lax.top_k(jnp.swapaxes(aff, 1, 2), cap)
    xg = jax.vmap(lambda hb, ib: hb[ib])(h, top_idx)
    hid = jax.nn.silu(jnp.einsum("becd,edf->becf", xg, w_gate)) * \
        jnp.einsum("becd,edf->becf", xg, w_up)
    ye = jnp.einsum("becf,efd->becd", hid, w_down) * top_val[..., None].astype(h.dtype)
    return jax.vmap(
        lambda yb, ib: jnp.zeros((s, d), yb.dtype).at[ib.reshape(-1)].add(yb.reshape(-1, d))
    )(ye, top_idx)


def setup_inputs(seed: int = 0) -> dict:
    key = jax.random.key(seed)
    ks = jax.random.split(key, 24)
    f32 = jnp.float32
    nrm = lambda k, shape, scale: jax.random.normal(k, shape, f32) * scale
    gain = lambda k, shape: 1.0 + 0.02 * jax.random.normal(k, shape, f32)
    L = DEPTH
    return {
        "x": jax.random.normal(ks[0], (BATCH, SEQ, D_MODEL), f32),
        "p": jax.random.normal(ks[1], (DEPTH, BATCH, SEQ, PLE_DIM), f32),
        "norm1_g": gain(ks[2], (L, D_MODEL)),
        "w_in": nrm(ks[3], (L, D_MODEL, IN_COLS), D_MODEL ** -0.5),
        "b_gate": nrm(ks[4], (L, N_BRANCHES * D_MODEL), 0.02),
        "conv_w": nrm(ks[5], (L, CONV_WIDTH, CONV_DIM), CONV_WIDTH ** -0.5),
        "conv_b": nrm(ks[6], (L, CONV_DIM), 0.02),
        "conv_ln_g": gain(ks[7], (L, CONV_DIM)),
        "conv_ln_b": nrm(ks[8], (L, CONV_DIM), 0.02),
        "w_conv_out": nrm(ks[9], (L, CONV_DIM, D_MODEL), CONV_DIM ** -0.5),
        "w_pool": nrm(ks[10], (L, POOL_GROUPS, POOL_GROUP_DIM, POOL_OUT_GROUP_DIM), POOL_GROUP_DIM ** -0.5),
        "pool_scale": gain(ks[11], (L, D_MODEL)),
        "w_out": nrm(ks[12], (L, D_MODEL, D_MODEL), D_MODEL ** -0.5),
        "norm2_g": gain(ks[13], (L, D_MODEL)),
        "w_router": nrm(ks[14], (L, D_MODEL, N_EXPERTS), D_MODEL ** -0.5),
        "w_exp_gate": nrm(ks[15], (L, N_EXPERTS, D_MODEL, EXPERT_FF), D_MODEL ** -0.5),
        "w_exp_up": nrm(ks[16], (L, N_EXPERTS, D_MODEL, EXPERT_FF), D_MODEL ** -0.5),
        "w_exp_down": nrm(ks[17], (L, N_EXPERTS, EXPERT_FF, D_MODEL), EXPERT_FF ** -0.5),
        "norm3_g": gain(ks[18], (L, D_MODEL)),
        "w_ple_gate": nrm(ks[19], (L, D_MODEL, D_MODEL), D_MODEL ** -0.5),
        "b_ple_gate": nrm(ks[20], (L, D_MODEL), 0.02),
        "w_ple": nrm(ks[21], (L, PLE_DIM, D_MODEL), PLE_DIM ** -0.5),
        "ple_norm_g": gain(ks[22], (L, D_MODEL)),
        "final_g": gain(ks[23], (D_MODEL,)),
    }


def reference(x, p, norm1_g, w_in, b_gate, conv_w, conv_b, conv_ln_g, conv_ln_b,
              w_conv_out, w_pool, pool_scale, w_out, norm2_g, w_router,
              w_exp_gate, w_exp_up, w_exp_down, norm3_g, w_ple_gate, b_ple_gate,
              w_ple, ple_norm_g, final_g):
    c1 = CONV_DIM
    c2 = 2 * CONV_DIM
    c3 = c2 + POOL_DIM
    c4 = c3 + D_MODEL
    for i in range(DEPTH):
        h = rms_norm(x, norm1_g[i])
        z = jnp.einsum("bsd,dk->bsk", h, w_in[i])
        gates = jax.nn.sigmoid(z[..., c3:] + b_gate[i])
        y_conv = conformer_conv(z[..., :c1], z[..., c1:c2], conv_w[i], conv_b[i],
                                conv_ln_g[i], conv_ln_b[i], w_conv_out[i])
        y_pool = multiscale_pool(z[..., c2:c3], w_pool[i], pool_scale[i])
        merged = gates[..., :D_MODEL] * y_conv + gates[..., D_MODEL:] * y_pool
        x = x + jnp.einsum("bsd,de->bse", merged, w_out[i])
        x = x + expert_choice_ffn(rms_norm(x, norm2_g[i]), w_router[i],
                                  w_exp_gate[i], w_exp_up[i], w_exp_down[i])
        g = jax.nn.sigmoid(jnp.einsum("bsd,de->bse", rms_norm(x, norm3_g[i]), w_ple_gate[i]) + b_ple_gate[i])
        e = rms_norm(jnp.einsum("bsq,qd->bsd", p[i], w_ple[i]), ple_norm_g[i])
        x = x + g * e
    return rms_norm(x, final_g)
```

```cpp
#include <hip/hip_runtime.h>
#include <cstdio>
#include <cstdint>

#define LAS __attribute__((address_space(3)))
typedef unsigned short bf16_t;
typedef float f32x4 __attribute__((ext_vector_type(4)));
typedef unsigned u32x2 __attribute__((ext_vector_type(2)));
typedef unsigned u32x4 __attribute__((ext_vector_type(4)));

constexpr int NB = 16, SEQ = 2048, DM = 1024, NT = NB * SEQ;
constexpr int PLE = 256, CD = 512, CWID = 31, PDIM = 512, NE = 16, FF = 1024, CAP = 256, INC = 3584;
constexpr float EPS = 1e-6f;
constexpr int NWAVES = 8, NTHREADS = 512;
constexpr int LDS_BYTES = 147456;

constexpr size_t MiB = 1u << 20;
constexpr size_t WS_CTL = 0;
constexpr size_t WS_WIN = 1 * MiB;
constexpr size_t WS_WC = 8 * MiB;
constexpr size_t WS_WP = 9 * MiB;
constexpr size_t WS_WPLE = 9 * MiB + 512 * 1024;
constexpr size_t WS_WOUT = 10 * MiB;
constexpr size_t WS_WPG = 12 * MiB;
constexpr size_t WS_WGU = 14 * MiB;
constexpr size_t WS_WD = 78 * MiB;
constexpr size_t WS_XN = 111 * MiB;
constexpr size_t WS_R1 = 175 * MiB;
constexpr size_t WS_V = WS_R1;
constexpr size_t WS_U = WS_R1 + 32 * MiB;
constexpr size_t WS_G = WS_R1 + 64 * MiB;
constexpr size_t WS_MERGED = WS_R1;
constexpr size_t WS_HID = WS_R1;
constexpr size_t WS_GL = WS_R1;
constexpr size_t WS_ERAW = WS_R1 + 64 * MiB;
constexpr size_t WS_PBF = WS_R1 + 128 * MiB;
constexpr size_t WS_R2 = 367 * MiB;
constexpr size_t WS_CS = WS_R2;
constexpr size_t WS_PD = WS_R2 + 32 * MiB;
constexpr size_t WS_MP = WS_R2 + 64 * MiB;
constexpr size_t WS_XG = WS_R2;
constexpr size_t WS_YE = WS_R2;
constexpr size_t WS_AFF = 495 * MiB;
constexpr size_t WS_IDX = 497 * MiB;
constexpr size_t WS_VAL = 497 * MiB + 512 * 1024;
constexpr size_t WS_INV = 498 * MiB;
constexpr size_t WS_END = 512 * MiB;

#define LDS_WAIT() asm volatile("s_waitcnt lgkmcnt(0)" ::: "memory")
#define VM_WAIT() asm volatile("s_waitcnt vmcnt(0)" ::: "memory")
__device__ __forceinline__ unsigned f2bf(float f) { unsigned u = __float_as_uint(f); return (u + 0x7fffu + ((u >> 16) & 1u)) >> 16; }
__device__ __forceinline__ unsigned pk2(float lo, float hi) { return f2bf(lo) | (f2bf(hi) << 16); }
__device__ __forceinline__ float bf_lo(unsigned w) { return __uint_as_float(w << 16); }
__device__ __forceinline__ float bf_hi(unsigned w) { return __uint_as_float(w & 0xffff0000u); }
__device__ __forceinline__ float sigm(float x) { return 1.0f / (1.0f + __expf(-x)); }
__device__ __forceinline__ f32x4 sigm4(f32x4 v) { f32x4 o; o.x = sigm(v.x); o.y = sigm(v.y); o.z = sigm(v.z); o.w = sigm(v.w); return o; }
__device__ __forceinline__ void store_bf4(bf16_t* p, f32x4 v) { u32x2 w; w.x = pk2(v.x, v.y); w.y = pk2(v.z, v.w); *(u32x2*)p = w; }
__device__ __forceinline__ f32x4 load_bf4(const bf16_t* p) { const u32x2 w = *(const u32x2*)p; f32x4 o; o.x = bf_lo(w.x); o.y = bf_hi(w.x); o.z = bf_lo(w.y); o.w = bf_hi(w.y); return o; }
__device__ __forceinline__ float wave_sum(float v) {
#pragma unroll
    for (int o = 1; o < 64; o <<= 1) v += __shfl_xor(v, o);
    return v;
}

struct Unit { int pm, pn; };
constexpr int NXCD = 8, WGM = 8;
struct StaticOrder {
    int nM, nN, nwg, G, c;
    __device__ void init(int nM_, int nN_, int G_, int c_) { nM = nM_; nN = nN_; nwg = nM * nN; G = G_; c = c_; }
    __device__ bool next(int i, Unit& u) const {
        const long L = (long)i * G + c; if (L >= nwg) return false;
        int wgid = (int)L; { const int q = nwg / NXCD, r = nwg % NXCD, xcd = wgid % NXCD, off = wgid / NXCD; wgid = (xcd < r ? xcd * (q + 1) : r * (q + 1) + (xcd - r) * q) + off; }
        const int nig = WGM * nN, gid = wgid / nig, fm = gid * WGM, gsz = (nM - fm) < WGM ? (nM - fm) : WGM;
        u.pm = fm + ((wgid % nig) % gsz); u.pn = (wgid % nig) / gsz; return true;
    }
};
struct GemmDesc {
    const bf16_t* A; const bf16_t* Bt; int lda, K, nM, nN, a_col_step, moe; size_t b_mat_stride;
    __device__ __forceinline__ int mem_pm(int pm) const { return moe ? ((pm & 15) * 16 + (pm >> 4)) : pm; }
    __device__ __forceinline__ const bf16_t* a_ptr(const Unit& u) const { return A + (size_t)mem_pm(u.pm) * 256 * lda + (size_t)u.pn * a_col_step; }
    __device__ __forceinline__ const bf16_t* b_ptr(const Unit& u) const { return Bt + (moe ? (size_t)(u.pm >> 4) * b_mat_stride : (size_t)0) + (size_t)u.pn * 256 * K; }
};

struct Epi1 {
    bf16_t* V; bf16_t* U; bf16_t* Gt; const float* bgate;
    __device__ __forceinline__ void pair(int mpm, int pn, int r, int c, f32x4 va, f32x4 vb) const {
        const size_t row = (size_t)mpm * 256 + r;
        if (pn < 4) { store_bf4(V + row * CD + 128 * pn + c, va * sigm4(vb)); }
        else if (pn < 6) { bf16_t* p = U + row * PDIM + 256 * (pn - 4) + c; store_bf4(p, va); store_bf4(p + 128, vb); }
        else { const int j0 = 256 * (pn - 6) + c; const f32x4 b0 = *(const f32x4*)(bgate + j0), b1 = *(const f32x4*)(bgate + j0 + 128);
            bf16_t* p = Gt + row * 2048 + j0; store_bf4(p, sigm4(va + b0)); store_bf4(p + 128, sigm4(vb + b1)); }
    }
};
struct Epi2 {
    const bf16_t* Gt; const float* scale; bf16_t* MP;
    __device__ __forceinline__ void pair(int mpm, int pn, int r, int c, f32x4 va, f32x4 vb) const {
        const size_t row = (size_t)mpm * 256 + r; const int col = 256 * pn + c;
        const f32x4 g0 = load_bf4(Gt + row * 2048 + 1024 + col), g1 = load_bf4(Gt + row * 2048 + 1024 + col + 128);
        const f32x4 s0 = *(const f32x4*)(scale + col), s1 = *(const f32x4*)(scale + col + 128);
        store_bf4(MP + row * DM + col, g0 * s0 * va); store_bf4(MP + row * DM + col + 128, g1 * s1 * vb);
    }
};
struct Epi3 {
    const bf16_t* Gt; const bf16_t* MP; bf16_t* MG;
    __device__ __forceinline__ void pair(int mpm, int pn, int r, int c, f32x4 va, f32x4 vb) const {
        const size_t row = (size_t)mpm * 256 + r; const int col = 256 * pn + c;
        const f32x4 g0 = load_bf4(Gt + row * 2048 + col), g1 = load_bf4(Gt + row * 2048 + col + 128);
        const f32x4 m0 = load_bf4(MP + row * DM + col), m1 = load_bf4(MP + row * DM + col + 128);
        store_bf4(MG + row * DM + col, g0 * va + m0); store_bf4(MG + row * DM + col + 128, g1 * vb + m1);
    }
};
struct Epi4 {
    const float* X; float* O;
    __device__ __forceinline__ void pair(int mpm, int pn, int r, int c, f32x4 va, f32x4 vb) const {
        const size_t off = ((size_t)mpm * 256 + r) * DM + 256 * pn + c;
        *(f32x4*)(O + off) = *(const f32x4*)(X + off) + va; *(f32x4*)(O + off + 128) = *(const f32x4*)(X + off + 128) + vb;
    }
};
struct Epi5 {
    bf16_t* H;
    __device__ __forceinline__ void pair(int mpm, int pn, int r, int c, f32x4 va, f32x4 vb) const {
        store_bf4(H + ((size_t)mpm * 256 + r) * FF + 128 * pn + c, va * sigm4(va) * vb);
    }
};
struct Epi6 {
    const float* VAL; bf16_t* YE;
    __device__ __forceinline__ void pair(int mpm, int pn, int r, int c, f32x4 va, f32x4 vb) const {
        const size_t row = (size_t)mpm * 256 + r; const float tv = VAL[row]; bf16_t* p = YE + row * DM + 256 * pn + c;
        store_bf4(p, va * tv); store_bf4(p + 128, vb * tv);
    }
};
struct Epi7 {
    const float* bias; bf16_t* GL;
    __device__ __forceinline__ void pair(int mpm, int pn, int r, int c, f32x4 va, f32x4 vb) const {
        const int col = 256 * pn + c; bf16_t* p = GL + ((size_t)mpm * 256 + r) * DM + col;
        store_bf4(p, sigm4(va + *(const f32x4*)(bias + col))); store_bf4(p + 128, sigm4(vb + *(const f32x4*)(bias + col + 128)));
    }
};
struct Epi8 {
    bf16_t* ER;
    __device__ __forceinline__ void pair(int mpm, int pn, int r, int c, f32x4 va, f32x4 vb) const {
        bf16_t* p = ER + ((size_t)mpm * 256 + r) * DM + 256 * pn + c; store_bf4(p, va); store_bf4(p + 128, vb);
    }
};

template <class Epi>
__device__ __forceinline__ void gemm_simple(LAS unsigned char* lds, const GemmDesc& g, int G, int cidx, const Epi& E) {
    LAS float* As = (LAS float*)lds;
    LAS float* Bs = As + 32 * 256;
    const int tid = threadIdx.x, tx = tid & 31, ty = tid >> 5;
    StaticOrder S; S.init(g.nM, g.nN, G, cidx);
    Unit u;
    for (int it = 0; S.next(it, u); ++it) {
        const bf16_t* Ap = g.a_ptr(u); const bf16_t* Bp = g.b_ptr(u);
        f32x4 accA[16], accB[16];
#pragma unroll
        for (int i = 0; i < 16; ++i) { accA[i] = (f32x4){0.f, 0.f, 0.f, 0.f}; accB[i] = (f32x4){0.f, 0.f, 0.f, 0.f}; }
        for (int k0 = 0; k0 < g.K; k0 += 32) {
            __syncthreads();
            {
                const int row = tid >> 1, hf = tid & 1;
                const u32x4* pa = (const u32x4*)(Ap + (size_t)row * g.lda + k0 + 16 * hf);
                const u32x4* pb = (const u32x4*)(Bp + (size_t)row * g.K + k0 + 16 * hf);
                const u32x4 a0 = pa[0], a1 = pa[1], b0 = pb[0], b1 = pb[1];
                const unsigned aw[8] = {a0.x, a0.y, a0.z, a0.w, a1.x, a1.y, a1.z, a1.w};
                const unsigned bw[8] = {b0.x, b0.y, b0.z, b0.w, b1.x, b1.y, b1.z, b1.w};
#pragma unroll
                for (int q = 0; q < 8; ++q) {
                    As[(16 * hf + 2 * q) * 256 + row] = bf_lo(aw[q]); As[(16 * hf + 2 * q + 1) * 256 + row] = bf_hi(aw[q]);
                    Bs[(16 * hf + 2 * q) * 256 + row] = bf_lo(bw[q]); Bs[(16 * hf + 2 * q + 1) * 256 + row] = bf_hi(bw[q]);
                }
            }
            __syncthreads();
#pragma unroll 2
            for (int kk = 0; kk < 32; ++kk) {
                f32x4 a[4];
#pragma unroll
                for (int q = 0; q < 4; ++q) a[q] = *(const LAS f32x4*)(As + kk * 256 + 16 * ty + 4 * q);
                const f32x4 b0 = *(const LAS f32x4*)(Bs + kk * 256 + 4 * tx), b1 = *(const LAS f32x4*)(Bs + kk * 256 + 128 + 4 * tx);
#pragma unroll
                for (int i = 0; i < 16; ++i) { const float av = a[i >> 2][i & 3]; accA[i] += av * b0; accB[i] += av * b1; }
            }
        }
        const int mpm = g.mem_pm(u.pm);
#pragma unroll
        for (int i = 0; i < 16; ++i) E.pair(mpm, u.pn, 16 * ty + i, 4 * tx, accA[i], accB[i]);
    }
    __syncthreads();
}

template <class Epi>
__device__ __forceinline__ void gemm_phase(LAS unsigned char* lds, const GemmDesc& g, int G, int cidx, const Epi& E) { gemm_simple<Epi>(lds, g, G, cidx, E); }

struct Args { const float* in[24]; float* out; unsigned char* ws; };
enum { I_X = 0, I_P, I_N1G, I_WIN, I_BGATE, I_CONVW, I_CONVB, I_LNG, I_LNB, I_WCO, I_WPOOL, I_PSCALE, I_WOUT, I_N2G, I_WR, I_WEG, I_WEU, I_WED, I_N3G, I_WPG, I_BPG, I_WPLE, I_PNG, I_FG };

__device__ __forceinline__ void transpose_item(const float* W, int K, int N, bf16_t* WT, int k0, int n0, int drow0, LAS float* scr, int lane) {
#pragma unroll 8
    for (int i = 0; i < 32; ++i) { const int kk = 2 * i + (lane >> 5); scr[kk * 33 + (lane & 31)] = W[(size_t)(k0 + kk) * N + n0 + (lane & 31)]; }
    LDS_WAIT();
    const int c = lane & 7;
#pragma unroll
    for (int j = 0; j < 4; ++j) { const int n = (lane >> 3) + 8 * j; const LAS float* s = scr + (8 * c) * 33 + n;
        u32x4 o; o.x = pk2(s[0 * 33], s[1 * 33]); o.y = pk2(s[2 * 33], s[3 * 33]); o.z = pk2(s[4 * 33], s[5 * 33]); o.w = pk2(s[6 * 33], s[7 * 33]);
        *(u32x4*)(WT + (size_t)(drow0 + n) * K + k0 + 8 * c) = o; }
    LDS_WAIT();
}
constexpr int IT_WIN = (DM / 64) * (INC / 32);
constexpr int IT_WC = (CD / 64) * (DM / 32);
constexpr int IT_WP = 4 * (128 / 64) * (256 / 32);
constexpr int IT_SQ = (DM / 64) * (DM / 32);
constexpr int IT_WPLE = (PLE / 64) * (DM / 32);
constexpr int IT_EXP = NE * IT_SQ;
constexpr int IT_TOTAL = IT_WIN + IT_WC + IT_WP + IT_SQ + IT_SQ + IT_WPLE + 3 * IT_EXP;

__device__ __forceinline__ void phase0(const Args& a, LAS unsigned char* lds, int gw, int NGW, int wave, int lane) {
    unsigned char* ws = a.ws;
    LAS float* scr = (LAS float*)(lds + wave * 16384);
    for (int it = gw; it < IT_TOTAL; it += NGW) {
        int r = it;
        if (r < IT_WIN) {
            const int nblk = INC / 32, kb = r / nblk, nb = r % nblk, n0 = 32 * nb;
            int d0;
            if (n0 < 512) d0 = 256 * (n0 >> 7) + (n0 & 127); else if (n0 < 1024) d0 = 256 * ((n0 - 512) >> 7) + 128 + (n0 & 127); else d0 = n0;
            transpose_item(a.in[I_WIN], DM, INC, (bf16_t*)(ws + WS_WIN), 64 * kb, n0, d0, scr, lane); continue; }
        r -= IT_WIN;
        if (r < IT_WC) { const int nblk = DM / 32, kb = r / nblk, nb = r % nblk; transpose_item(a.in[I_WCO], CD, DM, (bf16_t*)(ws + WS_WC), 64 * kb, 32 * nb, 32 * nb, scr, lane); continue; }
        r -= IT_WC;
        if (r < IT_WP) { const int gi = r / 16, q = r % 16, kb = q / 8, nb = q % 8;
            transpose_item(a.in[I_WPOOL] + (size_t)gi * 128 * 256, 128, 256, (bf16_t*)(ws + WS_WP) + (size_t)gi * 256 * 128, 64 * kb, 32 * nb, 32 * nb, scr, lane); continue; }
        r -= IT_WP;
        if (r < IT_SQ) { const int kb = r / 32, nb = r % 32; transpose_item(a.in[I_WOUT], DM, DM, (bf16_t*)(ws + WS_WOUT), 64 * kb, 32 * nb, 32 * nb, scr, lane); continue; }
        r -= IT_SQ;
        if (r < IT_SQ) { const int kb = r / 32, nb = r % 32; transpose_item(a.in[I_WPG], DM, DM, (bf16_t*)(ws + WS_WPG), 64 * kb, 32 * nb, 32 * nb, scr, lane); continue; }
        r -= IT_SQ;
        if (r < IT_WPLE) { const int kb = r / 32, nb = r % 32; transpose_item(a.in[I_WPLE], PLE, DM, (bf16_t*)(ws + WS_WPLE), 64 * kb, 32 * nb, 32 * nb, scr, lane); continue; }
        r -= IT_WPLE;
        if (r < IT_EXP) { const int e = r / IT_SQ, q = r % IT_SQ, kb = q / 32, nb = q % 32, n0 = 32 * nb;
            transpose_item(a.in[I_WEG] + (size_t)e * DM * FF, DM, FF, (bf16_t*)(ws + WS_WGU) + (size_t)e * 2048 * DM, 64 * kb, n0, 256 * (n0 >> 7) + (n0 & 127), scr, lane); continue; }
        r -= IT_EXP;
        if (r < IT_EXP) { const int e = r / IT_SQ, q = r % IT_SQ, kb = q / 32, nb = q % 32, n0 = 32 * nb;
            transpose_item(a.in[I_WEU] + (size_t)e * DM * FF, DM, FF, (bf16_t*)(ws + WS_WGU) + (size_t)e * 2048 * DM, 64 * kb, n0, 256 * (n0 >> 7) + 128 + (n0 & 127), scr, lane); continue; }
        r -= IT_EXP;
        { const int e = r / IT_SQ, q = r % IT_SQ, kb = q / 32, nb = q % 32;
            transpose_item(a.in[I_WED] + (size_t)e * FF * DM, FF, DM, (bf16_t*)(ws + WS_WD) + (size_t)e * DM * FF, 64 * kb, 32 * nb, 32 * nb, scr, lane); }
    }
    const float* x = a.in[I_X]; const float* g1 = a.in[I_N1G]; bf16_t* XN = (bf16_t*)(ws + WS_XN);
    f32x4 gg[4];
#pragma unroll
    for (int j = 0; j < 4; ++j) gg[j] = ((const f32x4*)g1)[lane + 64 * j];
    for (int m = gw; m < NT; m += NGW) {
        const f32x4* xr = (const f32x4*)(x + (size_t)m * DM) + lane; f32x4 v[4]; float s = 0.f;
#pragma unroll
        for (int j = 0; j < 4; ++j) { v[j] = xr[64 * j]; s += (v[j].x * v[j].x + v[j].y * v[j].y) + (v[j].z * v[j].z + v[j].w * v[j].w); }
        const float rstd = rsqrtf(wave_sum(s) * (1.0f / DM) + EPS);
        u32x2* o = (u32x2*)(XN + (size_t)m * DM) + lane;
#pragma unroll
        for (int j = 0; j < 4; ++j) { const f32x4 y = v[j] * rstd * gg[j]; u32x2 w; w.x = pk2(y.x, y.y); w.y = pk2(y.z, y.w); o[64 * j] = w; }
    }
}

__device__ __forceinline__ void phase2(const Args& a, LAS unsigned char* lds, int G, int cidx) {
    unsigned char* ws = a.ws;
    const bf16_t* V = (const bf16_t*)(ws + WS_V); const bf16_t* U = (const bf16_t*)(ws + WS_U);
    bf16_t* CS = (bf16_t*)(ws + WS_CS); bf16_t* PDo = (bf16_t*)(ws + WS_PD);
    LAS unsigned* Vs = (LAS unsigned*)lds;
    LAS unsigned* Us = Vs + 46 * 256;
    LAS float* red = (LAS float*)(Us + 31 * 256);
    const int tid = threadIdx.x, cp = tid & 255, th = tid >> 8, wave = tid >> 6, lane = tid & 63;
    const float cb0 = a.in[I_CONVB][2 * cp], cb1 = a.in[I_CONVB][2 * cp + 1];
    const float lg0 = a.in[I_LNG][2 * cp], lg1 = a.in[I_LNG][2 * cp + 1], lb0 = a.in[I_LNB][2 * cp], lb1 = a.in[I_LNB][2 * cp + 1];
    const int grp = cp >> 6, half = 1 << grp;
    for (int unit = cidx; unit < NT / 16; unit += G) {
        const int t0 = unit * 16, b = t0 / SEQ, s0 = t0 % SEQ;
        __syncthreads();
#pragma unroll 1
        for (int q = tid; q < 46 * 64; q += NTHREADS) { const int r = q >> 6, ch = q & 63, s = s0 - 15 + r;
            u32x4 v = (u32x4){0u, 0u, 0u, 0u};
            if (s >= 0 && s < SEQ) v = *(const u32x4*)(V + ((size_t)(b * SEQ + s)) * CD + ch * 8);
            *(LAS u32x4*)(Vs + r * 256 + ch * 4) = v; }
#pragma unroll 1
        for (int q = tid; q < 31 * 64; q += NTHREADS) { const int r = q >> 6, ch = q & 63, s = s0 - 8 + r;
            u32x4 v = (u32x4){0u, 0u, 0u, 0u};
            if (s >= 0 && s < SEQ) v = *(const u32x4*)(U + ((size_t)(b * SEQ + s)) * PDIM + ch * 8);
            *(LAS u32x4*)(Us + r * 256 + ch * 4) = v; }
        __syncthreads();
        float a0[8], a1[8];
#pragma unroll
        for (int j = 0; j < 8; ++j) { a0[j] = cb0; a1[j] = cb1; }
#pragma unroll 1
        for (int kc = 0; kc < 32; kc += 8) {
            float w0[8], w1[8];
#pragma unroll
            for (int kk = 0; kk < 8; ++kk) { const int k = kc + kk; typedef float f32x2_ __attribute__((ext_vector_type(2)));
                f32x2_ wv = (f32x2_){0.f, 0.f}; if (k < CWID) wv = *(const f32x2_*)(a.in[I_CONVW] + k * CD + 2 * cp); w0[kk] = wv.x; w1[kk] = wv.y; }
#pragma unroll
            for (int rr = 0; rr < 15; ++rr) {
                const int r = kc + rr;
                unsigned pv = 0u; if (r < 38) pv = Vs[(8 * th + r) * 256 + cp];
                const float x0 = bf_lo(pv), x1 = bf_hi(pv);
#pragma unroll
                for (int j = 0; j < 8; ++j) { const int kk = rr - j; if (kk >= 0 && kk < 8) { a0[j] += x0 * w0[kk]; a1[j] += x1 * w1[kk]; } }
            }
        }
        asm volatile("" ::: "memory");
        float s1[8], s2[8];
#pragma unroll
        for (int j = 0; j < 8; ++j) { s1[j] = wave_sum(a0[j] + a1[j]); s2[j] = wave_sum(a0[j] * a0[j] + a1[j] * a1[j]); }
        if (lane == 0) {
#pragma unroll
            for (int j = 0; j < 8; ++j) { red[wave * 16 + j] = s1[j]; red[wave * 16 + 8 + j] = s2[j]; } }
        __syncthreads();
#pragma unroll
        for (int j = 0; j < 8; ++j) {
            float t1 = 0.f, t2 = 0.f;
#pragma unroll
            for (int w = 0; w < 4; ++w) { t1 += red[(4 * th + w) * 16 + j]; t2 += red[(4 * th + w) * 16 + 8 + j]; }
            const float mean = t1 * (1.0f / CD); float var = t2 * (1.0f / CD) - mean * mean; var = var > 0.f ? var : 0.f;
            const float rstd = rsqrtf(var + EPS);
            const float y0 = (a0[j] - mean) * rstd * lg0 + lb0, y1 = (a1[j] - mean) * rstd * lg1 + lb1;
            *(unsigned*)(CS + ((size_t)(t0 + 8 * th + j)) * CD + 2 * cp) = pk2(y0 * sigm(y0), y1 * sigm(y1));
        }
        asm volatile("" ::: "memory");
#pragma unroll 1
        for (int j = 0; j < 8; ++j) {
            const int s = s0 + 8 * th + j; float p0 = 0.f, p1 = 0.f;
            for (int k = -half; k < half; ++k) { const unsigned pu = Us[(8 * th + j + k + 8) * 256 + cp]; p0 += bf_lo(pu); p1 += bf_hi(pu); }
            const int lo = (s - half) > 0 ? (s - half) : 0, hi = (s + half - 1) < (SEQ - 1) ? (s + half - 1) : (SEQ - 1);
            const float inv = 1.0f / (float)(hi - lo + 1);
            const unsigned pc = Us[(8 * th + j + 8) * 256 + cp];
            *(unsigned*)(PDo + ((size_t)(t0 + 8 * th + j)) * PDIM + 2 * cp) = pk2(p0 * inv - bf_lo(pc), p1 * inv - bf_hi(pc));
        }
    }
    __syncthreads();
}

__device__ __forceinline__ void phase6(const Args& a, LAS unsigned char* lds, int gw, int NGW, int lane) {
    unsigned char* ws = a.ws;
    LAS float* wrT = (LAS float*)lds;
    for (int q = threadIdx.x; q < DM * NE; q += NTHREADS) { const int d = q >> 4, e = q & 15; wrT[e * DM + d] = a.in[I_WR][q]; }
    __syncthreads();
    const float* X1 = a.out; const float* g2 = a.in[I_N2G]; bf16_t* XN = (bf16_t*)(ws + WS_XN); float* AFF = (float*)(ws + WS_AFF);
    f32x4 gg[4];
#pragma unroll
    for (int j = 0; j < 4; ++j) gg[j] = ((const f32x4*)g2)[lane + 64 * j];
    for (int m = gw; m < NT; m += NGW) {
        const f32x4* xr = (const f32x4*)(X1 + (size_t)m * DM) + lane; f32x4 v[4]; float s = 0.f;
#pragma unroll
        for (int j = 0; j < 4; ++j) { v[j] = xr[64 * j]; s += (v[j].x * v[j].x + v[j].y * v[j].y) + (v[j].z * v[j].z + v[j].w * v[j].w); }
        const float rstd = rsqrtf(wave_sum(s) * (1.0f / DM) + EPS);
        u32x2* o = (u32x2*)(XN + (size_t)m * DM) + lane;
#pragma unroll
        for (int j = 0; j < 4; ++j) { v[j] = v[j] * rstd * gg[j]; u32x2 w; w.x = pk2(v[j].x, v[j].y); w.y = pk2(v[j].z, v[j].w); o[64 * j] = w; }
        float lg[NE];
        asm volatile("" ::: "memory");
#pragma unroll
        for (int e = 0; e < NE; ++e) { float t = 0.f;
#pragma unroll
            for (int j = 0; j < 4; ++j) { const f32x4 w = *(const LAS f32x4*)(wrT + e * DM + 256 * j + 4 * lane); t += (v[j].x * w.x + v[j].y * w.y) + (v[j].z * w.z + v[j].w * w.w); }
            lg[e] = wave_sum(t); }
        float mx = lg[0];
#pragma unroll
        for (int e = 1; e < NE; ++e) mx = fmaxf(mx, lg[e]);
        float den = 0.f;
#pragma unroll
        for (int e = 0; e < NE; ++e) { lg[e] = __expf(lg[e] - mx); den += lg[e]; }
        const float rden = 1.0f / den; float mine = lg[0];
#pragma unroll
        for (int e = 1; e < NE; ++e) mine = (lane == e) ? lg[e] : mine;
        if (lane < NE) AFF[(size_t)m * NE + lane] = mine * rden;
    }
    __syncthreads();
}

__device__ __forceinline__ void phase7(const Args& a, LAS unsigned char* lds, int G, int cidx) {
    unsigned char* ws = a.ws;
    const float* AFF = (const float*)(ws + WS_AFF); int* IDX = (int*)(ws + WS_IDX); float* VAL = (float*)(ws + WS_VAL); int* INV = (int*)(ws + WS_INV);
    const bf16_t* XN = (const bf16_t*)(ws + WS_XN); bf16_t* XG = (bf16_t*)(ws + WS_XG);
    LAS int* cnt = (LAS int*)lds;
    LAS int* wtot = cnt + 16;
    LAS int* sidx = wtot + 8;
    const int tid = threadIdx.x, wave = tid >> 6, lane = tid & 63;
    for (int be = cidx; be < NB * NE; be += G) {
        const int b = be >> 4, e = be & 15;
        __syncthreads();
        unsigned v[4];
#pragma unroll
        for (int j = 0; j < 4; ++j) v[j] = __float_as_uint(AFF[((size_t)(b * SEQ + 4 * tid + j)) * NE + e]);
        unsigned T = 0u;
        for (int bit = 30; bit >= 0; --bit) {
            const unsigned cand = T | (1u << bit); int c = 0;
#pragma unroll
            for (int j = 0; j < 4; ++j) c += (int)__popcll(__ballot(v[j] >= cand));
            LAS int* slot = cnt + ((bit & 1) << 3);
            if (lane == 0) slot[wave] = c;
            __syncthreads();
            int tot = 0;
#pragma unroll
            for (int w = 0; w < 8; ++w) tot += slot[w];
            if (tot >= CAP) T = cand;
        }
        int mygt = 0, myeq = 0;
#pragma unroll
        for (int j = 0; j < 4; ++j) { mygt += (v[j] > T) ? 1 : 0; myeq += (v[j] == T) ? 1 : 0; }
        const int pk = mygt | (myeq << 16); int inc = pk;
#pragma unroll
        for (int o = 1; o < 64; o <<= 1) { const int t = __shfl_up(inc, o); if (lane >= o) inc += t; }
        __syncthreads();
        if (lane == 63) wtot[wave] = inc;
        __syncthreads();
        int base = 0, total = 0;
#pragma unroll
        for (int w = 0; w < 8; ++w) { const int t = wtot[w]; if (w < wave) base += t; total += t; }
        const int excl = base + inc - pk; int pg = excl & 0xffff, pq = excl >> 16;
        const int ngt = total & 0xffff, need = CAP - ngt;
#pragma unroll
        for (int j = 0; j < 4; ++j) {
            const int tok = 4 * tid + j; int slot = -1;
            if (v[j] > T) { slot = pg + (pq < need ? pq : need); ++pg; }
            else if (v[j] == T) { if (pq < need) slot = pg + pq; ++pq; }
            INV[((size_t)(b * SEQ + tok)) * NE + e] = slot;
            if (slot >= 0) { IDX[be * CAP + slot] = tok; VAL[be * CAP + slot] = __uint_as_float(v[j]); sidx[slot] = tok; }
        }
        __syncthreads();
        for (int r = wave; r < CAP; r += NWAVES) {
            const int tok = sidx[r];
            const u32x4* src = (const u32x4*)(XN + ((size_t)(b * SEQ + tok)) * DM) + lane; u32x4* dst = (u32x4*)(XG + ((size_t)be * CAP + r) * DM) + lane;
            dst[0] = src[0]; dst[64] = src[64];
        }
    }
    __syncthreads();
}

__device__ __forceinline__ void phase10(const Args& a, int gw, int NGW, int lane) {
    unsigned char* ws = a.ws;
    const int* INV = (const int*)(ws + WS_INV); const bf16_t* YE = (const bf16_t*)(ws + WS_YE); bf16_t* XN = (bf16_t*)(ws + WS_XN);
    float* X = a.out; const float* g3 = a.in[I_N3G];
    f32x4 gg[4];
#pragma unroll
    for (int j = 0; j < 4; ++j) gg[j] = ((const f32x4*)g3)[lane + 64 * j];
    for (int m = gw; m < NT; m += NGW) {
        const int b = m / SEQ;
        const int myinv = INV[(size_t)m * NE + (lane & 15)];
        f32x4* xr = (f32x4*)(X + (size_t)m * DM) + lane; f32x4 v[4];
#pragma unroll
        for (int j = 0; j < 4; ++j) v[j] = xr[64 * j];
#pragma unroll
        for (int e = 0; e < NE; ++e) {
            const int slot = __builtin_amdgcn_readlane(myinv, e);
            if (slot >= 0) {
                const bf16_t* yr = YE + ((size_t)(b * NE + e) * CAP + slot) * DM + 4 * lane;
#pragma unroll
                for (int j = 0; j < 4; ++j) v[j] += load_bf4(yr + 256 * j);
            }
        }
        float s = 0.f;
#pragma unroll
        for (int j = 0; j < 4; ++j) { xr[64 * j] = v[j]; s += (v[j].x * v[j].x + v[j].y * v[j].y) + (v[j].z * v[j].z + v[j].w * v[j].w); }
        const float rstd = rsqrtf(wave_sum(s) * (1.0f / DM) + EPS);
        u32x2* o = (u32x2*)(XN + (size_t)m * DM) + lane;
#pragma unroll
        for (int j = 0; j < 4; ++j) { const f32x4 y = v[j] * rstd * gg[j]; u32x2 w; w.x = pk2(y.x, y.y); w.y = pk2(y.z, y.w); o[64 * j] = w; }
    }
    const f32x4* P = (const f32x4*)a.in[I_P]; u32x2* PB = (u32x2*)(ws + WS_PBF);
    for (size_t q = (size_t)gw * 64 + lane; q < (size_t)NT * PLE / 4; q += (size_t)NGW * 64) { const f32x4 t = P[q]; u32x2 w; w.x = pk2(t.x, t.y); w.y = pk2(t.z, t.w); PB[q] = w; }
}

__device__ __forceinline__ void phase12(const Args& a, int gw, int NGW, int lane) {
    unsigned char* ws = a.ws;
    const bf16_t* GL = (const bf16_t*)(ws + WS_GL); const bf16_t* ER = (const bf16_t*)(ws + WS_ERAW); float* X = a.out;
    f32x4 gp[4], gf[4];
#pragma unroll
    for (int j = 0; j < 4; ++j) { gp[j] = ((const f32x4*)a.in[I_PNG])[lane + 64 * j]; gf[j] = ((const f32x4*)a.in[I_FG])[lane + 64 * j]; }
    for (int m = gw; m < NT; m += NGW) {
        f32x4* xr = (f32x4*)(X + (size_t)m * DM) + lane; f32x4 v[4], ev[4], gv[4]; float se = 0.f;
#pragma unroll
        for (int j = 0; j < 4; ++j) { v[j] = xr[64 * j]; ev[j] = load_bf4(ER + (size_t)m * DM + 4 * lane + 256 * j); gv[j] = load_bf4(GL + (size_t)m * DM + 4 * lane + 256 * j);
            se += (ev[j].x * ev[j].x + ev[j].y * ev[j].y) + (ev[j].z * ev[j].z + ev[j].w * ev[j].w); }
        const float rse = rsqrtf(wave_sum(se) * (1.0f / DM) + EPS); float s = 0.f;
#pragma unroll
        for (int j = 0; j < 4; ++j) { v[j] = v[j] + gv[j] * (ev[j] * rse * gp[j]); s += (v[j].x * v[j].x + v[j].y * v[j].y) + (v[j].z * v[j].z + v[j].w * v[j].w); }
        const float rstd = rsqrtf(wave_sum(s) * (1.0f / DM) + EPS);
#pragma unroll
        for (int j = 0; j < 4; ++j) xr[64 * j] = v[j] * rstd * gf[j];
    }
}

constexpr int N_PHASES = 13;
template <int LO, int HI>
__global__ void __launch_bounds__(NTHREADS, 2) mk_fwd(Args a) {
    extern __shared__ __attribute__((aligned(16))) unsigned char lds_raw[];
    LAS unsigned char* lds = (LAS unsigned char*)lds_raw;
    const int tid = threadIdx.x, lane = tid & 63, wave = __builtin_amdgcn_readfirstlane(tid >> 6);
    const int G = gridDim.x, bx = blockIdx.x;
    const int vcu = (G % 8 == 0) ? (bx % 8) * (G / 8) + bx / 8 : bx;
    const int gw = vcu * NWAVES + wave, NGW = G * NWAVES;
    unsigned char* ws = a.ws;
#define IN(k) (LO <= (k) && (k) < HI)
    if (IN(0)) phase0(a, lds, gw, NGW, wave, lane);
    if (IN(1)) {
        GemmDesc g{(const bf16_t*)(ws + WS_XN), (const bf16_t*)(ws + WS_WIN), DM, DM, NT / 256, INC / 256, 0, 0, 0};
        Epi1 E{(bf16_t*)(ws + WS_V), (bf16_t*)(ws + WS_U), (bf16_t*)(ws + WS_G), a.in[I_BGATE]};
        gemm_phase(lds, g, G, bx, E);
    }
    if (IN(2)) phase2(a, lds, G, vcu);
    if (IN(3)) {
        GemmDesc g{(const bf16_t*)(ws + WS_PD), (const bf16_t*)(ws + WS_WP), PDIM, 128, NT / 256, 4, 128, 0, 0};
        Epi2 E{(const bf16_t*)(ws + WS_G), a.in[I_PSCALE], (bf16_t*)(ws + WS_MP)};
        gemm_phase(lds, g, G, bx, E);
    }
    if (IN(4)) {
        GemmDesc g{(const bf16_t*)(ws + WS_CS), (const bf16_t*)(ws + WS_WC), CD, CD, NT / 256, DM / 256, 0, 0, 0};
        Epi3 E{(const bf16_t*)(ws + WS_G), (const bf16_t*)(ws + WS_MP), (bf16_t*)(ws + WS_MERGED)};
        gemm_phase(lds, g, G, bx, E);
    }
    if (IN(5)) {
        GemmDesc g{(const bf16_t*)(ws + WS_MERGED), (const bf16_t*)(ws + WS_WOUT), DM, DM, NT / 256, DM / 256, 0, 0, 0};
        Epi4 E{a.in[I_X], a.out};
        gemm_phase(lds, g, G, bx, E);
    }
    if (IN(6)) phase6(a, lds, gw, NGW, lane);
    if (IN(7)) phase7(a, lds, G, vcu);
    if (IN(8)) {
        GemmDesc g{(const bf16_t*)(ws + WS_XG), (const bf16_t*)(ws + WS_WGU), DM, DM, NB * NE, 2048 / 256, 0, 1, (size_t)2048 * DM};
        Epi5 E{(bf16_t*)(ws + WS_HID)};
        gemm_phase(lds, g, G, bx, E);
    }
    if (IN(9)) {
        GemmDesc g{(const bf16_t*)(ws + WS_HID), (const bf16_t*)(ws + WS_WD), FF, FF, NB * NE, DM / 256, 0, 1, (size_t)DM * FF};
        Epi6 E{(const float*)(ws + WS_VAL), (bf16_t*)(ws + WS_YE)};
        gemm_phase(lds, g, G, bx, E);
    }
    if (IN(10)) phase10(a, gw, NGW, lane);
    if (IN(11)) {
        { GemmDesc g{(const bf16_t*)(ws + WS_XN), (const bf16_t*)(ws + WS_WPG), DM, DM, NT / 256, DM / 256, 0, 0, 0};
          Epi7 E{a.in[I_BPG], (bf16_t*)(ws + WS_GL)};
          gemm_phase(lds, g, G, bx, E); }
        { GemmDesc g{(const bf16_t*)(ws + WS_PBF), (const bf16_t*)(ws + WS_WPLE), PLE, PLE, NT / 256, DM / 256, 0, 0, 0};
          Epi8 E{(bf16_t*)(ws + WS_ERAW)};
          gemm_phase(lds, g, G, bx, E); }
    }
    if (IN(12)) phase12(a, gw, NGW, lane);
#undef IN
}

typedef void (*kern_t)(Args);
template <int P> struct PhaseTab { static void fill(kern_t* t) { t[P] = mk_fwd<P, P + 1>; PhaseTab<P - 1>::fill(t); } };
template <> struct PhaseTab<-1> { static void fill(kern_t*) {} };

extern "C" void kernel_launch(void* const* d_in, const int* in_sizes, int n_in, void* d_out, int out_size, void* d_ws, size_t ws_size, hipStream_t stream) {
    static int grid = 0; static kern_t tab[N_PHASES];
    if (grid == 0) {
        if (n_in != 24 || in_sizes[0] != NT * DM || out_size != NT * DM || ws_size < WS_END) {
            fprintf(stderr, "kernel_launch: unexpected shapes: n_in %d in0 %d out %d ws %zu (need %zu)\n", n_in, n_in > 0 ? in_sizes[0] : -1, out_size, ws_size, (size_t)WS_END); grid = -1; return; }
        int dev = 0, cus = 0;
        if (hipGetDevice(&dev) != hipSuccess || hipDeviceGetAttribute(&cus, hipDeviceAttributeMultiprocessorCount, dev) != hipSuccess) { grid = -1; return; }
        PhaseTab<N_PHASES - 1>::fill(tab);
        for (int p = 0; p < N_PHASES; ++p) {
            int per_cu = 0;
            if (hipFuncSetAttribute((const void*)tab[p], hipFuncAttributeMaxDynamicSharedMemorySize, LDS_BYTES) != hipSuccess) { fprintf(stderr, "kernel_launch: hipFuncSetAttribute failed (phase %d)\n", p); grid = -1; return; }
            if (hipOccupancyMaxActiveBlocksPerMultiprocessor(&per_cu, (const void*)tab[p], NTHREADS, LDS_BYTES) != hipSuccess || per_cu < 1) { fprintf(stderr, "kernel_launch: occupancy query says %d (phase %d)\n", per_cu, p); grid = -1; (void)hipGetLastError(); return; }
        }
        grid = cus;
    }
    if (grid < 0) return;
    Args a{};
    for (int i = 0; i < 24; ++i) a.in[i] = (const float*)d_in[i];
    a.out = (float*)d_out; a.ws = (unsigned char*)d_ws;
    for (int p = 0; p < N_PHASES; ++p) hipLaunchKernelGGL(tab[p], dim3(grid), dim3(NTHREADS), LDS_BYTES, stream, a);
}
```

```cpp
#include <hip/hip_runtime.h>
#include <cstdio>
#include <cstdint>

#define LAS __attribute__((address_space(3)))
typedef unsigned short bf16_t;
typedef float f32x4 __attribute__((ext_vector_type(4)));
typedef unsigned u32x2 __attribute__((ext_vector_type(2)));
typedef unsigned u32x4 __attribute__((ext_vector_type(4)));

constexpr int NB = 16, SEQ = 2048, DM = 1024, NT = NB * SEQ;
constexpr int PLE = 256, CD = 512, CWID = 31, PDIM = 512, NE = 16, FF = 1024, CAP = 256, INC = 3584;
constexpr float EPS = 1e-6f;
constexpr int NWAVES = 8, NTHREADS = 512;
constexpr int LDS_BYTES = 147456;

constexpr size_t MiB = 1u << 20;
constexpr size_t WS_CTL = 0;
constexpr size_t WS_WIN = 1 * MiB;
constexpr size_t WS_WCAT = 8 * MiB;
constexpr size_t WS_WPLE = 9 * MiB + 512 * 1024;
constexpr size_t WS_WOUT = 10 * MiB;
constexpr size_t WS_WPG = 12 * MiB;
constexpr size_t WS_WGU = 14 * MiB;
constexpr size_t WS_WD = 78 * MiB;
constexpr size_t WS_XN = 111 * MiB;
constexpr size_t WS_R1 = 175 * MiB;
constexpr size_t WS_V = WS_R1;
constexpr size_t WS_U = WS_R1 + 32 * MiB;
constexpr size_t WS_G = WS_R1 + 64 * MiB;
constexpr size_t WS_MERGED = WS_R1;
constexpr size_t WS_HID = WS_R1;
constexpr size_t WS_GL = WS_R1 + 64 * MiB;
constexpr size_t WS_PBF = WS_R1;
constexpr size_t WS_X2Q = WS_R1 + 16 * MiB;
constexpr size_t WS_X1B = WS_R1 + 128 * MiB;
constexpr size_t WS_R2 = 367 * MiB;
constexpr size_t WS_CS = WS_R2;
constexpr size_t WS_PD = WS_R2 + 32 * MiB;
constexpr size_t WS_XQ = WS_R2;
constexpr size_t WS_X1Q = WS_R2;
constexpr size_t WS_YE = WS_R2;
constexpr size_t WS_ERAW = WS_R2;
constexpr size_t WS_AFF = 495 * MiB;
constexpr size_t WS_IDX = 497 * MiB;
constexpr size_t WS_VAL = 497 * MiB + 512 * 1024;
constexpr size_t WS_INV = 498 * MiB;
constexpr size_t WS_RSTD2 = 500 * MiB;
constexpr size_t WS_RSTD0 = 502 * MiB;
constexpr size_t WS_RSTD1 = 501 * MiB;
constexpr size_t WS_RSV = 497 * MiB + 256 * 1024;
constexpr size_t WS_END = 512 * MiB;

#define LDS_WAIT() asm volatile("s_waitcnt lgkmcnt(0)" ::: "memory")
#define VM_WAIT() asm volatile("s_waitcnt vmcnt(0)" ::: "memory")
__device__ __forceinline__ unsigned f2bf(float f) { unsigned u = __float_as_uint(f); return (u + 0x7fffu + ((u >> 16) & 1u)) >> 16; }
typedef float f32x2p __attribute__((ext_vector_type(2))); typedef __bf16 bf16x2p __attribute__((ext_vector_type(2)));
__device__ __forceinline__ unsigned pk2(float lo, float hi) { const f32x2p v = {lo, hi}; const bf16x2p b = __builtin_convertvector(v, bf16x2p); return __builtin_bit_cast(unsigned, b); }
__device__ __forceinline__ float bf_lo(unsigned w) { return __uint_as_float(w << 16); }
__device__ __forceinline__ float bf_hi(unsigned w) { return __uint_as_float(w & 0xffff0000u); }
__device__ __forceinline__ float sigm(float x) { return __builtin_amdgcn_rcpf(1.0f + __expf(-x)); }
__device__ __forceinline__ f32x4 sigm4(f32x4 v) { f32x4 o; o.x = sigm(v.x); o.y = sigm(v.y); o.z = sigm(v.z); o.w = sigm(v.w); return o; }
__device__ __forceinline__ void store_bf4(bf16_t* p, f32x4 v) { u32x2 w; w.x = pk2(v.x, v.y); w.y = pk2(v.z, v.w); *(u32x2*)p = w; }
__device__ __forceinline__ f32x4 load_bf4(const bf16_t* p) { const u32x2 w = *(const u32x2*)p; f32x4 o; o.x = bf_lo(w.x); o.y = bf_hi(w.x); o.z = bf_lo(w.y); o.w = bf_hi(w.y); return o; }
__device__ __forceinline__ void store_bf8(bf16_t* p, f32x4 lo, f32x4 hi) { u32x4 w; w.x = pk2(lo.x, lo.y); w.y = pk2(lo.z, lo.w); w.z = pk2(hi.x, hi.y); w.w = pk2(hi.z, hi.w); *(u32x4*)p = w; }
__device__ __forceinline__ void load_bf8(const bf16_t* p, f32x4& lo, f32x4& hi) { const u32x4 w = *(const u32x4*)p; lo = (f32x4){bf_lo(w.x), bf_hi(w.x), bf_lo(w.y), bf_hi(w.y)}; hi = (f32x4){bf_lo(w.z), bf_hi(w.z), bf_lo(w.w), bf_hi(w.w)}; }
__device__ __forceinline__ void r16_unpack(f32x4 (&o)[4], const u32x4 (&w)[2]) {
#pragma unroll
    for (int j = 0; j < 2; ++j) { o[2 * j] = (f32x4){bf_lo(w[j].x), bf_hi(w[j].x), bf_lo(w[j].y), bf_hi(w[j].y)}; o[2 * j + 1] = (f32x4){bf_lo(w[j].z), bf_hi(w[j].z), bf_lo(w[j].w), bf_hi(w[j].w)}; }
}
__device__ __forceinline__ unsigned pk_fp8x4(float a, float b, float c, float d) { int p = __builtin_amdgcn_cvt_pk_fp8_f32(a, b, 0, false); p = __builtin_amdgcn_cvt_pk_fp8_f32(c, d, p, true); return (unsigned)p; }
__device__ __forceinline__ unsigned q8x4(float a, float b, float c, float d) {
    const float M = 12582912.0f; const unsigned ua = __float_as_uint(a + M), ub = __float_as_uint(b + M), uc = __float_as_uint(c + M), ud = __float_as_uint(d + M);
    return __builtin_amdgcn_perm(__builtin_amdgcn_perm(ud, uc, 0x0c0c0400u), __builtin_amdgcn_perm(ub, ua, 0x0c0c0400u), 0x05040100u); }
__device__ __forceinline__ unsigned q8x4s(f32x4 v, float s) {
    const f32x4 t = v * s + 12582912.0f; const unsigned ua = __float_as_uint(t.x), ub = __float_as_uint(t.y), uc = __float_as_uint(t.z), ud = __float_as_uint(t.w);
    return __builtin_amdgcn_perm(__builtin_amdgcn_perm(ud, uc, 0x0c0c0400u), __builtin_amdgcn_perm(ub, ua, 0x0c0c0400u), 0x05040100u); }
__device__ __forceinline__ float clamp127(float v) { return __builtin_amdgcn_fmed3f(v, -127.0f, 127.0f); }
constexpr float WQ_SCALE = 127.0f * 32.0f / 4.0f, WQ_INV = 4.0f / (127.0f * 32.0f);
constexpr float W8_SCALE = 32.0f, W8_INV = 1.0f / 32.0f;
__device__ __forceinline__ float wave_sum(float v) {
#pragma unroll
    for (int o = 1; o < 64; o <<= 1) v += __shfl_xor(v, o);
    return v;
}


#define XB_TMO      128
#define XB_XCNT(j)  (256  + 64 * (j))
#define XB_XSUB(j)  (1280 + 64 * (j))
#define XB_XGEN(j)  (2304 + 64 * (j))
#define XB_TOP      3328
#define XB_TOPGEN   3392
#define XCD_BAR_WORDS 3456
#define XB_SPIN_CAP (1u << 18)
__device__ __forceinline__ unsigned xb_ld(unsigned* p)              { return __hip_atomic_load(p, __ATOMIC_RELAXED, __HIP_MEMORY_SCOPE_AGENT); }
__device__ __forceinline__ unsigned xb_add(unsigned* p, unsigned v) { return __hip_atomic_fetch_add(p, v, __ATOMIC_RELAXED, __HIP_MEMORY_SCOPE_AGENT); }
__device__ __forceinline__ unsigned xb_xcc_id() { return (unsigned)__builtin_amdgcn_s_getreg((3 << 11) | 20) & 0xFu; }
#define XB_SPIN(cond, bar) do { unsigned _sp = 0; while (cond) { __builtin_amdgcn_s_sleep(1); \
    if ((++_sp & 255u) == 0u) { if (xb_ld(&(bar)[XB_TMO])) break; if (_sp > XB_SPIN_CAP) { atomicAdd(&(bar)[XB_TMO], 1u); break; } } } } while (0)
struct XcdBarrier { unsigned* bar; unsigned x; volatile LAS unsigned* st; };
__device__ __forceinline__ XcdBarrier xcd_barrier_post(unsigned* bar, volatile LAS unsigned* st) {
    XcdBarrier b; b.bar = bar; b.x = xb_xcc_id(); b.st = st;
    if (threadIdx.x == 0) (void)xb_add(&bar[XB_XCNT(b.x)], 1u);
    return b;
}
__device__ __forceinline__ void xcd_barrier_complete(unsigned* bar, unsigned x, unsigned& nloc, unsigned& nx) {
    const unsigned G = gridDim.x * gridDim.y * gridDim.z;
    unsigned sum, cnt, mine, sp = 0u;
    for (;;) {
        sum = 0u; cnt = 0u; mine = 0u;
#pragma unroll
        for (unsigned j = 0; j < 16; ++j) { const unsigned c = xb_ld(&bar[XB_XCNT(j)]); sum += c; cnt += (c > 0u) ? 1u : 0u; mine = (j == x) ? c : mine; }
        if (sum == G) break;
        __builtin_amdgcn_s_sleep(1);
        if ((++sp & 255u) == 0u) { if (xb_ld(&bar[XB_TMO])) break; if (sp > XB_SPIN_CAP) { atomicAdd(&bar[XB_TMO], 1u); break; } }
    }
    nloc = mine > 0u ? mine : 1u; nx = cnt > 0u ? cnt : 1u;
}
__device__ __forceinline__ void xcd_barrier(const XcdBarrier& b) {
    asm volatile("s_waitcnt vmcnt(0)" ::: "memory");
    __syncthreads();
    if (threadIdx.x == 0) {
        unsigned* bar = b.bar;
        __builtin_amdgcn_s_waitcnt(0);
        unsigned nloc = b.st[0], nx = b.st[1];
        if (nloc == 0u) { xcd_barrier_complete(bar, b.x, nloc, nx); b.st[0] = nloc; b.st[1] = nx; }
        const unsigned old = xb_add(&bar[XB_XSUB(b.x)], 1u);
        const unsigned gen = old / nloc;
        if (old + 1u == (gen + 1u) * nloc) {
            __builtin_amdgcn_fence(__ATOMIC_RELEASE, "agent");
            asm volatile("s_waitcnt vmcnt(0)" ::: "memory");
            const unsigned og = xb_add(&bar[XB_TOP], 1u);
            const unsigned tg = og / nx;
            if (og + 1u == (tg + 1u) * nx) xb_add(&bar[XB_TOPGEN], 1u);
            else XB_SPIN(xb_ld(&bar[XB_TOPGEN]) == tg, bar);
            __builtin_amdgcn_fence(__ATOMIC_ACQUIRE, "agent");
            xb_add(&bar[XB_XGEN(b.x)], 1u);
            asm volatile("s_waitcnt vmcnt(0)" ::: "memory");
        } else {
            XB_SPIN(xb_ld(&bar[XB_XGEN(b.x)]) == gen, bar);
            __builtin_amdgcn_fence(__ATOMIC_ACQUIRE, "agent");
            asm volatile("s_waitcnt vmcnt(0)" ::: "memory");
        }
    }
    __syncthreads();
}
constexpr int MISC_OFF = LDS_BYTES - 64;
constexpr size_t CTL_ZERO_BYTES = 65536;

struct Unit { int pm, pn; };
constexpr int NXCD = 8, WGM = 8;
struct StaticOrder {
    int nM, nN, nwg, G, c;
    __device__ void init(int nM_, int nN_, int G_, int c_) { nM = nM_; nN = nN_; nwg = nM * nN; G = G_; c = c_; }
    __device__ bool next(int i, Unit& u) const {
        const long L = (long)i * G + c; if (L >= nwg) return false;
        int wgid = (int)L; { const int q = nwg / NXCD, r = nwg % NXCD, xcd = wgid % NXCD, off = wgid / NXCD; wgid = (xcd < r ? xcd * (q + 1) : r * (q + 1) + (xcd - r) * q) + off; }
        const int nig = WGM * nN, gid = wgid / nig, fm = gid * WGM, gsz = (nM - fm) < WGM ? (nM - fm) : WGM;
        u.pm = fm + ((wgid % nig) % gsz); u.pn = (wgid % nig) / gsz; return true;
    }
};
struct GemmDesc {
    const bf16_t* A; const bf16_t* Bt; int lda, K, nM, nN, a_col_step, moe; size_t b_mat_stride; const int* rowidx; const bf16_t* A2;
    __device__ __forceinline__ int mem_pm(int pm) const { return moe ? ((pm & 15) * 16 + (pm >> 4)) : pm; }
    __device__ __forceinline__ const bf16_t* a_ptr(const Unit& u) const { return A + (size_t)mem_pm(u.pm) * 256 * lda + (size_t)u.pn * a_col_step; }
    __device__ __forceinline__ const bf16_t* a2_ptr(const Unit& u) const { return A2 + (size_t)mem_pm(u.pm) * 256 * lda; }
    __device__ __forceinline__ const bf16_t* b_ptr(const Unit& u) const { return Bt + (moe ? (size_t)(u.pm >> 4) * b_mat_stride : (size_t)0) + (size_t)u.pn * 256 * K; }
};

struct Epi1 { static constexpr bool DUAL = false;
    bf16_t* V; bf16_t* U; bf16_t* Gt; const float* bgate; const float* RS;
    struct Early { float r[8]; };
    __device__ __forceinline__ void early(Early& e, int mpm, int rbase) const {
#pragma unroll
        for (int g = 0; g < 8; ++g) e.r[g] = RS[(size_t)mpm * 256 + 128 * (g >> 2) + 16 * (g & 3) + rbase]; }
    struct Ctx { f32x4 b[4]; }; struct Pre {}; static constexpr int DIST = 0;
    __device__ __forceinline__ void begin(Ctx& c, int mpm, int pn, int c8, int rbase) const { const float* bp = bgate + (pn >= 6 ? 256 * (pn - 6) : 0) + c8;
        c.b[0] = *(const f32x4*)bp; c.b[1] = *(const f32x4*)(bp + 4); c.b[2] = *(const f32x4*)(bp + 128); c.b[3] = *(const f32x4*)(bp + 132); }
    __device__ __forceinline__ void prefetch(Pre&, int, int, int, int) const {}
    __device__ __forceinline__ void finish(const Early& ea, const Ctx& c, const Pre&, int g, int mpm, int pn, int r, int c8, f32x4 a0, f32x4 a1, f32x4 b0, f32x4 b1) const {
        const size_t row = (size_t)mpm * 256 + r; const float rs = ea.r[g]; a0 = a0 * rs; a1 = a1 * rs; b0 = b0 * rs; b1 = b1 * rs;
        if (pn < 4) { store_bf8(V + row * CD + 128 * pn + c8, a0 * sigm4(b0), a1 * sigm4(b1)); }
        else if (pn < 6) { bf16_t* p = U + row * PDIM + 256 * (pn - 4) + c8; store_bf8(p, a0, a1); store_bf8(p + 128, b0, b1); }
        else { bf16_t* p = Gt + row * 2048 + 256 * (pn - 6) + c8; store_bf8(p, sigm4(a0 + c.b[0]), sigm4(a1 + c.b[1])); store_bf8(p + 128, sigm4(b0 + c.b[2]), sigm4(b1 + c.b[3])); }
    }
};
struct Epi23 {
    static constexpr bool DUAL = true;
    const bf16_t* Gt; const float* scale; bf16_t* MG;
    struct TCtx { f32x4 s[4]; }; struct TPre { u32x4 g1[2], g2[2]; };
    __device__ __forceinline__ void t_begin(TCtx& c, int mpm, int pn, int c8) const { const float* sp = scale + 256 * pn + c8;
        c.s[0] = *(const f32x4*)sp; c.s[1] = *(const f32x4*)(sp + 4); c.s[2] = *(const f32x4*)(sp + 128); c.s[3] = *(const f32x4*)(sp + 132); }
    __device__ __forceinline__ void t_prefetch(TPre& p, int mpm, int pn, int r, int c8) const { const bf16_t* gp = Gt + ((size_t)mpm * 256 + r) * 2048 + 256 * pn + c8;
        p.g1[0] = *(const u32x4*)gp; p.g1[1] = *(const u32x4*)(gp + 128); p.g2[0] = *(const u32x4*)(gp + 1024); p.g2[1] = *(const u32x4*)(gp + 1024 + 128); }
    __device__ __forceinline__ static f32x4 ratio4(f32x4 g2, f32x4 sc, f32x4 g1) { f32x4 o;
        o.x = g2.x * sc.x * __builtin_amdgcn_rcpf(fmaxf(g1.x, 1e-30f)); o.y = g2.y * sc.y * __builtin_amdgcn_rcpf(fmaxf(g1.y, 1e-30f));
        o.z = g2.z * sc.z * __builtin_amdgcn_rcpf(fmaxf(g1.z, 1e-30f)); o.w = g2.w * sc.w * __builtin_amdgcn_rcpf(fmaxf(g1.w, 1e-30f)); return o; }
    __device__ __forceinline__ void t_apply(const TCtx& c, const TPre& p, f32x4& a0, f32x4& a1, f32x4& b0, f32x4& b1) const {
        f32x4 o1[4], o2[4]; r16_unpack(o1, p.g1); r16_unpack(o2, p.g2);
        a0 = a0 * ratio4(o2[0], c.s[0], o1[0]); a1 = a1 * ratio4(o2[1], c.s[1], o1[1]); b0 = b0 * ratio4(o2[2], c.s[2], o1[2]); b1 = b1 * ratio4(o2[3], c.s[3], o1[3]);
    }
    struct Early {}; __device__ __forceinline__ void early(Early&, int, int) const {}
    struct Ctx {}; struct Pre { u32x4 g[2]; }; static constexpr int DIST = 2;
    __device__ __forceinline__ void begin(Ctx&, int, int, int, int) const {}
    __device__ __forceinline__ void prefetch(Pre& p, int mpm, int pn, int r, int c8) const { const bf16_t* gp = Gt + ((size_t)mpm * 256 + r) * 2048 + 256 * pn + c8;
        p.g[0] = *(const u32x4*)gp; p.g[1] = *(const u32x4*)(gp + 128); }
    __device__ __forceinline__ void finish(const Early& ea, const Ctx&, const Pre& p, int g, int mpm, int pn, int r, int c8, f32x4 a0, f32x4 a1, f32x4 b0, f32x4 b1) const {
        f32x4 o[4]; r16_unpack(o, p.g); bf16_t* mp = MG + ((size_t)mpm * 256 + r) * DM + 256 * pn + c8;
        store_bf8(mp, o[0] * a0, o[1] * a1); store_bf8(mp + 128, o[2] * b0, o[3] * b1);
    }
};
struct Epi4 { static constexpr bool DUAL = false;
    const bf16_t* X; bf16_t* O;
    struct Early {}; __device__ __forceinline__ void early(Early&, int, int) const {}
    struct Ctx {}; struct Pre { u32x4 x[2]; }; static constexpr int DIST = 2;
    __device__ __forceinline__ void begin(Ctx&, int, int, int, int) const {}
    __device__ __forceinline__ void prefetch(Pre& p, int mpm, int pn, int r, int c8) const { const bf16_t* xp = X + ((size_t)mpm * 256 + r) * DM + 256 * pn + c8;
        p.x[0] = *(const u32x4*)xp; p.x[1] = *(const u32x4*)(xp + 128); }
    __device__ __forceinline__ void finish(const Early& ea, const Ctx&, const Pre& p, int g, int mpm, int pn, int r, int c8, f32x4 a0, f32x4 a1, f32x4 b0, f32x4 b1) const {
        f32x4 o[4]; r16_unpack(o, p.x); bf16_t* op = O + ((size_t)mpm * 256 + r) * DM + 256 * pn + c8; store_bf8(op, o[0] + a0, o[1] + a1); store_bf8(op + 128, o[2] + b0, o[3] + b1);
    }
};
struct Epi5 { static constexpr bool DUAL = false;
    unsigned char* H; const float* RSV;
    struct Early { float r[8]; };
    __device__ __forceinline__ void early(Early& e, int mpm, int rbase) const {
#pragma unroll
        for (int g = 0; g < 8; ++g) e.r[g] = RSV[(size_t)mpm * 256 + 128 * (g >> 2) + 16 * (g & 3) + rbase]; }
    struct Ctx {}; struct Pre {}; static constexpr int DIST = 0;
    __device__ __forceinline__ void begin(Ctx&, int, int, int, int) const {}
    __device__ __forceinline__ void prefetch(Pre&, int, int, int, int) const {}
    __device__ __forceinline__ void finish(const Early& ea, const Ctx& c, const Pre&, int g, int mpm, int pn, int r, int c8, f32x4 a0, f32x4 a1, f32x4 b0, f32x4 b1) const {
        const float rs = ea.r[g]; const f32x4 g0 = a0 * rs, g1 = a1 * rs;
        const f32x4 h0 = g0 * sigm4(g0) * (b0 * rs), h1 = g1 * sigm4(g1) * (b1 * rs); u32x2 w; w.x = pk_fp8x4(h0.x, h0.y, h0.z, h0.w); w.y = pk_fp8x4(h1.x, h1.y, h1.z, h1.w);
        *(u32x2*)(H + ((size_t)mpm * 256 + r) * FF + 128 * pn + c8) = w;
    }
};
struct Epi6 { static constexpr bool DUAL = false;
    const float* VAL; unsigned char* YE;
    __device__ __forceinline__ static unsigned pack_fp8x4(f32x4 v) { int p = __builtin_amdgcn_cvt_pk_fp8_f32(v.x, v.y, 0, false); p = __builtin_amdgcn_cvt_pk_fp8_f32(v.z, v.w, p, true); return (unsigned)p; }
    struct Early { float r[8]; };
    __device__ __forceinline__ void early(Early& e, int mpm, int rbase) const {
#pragma unroll
        for (int g = 0; g < 8; ++g) e.r[g] = VAL[(size_t)mpm * 256 + 128 * (g >> 2) + 16 * (g & 3) + rbase]; }
    struct Ctx {}; struct Pre {}; static constexpr int DIST = 0;
    __device__ __forceinline__ void begin(Ctx&, int, int, int, int) const {}
    __device__ __forceinline__ void prefetch(Pre&, int, int, int, int) const {}
    __device__ __forceinline__ void finish(const Early& ea, const Ctx& c, const Pre&, int g, int mpm, int pn, int r, int c8, f32x4 a0, f32x4 a1, f32x4 b0, f32x4 b1) const {
        const float tv = ea.r[g]; unsigned char* p = YE + ((size_t)mpm * 256 + r) * DM + 256 * pn + c8;
        u32x2 w0, w1; w0.x = pack_fp8x4(a0 * tv); w0.y = pack_fp8x4(a1 * tv); w1.x = pack_fp8x4(b0 * tv); w1.y = pack_fp8x4(b1 * tv);
        *(u32x2*)p = w0; *(u32x2*)(p + 128) = w1;
    }
};
struct Epi7 { static constexpr bool DUAL = false;
    const float* bias; bf16_t* GL; const float* RS;
    struct Early { float r[8]; };
    __device__ __forceinline__ void early(Early& e, int mpm, int rbase) const {
#pragma unroll
        for (int g = 0; g < 8; ++g) e.r[g] = RS[(size_t)mpm * 256 + 128 * (g >> 2) + 16 * (g & 3) + rbase]; }
    struct Ctx { f32x4 b[4]; }; struct Pre {}; static constexpr int DIST = 0;
    __device__ __forceinline__ void begin(Ctx& c, int mpm, int pn, int c8, int rbase) const { const float* bp = bias + 256 * pn + c8;
        c.b[0] = *(const f32x4*)bp; c.b[1] = *(const f32x4*)(bp + 4); c.b[2] = *(const f32x4*)(bp + 128); c.b[3] = *(const f32x4*)(bp + 132); }
    __device__ __forceinline__ void prefetch(Pre&, int, int, int, int) const {}
    __device__ __forceinline__ void finish(const Early& ea, const Ctx& c, const Pre&, int g, int mpm, int pn, int r, int c8, f32x4 a0, f32x4 a1, f32x4 b0, f32x4 b1) const {
        const float rs = ea.r[g]; bf16_t* p = GL + ((size_t)mpm * 256 + r) * DM + 256 * pn + c8;
        store_bf8(p, sigm4(a0 * rs + c.b[0]), sigm4(a1 * rs + c.b[1])); store_bf8(p + 128, sigm4(b0 * rs + c.b[2]), sigm4(b1 * rs + c.b[3]));
    }
};
struct Epi8 { static constexpr bool DUAL = false;
    bf16_t* ER;
    struct Early {}; __device__ __forceinline__ void early(Early&, int, int) const {}
    struct Ctx {}; struct Pre {}; static constexpr int DIST = 0;
    __device__ __forceinline__ void begin(Ctx&, int, int, int, int) const {}
    __device__ __forceinline__ void prefetch(Pre&, int, int, int, int) const {}
    __device__ __forceinline__ void finish(const Early& ea, const Ctx&, const Pre&, int g, int mpm, int pn, int r, int c8, f32x4 a0, f32x4 a1, f32x4 b0, f32x4 b1) const {
        bf16_t* p = ER + ((size_t)mpm * 256 + r) * DM + 256 * pn + c8; store_bf8(p, a0, a1); store_bf8(p + 128, b0, b1);
    }
};

typedef short bf16x8 __attribute__((ext_vector_type(8)));
constexpr int BK = 64, HALF = 128, HTB = HALF * BK * 2, STAGE_BYTES = 8 * HTB;
__device__ __forceinline__ int lds_byte(int r, int c) { const int st = (r >> 4) * 2 + (c >> 5), rr = r & 15, cc = c & 31, ob = rr * 64 + cc * 2; return st * 1024 + (ob ^ (((ob >> 9) & 1) << 5)); }
__device__ __forceinline__ int perm32(int rho) { const int n = rho >> 4, i = rho & 15; return 8 * (i >> 2) + 4 * n + (i & 3); }
__device__ __forceinline__ void stage_rc(int b, int& R, int& C) { const int st = b / 1024, sb = b % 1024, swz = sb ^ (((sb >> 9) & 1) << 5); R = (st >> 1) * 16 + swz / 64; C = (st & 1) * 32 + (swz % 64) / 2; }

typedef int i32x4v __attribute__((ext_vector_type(4)));
typedef int i32x8v __attribute__((ext_vector_type(8)));
template <int MODE> struct AccT { typedef f32x4 type; }; template <> struct AccT<2> { typedef i32x4v type; };
__device__ __forceinline__ f32x4 acc_f32(f32x4 v) { return v; }
__device__ __forceinline__ f32x4 acc_f32(i32x4v v) { return __builtin_convertvector(v, f32x4); }
template <class Epi, bool ALIGN_EPI, bool SP2, bool GATHER, int MODE>
__device__ __forceinline__ void gemm_pg8(LAS unsigned char* lds, const GemmDesc& g, int G, int cidx, const Epi& E) {
    static_assert(SP2, "only the two-MFMA-blocks-per-barrier-pair loop carries the gather / dual-source staging");
    constexpr bool FP8 = (MODE == 1), I8 = (MODE == 2); typedef typename AccT<MODE>::type acc_t;
    int tid_ = threadIdx.x; asm volatile("" : "+v"(tid_));
    const int tid = tid_, wid = __builtin_amdgcn_readfirstlane(tid >> 6), lane = tid & 63, wr = wid >> 2, wc = wid & 3, fr = lane & 15, fq = lane >> 4;
    const int K = g.K, nt = K / BK, lda = g.lda;
    StaticOrder S; S.init(g.nM, g.nN, G, cidx);
    unsigned voffA[2], voffB[2];
    int stR[2], stC[2];
#pragma unroll
    for (int i = 0; i < 2; ++i) { stage_rc(tid * 16 + i * 8192, stR[i], stC[i]); voffA[i] = (unsigned)(stR[i] * lda + stC[i]) * 2u; voffB[i] = (unsigned)(((stR[i] & ~31) + perm32(stR[i] & 31)) * K + stC[i]) * 2u; }
    unsigned cv[2][2], nv[2][2];
#define PG8_ROWOFF(dst, u_) do { const int t_ = g.mem_pm((u_).pm); const int* ix_ = g.rowidx + t_ * 256; const int rb_ = (t_ >> 4) * SEQ; \
        _Pragma("unroll") for (int h_ = 0; h_ < 2; ++h_) _Pragma("unroll") for (int i_ = 0; i_ < 2; ++i_) dst[h_][i_] = (unsigned)((rb_ + ix_[128 * h_ + stR[i_]]) * lda + stC[i_]) * 2u; } while (0)
#define PG8_STAGE_A(bufoff, half, ptr, isnext) do { if constexpr (GATHER) { _Pragma("unroll") for (int _i = 0; _i < 2; ++_i) { const unsigned vo_ = (isnext) ? nv[half][_i] : cv[half][_i]; \
        __builtin_amdgcn_global_load_lds((const unsigned*)((const char*)(ptr) + vo_), (LAS unsigned*)(lds + (bufoff) + ldsw + _i * 8192), 16, 0, 0); } } \
        else { PG8_STAGE(bufoff, (ptr) + (half) * hstepA, voffA); } } while (0)
    const size_t kstep = (size_t)(BK * 2);
    const size_t hstepA = (size_t)HALF * lda * 2, hstepB = (size_t)HALF * K * 2;
    const unsigned ldsw = (unsigned)wid * 1024u;
    const int aoff = lds_byte(wr * 64 + fr, fq * 8), boff = lds_byte(wc * 32 + fr, fq * 8);
#define PG8_SA(b, h) (((b) * 2 + (h)) * HTB)
#define PG8_SB(b, h) ((4 + (b) * 2 + (h)) * HTB)
#define PG8_STAGE(bufoff, gbase, voff) do { _Pragma("unroll") for (int _i = 0; _i < 2; ++_i) \
        __builtin_amdgcn_global_load_lds((const unsigned*)((const char*)(gbase) + (voff)[_i]), (LAS unsigned*)(lds + (bufoff) + ldsw + _i * 8192), 16, 0, 0); } while (0)
#define PG8_LDA(dst, b, h) do { _Pragma("unroll") for (int m = 0; m < 4; ++m) _Pragma("unroll") for (int k = 0; k < 2; ++k) dst[m][k] = *(const LAS bf16x8*)(lds + PG8_SA(b, h) + aoff + m * 2048 + k * 1024); } while (0)
#define PG8_LDB(dst, b, h) do { _Pragma("unroll") for (int n = 0; n < 2; ++n) _Pragma("unroll") for (int k = 0; k < 2; ++k) dst[n][k] = *(const LAS bf16x8*)(lds + PG8_SB(b, h) + boff + n * 2048 + k * 1024); } while (0)
#define PG8_CAT(x) __builtin_shufflevector((i32x4v)(x)[0], (i32x4v)(x)[1], 0, 1, 2, 3, 4, 5, 6, 7)
#define PG8_MMA(ai, bj, At, Bt) do { __builtin_amdgcn_s_setprio(1); _Pragma("unroll") for (int m = 0; m < 4; ++m) _Pragma("unroll") for (int n = 0; n < 2; ++n) { \
        if constexpr (FP8) { const i32x8v b8_ = PG8_CAT(Bt[n]), a8_ = PG8_CAT(At[m]); asm volatile("v_mfma_scale_f32_16x16x128_f8f6f4 %0, %1, %2, %0, %3, %3 op_sel_hi:[0,0,0]" : "+v"(acc[ai][bj][m][n]) : "v"(b8_), "v"(a8_), "v"(sc127)); } \
        else if constexpr (I8) { _Pragma("unroll") for (int k = 0; k < 2; ++k) acc[ai][bj][m][n] = __builtin_amdgcn_mfma_i32_16x16x64_i8((i32x4v)Bt[n][k], (i32x4v)At[m][k], acc[ai][bj][m][n], 0, 0, 0); } \
        else { _Pragma("unroll") for (int k = 0; k < 2; ++k) acc[ai][bj][m][n] = __builtin_amdgcn_mfma_f32_16x16x32_bf16(Bt[n][k], At[m][k], acc[ai][bj][m][n], 0, 0, 0); } } __builtin_amdgcn_s_setprio(0); } while (0)
#define PG8_WAIT_V(n) asm volatile("s_waitcnt vmcnt(" #n ")" ::: "memory")
#define PG8_WAIT_L(n) asm volatile("s_waitcnt lgkmcnt(" #n ")" ::: "memory")
#define PG8_BAR __builtin_amdgcn_s_barrier()
#define PG8_SCHED __builtin_amdgcn_sched_barrier(0)
    Unit cur, nxt; int ui = 0;
    if (!S.next(0, cur)) return;
    acc_t acc[2][2][4][2];
#pragma unroll
    for (int a = 0; a < 2; ++a)
#pragma unroll
        for (int b = 0; b < 2; ++b)
#pragma unroll
            for (int m = 0; m < 4; ++m)
#pragma unroll
                for (int n = 0; n < 2; ++n) acc[a][b][m][n] = (acc_t){0, 0, 0, 0};
    bf16x8 At[4][2], B0[2][2], B1[2][2];
    int sc127 = 0x7f7f7f7f; asm volatile("" : "+v"(sc127));
    const char* cA = GATHER ? (const char*)g.A : (const char*)g.a_ptr(cur); const char* cB = (const char*)g.b_ptr(cur);
    const char* cA2 = cA; if constexpr (Epi::DUAL) cA2 = (const char*)g.a2_ptr(cur) - 2 * kstep;
    typename Epi::Early ea; E.early(ea, g.mem_pm(cur.pm), 64 * wr + fr);
    if constexpr (GATHER) {
        PG8_ROWOFF(cv, cur);
        if (S.next(1, nxt)) PG8_ROWOFF(nv, nxt); else { _Pragma("unroll") for (int h_ = 0; h_ < 2; ++h_) _Pragma("unroll") for (int i_ = 0; i_ < 2; ++i_) nv[h_][i_] = cv[h_][i_]; }
        asm volatile("" : "+v"(cv[0][0]), "+v"(cv[0][1]), "+v"(cv[1][0]), "+v"(cv[1][1]), "+v"(nv[0][0]), "+v"(nv[0][1]), "+v"(nv[1][0]), "+v"(nv[1][1]));
    }
    if constexpr (SP2) {
        PG8_STAGE(PG8_SB(0, 0), cB, voffB); PG8_STAGE(PG8_SB(0, 1), cB + hstepB, voffB); PG8_STAGE_A(PG8_SA(0, 0), 0, cA, false); PG8_STAGE_A(PG8_SA(0, 1), 1, cA, false);
        if (wr == 1) PG8_BAR;
        PG8_WAIT_V(2); PG8_BAR;
        PG8_STAGE(PG8_SB(1, 0), cB + kstep, voffB); PG8_STAGE_A(PG8_SA(1, 0), 0, cA + kstep, false); PG8_STAGE(PG8_SB(1, 1), cB + hstepB + kstep, voffB);
        PG8_WAIT_V(6); PG8_BAR;
    }
    for (;;) {
        const bool has_next = S.next(ui + 1, nxt);
        const char* nA = GATHER ? cA : (has_next ? (const char*)g.a_ptr(nxt) : cA); const char* nB = has_next ? (const char*)g.b_ptr(nxt) : cB;
        const char* nA2 = cA2; if constexpr (Epi::DUAL) { if (has_next) nA2 = (const char*)g.a2_ptr(nxt) - 2 * kstep; }
        for (int t = 0; t < nt; t += 2) {
            const bool last = (t == nt - 2);
            const char* a1 = ((Epi::DUAL && t >= 2) ? cA2 : cA) + (size_t)(t + 1) * kstep;
            const char* a2 = last ? nA : (Epi::DUAL ? cA2 : cA) + (size_t)(t + 2) * kstep; const char* b2 = last ? nB : cB + (size_t)(t + 2) * kstep;
            const char* a3 = a2 + kstep; const char* b3 = b2 + kstep;
            if constexpr (SP2) {
            PG8_LDB(B0, 0, 0); PG8_LDB(B1, 0, 1); PG8_SCHED; PG8_LDA(At, 0, 0); PG8_STAGE_A(PG8_SA(1, 1), 1, a1, false);
            PG8_WAIT_V(8); PG8_WAIT_L(0); PG8_BAR; PG8_MMA(0, 0, At, B0); PG8_MMA(0, 1, At, B1); PG8_BAR; PG8_SCHED;
            PG8_LDA(At, 0, 1); PG8_STAGE(PG8_SB(0, 0), b2, voffB); PG8_STAGE(PG8_SB(0, 1), b2 + hstepB, voffB); PG8_STAGE_A(PG8_SA(0, 0), 0, a2, last);
            PG8_WAIT_V(8); PG8_WAIT_L(0); PG8_BAR; PG8_MMA(1, 0, At, B0); PG8_MMA(1, 1, At, B1); PG8_BAR; PG8_SCHED;
            PG8_LDB(B0, 1, 0); PG8_LDB(B1, 1, 1); PG8_SCHED; PG8_LDA(At, 1, 0); PG8_STAGE_A(PG8_SA(0, 1), 1, a2, last);
            PG8_WAIT_V(8); PG8_WAIT_L(0); PG8_BAR; PG8_MMA(0, 0, At, B0); PG8_MMA(0, 1, At, B1); PG8_BAR; PG8_SCHED;
            PG8_LDA(At, 1, 1); PG8_STAGE(PG8_SB(1, 0), b3, voffB); PG8_STAGE(PG8_SB(1, 1), b3 + hstepB, voffB); PG8_STAGE_A(PG8_SA(1, 0), 0, a3, last);
            PG8_WAIT_V(8); PG8_WAIT_L(0); PG8_BAR; PG8_MMA(1, 0, At, B0); PG8_MMA(1, 1, At, B1); PG8_BAR; PG8_SCHED;
            }
            if constexpr (Epi::DUAL && MODE == 0) { if (t == 0) {
                const int mpm_t = g.mem_pm(cur.pm); int fr_t = fr, fq_t = fq; asm volatile("" : "+v"(fr_t), "+v"(fq_t));
                const int rbase = 64 * wr + fr_t, c8 = 32 * wc + 8 * fq_t, pn_ = cur.pn;
                typename Epi::TCtx tc; E.t_begin(tc, mpm_t, pn_, c8);
                typename Epi::TPre tp[3];
                E.t_prefetch(tp[0], mpm_t, pn_, rbase, c8); E.t_prefetch(tp[1], mpm_t, pn_, 16 + rbase, c8);
#pragma unroll
                for (int gi = 0; gi < 8; ++gi) {
                    if (gi + 2 < 8) { const int gn = gi + 2; E.t_prefetch(tp[gn % 3], mpm_t, pn_, 128 * (gn >> 2) + 16 * (gn & 3) + rbase, c8); }
                    E.t_apply(tc, tp[gi % 3], acc[gi >> 2][0][gi & 3][0], acc[gi >> 2][0][gi & 3][1], acc[gi >> 2][1][gi & 3][0], acc[gi >> 2][1][gi & 3][1]);
                    __builtin_amdgcn_sched_barrier(0);
                }
            } }
        }
        if constexpr (FP8) asm volatile("s_nop 15\n\ts_nop 15" ::: "memory");
        if constexpr (ALIGN_EPI) { if (wr == 0) PG8_BAR; }
        {
            const int mpm = g.mem_pm(cur.pm);
            int fr_e = fr, fq_e = fq; asm volatile("" : "+v"(fr_e), "+v"(fq_e));
            const int rbase = 64 * wr + fr_e, c8 = 32 * wc + 8 * fq_e, pn_ = cur.pn;
            typename Epi::Ctx ctx; E.begin(ctx, mpm, pn_, c8, rbase);
            typename Epi::Pre pre[3];
            if constexpr (Epi::DIST > 0) { E.prefetch(pre[0], mpm, pn_, rbase, c8); if constexpr (Epi::DIST > 1) E.prefetch(pre[1], mpm, pn_, 16 + rbase, c8); }
#pragma unroll
            for (int gi = 0; gi < 8; ++gi) {
                if constexpr (Epi::DIST > 0) { if (gi + Epi::DIST < 8) { const int gn = gi + Epi::DIST; E.prefetch(pre[gn % 3], mpm, pn_, 128 * (gn >> 2) + 16 * (gn & 3) + rbase, c8); } }
                E.finish(ea, ctx, pre[gi % 3], gi, mpm, pn_, 128 * (gi >> 2) + 16 * (gi & 3) + rbase, c8, acc_f32(acc[gi >> 2][0][gi & 3][0]), acc_f32(acc[gi >> 2][0][gi & 3][1]), acc_f32(acc[gi >> 2][1][gi & 3][0]), acc_f32(acc[gi >> 2][1][gi & 3][1]));
                __builtin_amdgcn_sched_barrier(0);
            }
        }
        if (!has_next) break;
        if constexpr (GATHER) {
            _Pragma("unroll") for (int h_ = 0; h_ < 2; ++h_) _Pragma("unroll") for (int i_ = 0; i_ < 2; ++i_) cv[h_][i_] = nv[h_][i_];
            Unit nn; if (S.next(ui + 2, nn)) { PG8_ROWOFF(nv, nn); }
            asm volatile("" : "+v"(nv[0][0]), "+v"(nv[0][1]), "+v"(nv[1][0]), "+v"(nv[1][1]));
        }
#pragma unroll
        for (int a = 0; a < 2; ++a)
#pragma unroll
            for (int b = 0; b < 2; ++b)
#pragma unroll
                for (int m = 0; m < 4; ++m)
#pragma unroll
                    for (int n = 0; n < 2; ++n) acc[a][b][m][n] = (acc_t){0, 0, 0, 0};
        cur = nxt; cA = nA; cB = nB; cA2 = nA2; ++ui;
        E.early(ea, g.mem_pm(cur.pm), 64 * wr + fr);
        if constexpr (ALIGN_EPI) { if (wr == 1) PG8_BAR; }
    }
    PG8_WAIT_V(0);
    if constexpr (!ALIGN_EPI) { if (wr == 0) PG8_BAR; }
    PG8_BAR;
#undef PG8_SA
#undef PG8_SB
#undef PG8_STAGE
#undef PG8_STAGE_A
#undef PG8_ROWOFF
#undef PG8_LDA
#undef PG8_LDB
#undef PG8_MMA
#undef PG8_CAT
#undef PG8_WAIT_V
#undef PG8_WAIT_L
#undef PG8_BAR
#undef PG8_SCHED
}

template <int ID, class Epi>
__device__ __forceinline__ void gemm_phase(LAS unsigned char* lds, const GemmDesc& g, int G, int cidx, const Epi& E) { gemm_pg8<Epi, true, true, ID == 5, ID == 6 ? 1 : ((ID == 1 || ID == 5 || ID == 7) ? 2 : 0)>(lds, g, G, cidx, E); }

struct Args { const float* in[24]; float* out; unsigned char* ws; };
enum { I_X = 0, I_P, I_N1G, I_WIN, I_BGATE, I_CONVW, I_CONVB, I_LNG, I_LNB, I_WCO, I_WPOOL, I_PSCALE, I_WOUT, I_N2G, I_WR, I_WEG, I_WEU, I_WED, I_N3G, I_WPG, I_BPG, I_WPLE, I_PNG, I_FG };

struct TrItem { const float* W; bf16_t* WT; const float* kscale; int K, N, k0, n0, drow0, ldt, kofs, f8; };
__device__ __forceinline__ void tr_load(const TrItem& t, f32x4 (&v)[16], float (&ks)[16], int lane) {
    const int cq = 4 * (lane & 15), rq = lane >> 4;
#pragma unroll
    for (int i = 0; i < 16; ++i) v[i] = __builtin_nontemporal_load((const f32x4*)(t.W + (size_t)(t.k0 + 4 * i + rq) * t.N + t.n0 + cq));
    const float* kp = t.kscale ? t.kscale : t.W;
#pragma unroll
    for (int i = 0; i < 16; ++i) ks[i] = kp[t.k0 + 4 * i + rq];
}
__device__ __forceinline__ void tr_store(const TrItem& t, const f32x4 (&v)[16], const float (&ks)[16], LAS float* scr, int lane) {
    const int cq = 4 * (lane & 15), rq = lane >> 4; const bool sc = t.kscale != nullptr; const float mul = t.f8 == 1 ? W8_SCALE : (t.f8 == 2 ? WQ_SCALE : 1.0f);
#pragma unroll
    for (int i = 0; i < 16; ++i) { const float f = (sc ? ks[i] : 1.0f) * mul; LAS float* p = scr + (4 * i + rq) * 65 + cq; p[0] = v[i].x * f; p[1] = v[i].y * f; p[2] = v[i].z * f; p[3] = v[i].w * f; }
    LDS_WAIT();
    if (t.f8) {
        const int c4 = lane & 3; unsigned char* W8 = (unsigned char*)t.WT;
#pragma unroll
        for (int j = 0; j < 4; ++j) { const int n = (lane >> 2) + 16 * j; const LAS float* sp = scr + (16 * c4) * 65 + n; u32x4 o;
            if (t.f8 == 1) { o.x = pk_fp8x4(sp[0 * 65], sp[1 * 65], sp[2 * 65], sp[3 * 65]); o.y = pk_fp8x4(sp[4 * 65], sp[5 * 65], sp[6 * 65], sp[7 * 65]);
                o.z = pk_fp8x4(sp[8 * 65], sp[9 * 65], sp[10 * 65], sp[11 * 65]); o.w = pk_fp8x4(sp[12 * 65], sp[13 * 65], sp[14 * 65], sp[15 * 65]); }
            else { o.x = q8x4(clamp127(sp[0 * 65]), clamp127(sp[1 * 65]), clamp127(sp[2 * 65]), clamp127(sp[3 * 65])); o.y = q8x4(clamp127(sp[4 * 65]), clamp127(sp[5 * 65]), clamp127(sp[6 * 65]), clamp127(sp[7 * 65]));
                o.z = q8x4(clamp127(sp[8 * 65]), clamp127(sp[9 * 65]), clamp127(sp[10 * 65]), clamp127(sp[11 * 65])); o.w = q8x4(clamp127(sp[12 * 65]), clamp127(sp[13 * 65]), clamp127(sp[14 * 65]), clamp127(sp[15 * 65])); }
            __builtin_nontemporal_store(o, (u32x4*)(W8 + (size_t)(t.drow0 + n) * t.ldt + t.kofs + t.k0 + 16 * c4)); }
        LDS_WAIT(); return;
    }
    const int c = lane & 7;
#pragma unroll
    for (int j = 0; j < 8; ++j) { const int n = (lane >> 3) + 8 * j; const LAS float* sp = scr + (8 * c) * 65 + n;
        u32x4 o; o.x = pk2(sp[0 * 65], sp[1 * 65]); o.y = pk2(sp[2 * 65], sp[3 * 65]); o.z = pk2(sp[4 * 65], sp[5 * 65]); o.w = pk2(sp[6 * 65], sp[7 * 65]);
        __builtin_nontemporal_store(o, (u32x4*)(t.WT + (size_t)(t.drow0 + n) * t.ldt + t.kofs + t.k0 + 8 * c)); }
    LDS_WAIT();
}
constexpr int IT_WIN = (DM / 64) * (INC / 64);
constexpr int IT_WC = (CD / 64) * (DM / 64);
constexpr int IT_WP = 4 * (128 / 64) * (256 / 64);
constexpr int IT_SQ = (DM / 64) * (DM / 64);
constexpr int IT_WPLE = (PLE / 64) * (DM / 64);
constexpr int IT_EXP = NE * IT_SQ;
constexpr int IT_TOTAL = IT_WIN + IT_WC + IT_WP + IT_SQ + IT_SQ + IT_WPLE + 3 * IT_EXP;
constexpr int IT_SMALL = IT_TOTAL - 3 * IT_EXP;
constexpr int IT_P1 = 4608;
__device__ __forceinline__ TrItem tr_decode(const Args& a, int it) {
    unsigned char* ws = a.ws; TrItem t; t.kscale = nullptr; t.f8 = 0;
    int r = it;
    if (r < IT_WIN) {
        const int nblk = INC / 64, kb = r / nblk, nb = r % nblk, n0 = 64 * nb; int d0;
        if (n0 < 512) d0 = 256 * (n0 >> 7) + (n0 & 127); else if (n0 < 1024) d0 = 256 * ((n0 - 512) >> 7) + 128 + (n0 & 127); else d0 = n0;
        t.W = a.in[I_WIN]; t.WT = (bf16_t*)(ws + WS_WIN); t.K = DM; t.N = INC; t.k0 = 64 * kb; t.n0 = n0; t.drow0 = d0; t.kscale = a.in[I_N1G]; t.ldt = t.K; t.kofs = 0; t.f8 = 2; return t; }
    r -= IT_WIN;
    if (r < IT_WC) { const int kb = r / 16, nb = r % 16; t.W = a.in[I_WCO]; t.WT = (bf16_t*)(ws + WS_WCAT); t.K = CD; t.N = DM; t.k0 = 64 * kb; t.n0 = 64 * nb; t.drow0 = 64 * nb; t.ldt = 640; t.kofs = 128; return t; }
    r -= IT_WC;
    if (r < IT_WP) { const int gi = r / 8, q = r % 8, kb = q / 4, nb = q % 4;
        t.W = a.in[I_WPOOL] + (size_t)gi * 128 * 256; t.WT = (bf16_t*)(ws + WS_WCAT); t.K = 128; t.N = 256; t.k0 = 64 * kb; t.n0 = 64 * nb; t.drow0 = 256 * gi + 64 * nb; t.ldt = 640; t.kofs = 0; return t; }
    r -= IT_WP;
    if (r < IT_SQ) { const int kb = r / 16, nb = r % 16; t.W = a.in[I_WOUT]; t.WT = (bf16_t*)(ws + WS_WOUT); t.K = DM; t.N = DM; t.k0 = 64 * kb; t.n0 = 64 * nb; t.drow0 = 64 * nb; t.ldt = t.K; t.kofs = 0; return t; }
    r -= IT_SQ;
    if (r < IT_SQ) { const int kb = r / 16, nb = r % 16; t.W = a.in[I_WPG]; t.WT = (bf16_t*)(ws + WS_WPG); t.K = DM; t.N = DM; t.k0 = 64 * kb; t.n0 = 64 * nb; t.drow0 = 64 * nb; t.kscale = a.in[I_N3G]; t.ldt = t.K; t.kofs = 0; t.f8 = 2; return t; }
    r -= IT_SQ;
    if (r < IT_WPLE) { const int kb = r / 16, nb = r % 16; t.W = a.in[I_WPLE]; t.WT = (bf16_t*)(ws + WS_WPLE); t.K = PLE; t.N = DM; t.k0 = 64 * kb; t.n0 = 64 * nb; t.drow0 = 64 * nb; t.ldt = t.K; t.kofs = 0; return t; }
    r -= IT_WPLE;
    if (r < IT_EXP) { const int e = r / IT_SQ, q = r % IT_SQ, kb = q / 16, nb = q % 16, n0 = 64 * nb;
        t.W = a.in[I_WEG] + (size_t)e * DM * FF; t.WT = (bf16_t*)(ws + WS_WGU + (size_t)e * 2048 * DM); t.K = DM; t.N = FF; t.k0 = 64 * kb; t.n0 = n0; t.drow0 = 256 * (n0 >> 7) + (n0 & 127); t.kscale = a.in[I_N2G]; t.ldt = t.K; t.kofs = 0; t.f8 = 2; return t; }
    r -= IT_EXP;
    if (r < IT_EXP) { const int e = r / IT_SQ, q = r % IT_SQ, kb = q / 16, nb = q % 16, n0 = 64 * nb;
        t.W = a.in[I_WEU] + (size_t)e * DM * FF; t.WT = (bf16_t*)(ws + WS_WGU + (size_t)e * 2048 * DM); t.K = DM; t.N = FF; t.k0 = 64 * kb; t.n0 = n0; t.drow0 = 256 * (n0 >> 7) + 128 + (n0 & 127); t.kscale = a.in[I_N2G]; t.ldt = t.K; t.kofs = 0; t.f8 = 2; return t; }
    r -= IT_EXP;
    { const int e = r / IT_SQ, q = r % IT_SQ, kb = q / 16, nb = q % 16;
        t.W = a.in[I_WED] + (size_t)e * FF * DM; t.WT = (bf16_t*)(ws + WS_WD + (size_t)e * DM * FF); t.K = FF; t.N = DM; t.k0 = 64 * kb; t.n0 = 64 * nb; t.drow0 = 64 * nb; t.ldt = t.K; t.kofs = 0; t.f8 = 1; return t; }
}
__device__ __forceinline__ void phase0(const Args& a, LAS unsigned char* lds, int gw, int NGW, int wave, int lane, int lo1, int n1, int lo2, int n2, bool do_rows) {
    unsigned char* ws = a.ws;
    LAS float* scr = (LAS float*)(lds + wave * 16640);
    {
        f32x4 v[16], vn[16]; float ks[16], ksn[16]; TrItem cur, nxt;
        const int nj = n1 + n2;
#define P0_JOB(j) ((j) < n1 ? lo1 + (j) : lo2 + ((j) - n1))
        int j = gw;
        if (j < nj) { cur = tr_decode(a, P0_JOB(j)); tr_load(cur, v, ks, lane); }
        for (; j < nj; j += NGW) {
            const bool has_next = j + NGW < nj;
            if (has_next) { nxt = tr_decode(a, P0_JOB(j + NGW)); tr_load(nxt, vn, ksn, lane); }
            tr_store(cur, v, ks, scr, lane);
            if (has_next) { cur = nxt;
#pragma unroll
                for (int i = 0; i < 16; ++i) { v[i] = vn[i]; ks[i] = ksn[i]; } }
        }
#undef P0_JOB
    }
    if (!do_rows) return;
    const float* x = a.in[I_X]; bf16_t* XN = (bf16_t*)(ws + WS_XN); float* RS0 = (float*)(ws + WS_RSTD0); unsigned char* XQ = ws + WS_XQ;
    f32x4 nx[4];
#define P0_ISSUE(mrow) do { _Pragma("unroll") for (int j = 0; j < 2; ++j) { nx[2 * j] = __builtin_nontemporal_load((const f32x4*)(x + (size_t)(mrow) * DM + 512 * j + 8 * lane)); nx[2 * j + 1] = __builtin_nontemporal_load((const f32x4*)(x + (size_t)(mrow) * DM + 512 * j + 8 * lane + 4)); } } while (0)
    if (gw < NT) P0_ISSUE(gw);
    for (int m = gw; m < NT; m += NGW) {
        f32x4 v[4]; float s = 0.f, mx = 0.f;
#pragma unroll
        for (int j = 0; j < 4; ++j) { v[j] = nx[j]; s += (v[j].x * v[j].x + v[j].y * v[j].y) + (v[j].z * v[j].z + v[j].w * v[j].w);
            mx = fmaxf(fmaxf(mx, fmaxf(fabsf(v[j].x), fabsf(v[j].y))), fmaxf(fabsf(v[j].z), fabsf(v[j].w))); }
        if (m + NGW < NT) P0_ISSUE(m + NGW);
        const float rstd = rsqrtf(wave_sum(s) * (1.0f / DM) + EPS);
#pragma unroll
        for (int o = 1; o < 64; o <<= 1) mx = fmaxf(mx, __shfl_xor(mx, o));
        mx = fmaxf(mx, 1e-30f); const float qs = 127.0f * __builtin_amdgcn_rcpf(mx);
        if (lane == 0) RS0[m] = rstd * (mx * (1.0f / 127.0f)) * WQ_INV;
#pragma unroll
        for (int j = 0; j < 2; ++j) { store_bf8(XN + (size_t)m * DM + 512 * j + 8 * lane, v[2 * j], v[2 * j + 1]);
            u32x2 q; q.x = q8x4s(v[2 * j], qs); q.y = q8x4s(v[2 * j + 1], qs);
            *(u32x2*)(XQ + (size_t)m * DM + 512 * j + 8 * lane) = q; }
    }
#undef P0_ISSUE
}

template <int HALF>
__device__ __forceinline__ void pool_unit(const LAS unsigned* Us, bf16_t* PDo, int th, int cp, int t0, int s0) {
    constexpr int NR = 7 + 2 * HALF;
    float r0[NR], r1[NR];
#pragma unroll
    for (int i = 0; i < NR; ++i) { const unsigned pu = Us[(8 * th + 8 - HALF + i) * 256 + cp]; r0[i] = bf_lo(pu); r1[i] = bf_hi(pu); }
    float p0 = 0.f, p1 = 0.f;
#pragma unroll
    for (int i = 0; i < 2 * HALF; ++i) { p0 += r0[i]; p1 += r1[i]; }
#pragma unroll
    for (int j = 0; j < 8; ++j) {
        const int s = s0 + 8 * th + j;
        const int lo = (s - HALF) > 0 ? (s - HALF) : 0, hi = (s + HALF - 1) < (SEQ - 1) ? (s + HALF - 1) : (SEQ - 1);
        const float inv = __builtin_amdgcn_rcpf((float)(hi - lo + 1));
        *(unsigned*)(PDo + ((size_t)(t0 + 8 * th + j)) * PDIM + 2 * cp) = pk2(p0 * inv - r0[j + HALF], p1 * inv - r1[j + HALF]);
        if (j < 7) { p0 += r0[j + 2 * HALF] - r0[j]; p1 += r1[j + 2 * HALF] - r1[j]; }
    }
}
__device__ __forceinline__ float wave_reduce16(const float (&v)[16], int lane) {
    float t8[8], t4[4], t2[2], t1;
    const bool b5 = (lane & 32) != 0, b4 = (lane & 16) != 0, b3 = (lane & 8) != 0, b2 = (lane & 4) != 0;
#pragma unroll
    for (int i = 0; i < 8; ++i) { const float send = b5 ? v[i] : v[i + 8], keep = b5 ? v[i + 8] : v[i]; t8[i] = keep + __shfl_xor(send, 32); }
#pragma unroll
    for (int i = 0; i < 4; ++i) { const float send = b4 ? t8[i] : t8[i + 4], keep = b4 ? t8[i + 4] : t8[i]; t4[i] = keep + __shfl_xor(send, 16); }
#pragma unroll
    for (int i = 0; i < 2; ++i) { const float send = b3 ? t4[i] : t4[i + 2], keep = b3 ? t4[i + 2] : t4[i]; t2[i] = keep + __shfl_xor(send, 8); }
    { const float send = b2 ? t2[0] : t2[1], keep = b2 ? t2[1] : t2[0]; t1 = keep + __shfl_xor(send, 4); }
    t1 += __shfl_xor(t1, 2); t1 += __shfl_xor(t1, 1);
    return t1;
}
__device__ __forceinline__ void phase2(const Args& a, LAS unsigned char* lds, int G, int cidx) {
    unsigned char* ws = a.ws;
    const bf16_t* V = (const bf16_t*)(ws + WS_V); const bf16_t* U = (const bf16_t*)(ws + WS_U);
    bf16_t* CS = (bf16_t*)(ws + WS_CS); bf16_t* PDo = (bf16_t*)(ws + WS_PD);
    LAS unsigned* Vs = (LAS unsigned*)lds;
    LAS unsigned* Us = Vs + 46 * 256;
    LAS float* red = (LAS float*)(Us + 31 * 256);
    int tid_ = threadIdx.x; asm volatile("" : "+v"(tid_));
    const int tid = tid_, cp = tid & 255, th = tid >> 8, wave = tid >> 6, lane = tid & 63;
    float w0[CWID], w1[CWID];
#pragma unroll
    for (int k = 0; k < CWID; ++k) { typedef float f32x2_ __attribute__((ext_vector_type(2))); const f32x2_ wv = *(const f32x2_*)(a.in[I_CONVW] + k * CD + 2 * cp); w0[k] = wv.x; w1[k] = wv.y; }
    const float cb0 = a.in[I_CONVB][2 * cp], cb1 = a.in[I_CONVB][2 * cp + 1];
    const float lg0 = a.in[I_LNG][2 * cp], lg1 = a.in[I_LNG][2 * cp + 1], lb0 = a.in[I_LNB][2 * cp], lb1 = a.in[I_LNB][2 * cp + 1];
    float cb0_ = cb0, cb1_ = cb1, lg0_ = lg0, lg1_ = lg1, lb0_ = lb0, lb1_ = lb1;
#pragma unroll
    for (int k = 0; k < CWID; ++k) asm volatile("" : "+v"(w0[k]), "+v"(w1[k]));
    asm volatile("" : "+v"(cb0_), "+v"(cb1_), "+v"(lg0_), "+v"(lg1_), "+v"(lb0_), "+v"(lb1_));
    const int grp = cp >> 6;
    const int NU = NT / 16, per = (NU + G - 1) / G;
    const int u_begin = cidx * per, u_end = (u_begin + per) < NU ? (u_begin + per) : NU;
    u32x4 pre[10];
#define P2_FETCH(unit) do { const int t0_ = (unit) * 16, b_ = t0_ / SEQ, s0_ = t0_ % SEQ; \
    _Pragma("unroll") for (int i = 0; i < 6; ++i) { const int q = tid + NTHREADS * i, r = (q >> 6) < 45 ? (q >> 6) : 45, ch = q & 63, sq = s0_ - 15 + r; \
        const int sc = sq < 0 ? 0 : (sq > SEQ - 1 ? SEQ - 1 : sq);     \
        pre[i] = *(const u32x4*)(V + ((size_t)(b_ * SEQ + sc)) * CD + ch * 8); } \
    _Pragma("unroll") for (int i = 0; i < 4; ++i) { const int q = tid + NTHREADS * i, r = (q >> 6) < 30 ? (q >> 6) : 30, ch = q & 63, sq = s0_ - 8 + r; \
        const int sc = sq < 0 ? 0 : (sq > SEQ - 1 ? SEQ - 1 : sq); \
        pre[6 + i] = *(const u32x4*)(U + ((size_t)(b_ * SEQ + sc)) * PDIM + ch * 8); } } while (0)
    if (u_begin < u_end) P2_FETCH(u_begin);
    for (int unit = u_begin; unit < u_end; ++unit) {
        const int t0 = unit * 16, s0 = t0 % SEQ;
        __syncthreads();
#pragma unroll
        for (int i = 0; i < 6; ++i) { const int q = tid + NTHREADS * i, sq = s0 - 15 + (q >> 6); const unsigned msk = (sq >= 0 && sq < SEQ) ? 0xffffffffu : 0u;
            if (q < 46 * 64) *(LAS u32x4*)(Vs + (q >> 6) * 256 + (q & 63) * 4) = (u32x4){pre[i].x & msk, pre[i].y & msk, pre[i].z & msk, pre[i].w & msk}; }
#pragma unroll
        for (int i = 0; i < 4; ++i) { const int q = tid + NTHREADS * i, sq = s0 - 8 + (q >> 6); const unsigned msk = (sq >= 0 && sq < SEQ) ? 0xffffffffu : 0u;
            if (q < 31 * 64) *(LAS u32x4*)(Us + (q >> 6) * 256 + (q & 63) * 4) = (u32x4){pre[6 + i].x & msk, pre[6 + i].y & msk, pre[6 + i].z & msk, pre[6 + i].w & msk}; }
        __syncthreads();
        if (unit + 1 < u_end) P2_FETCH(unit + 1);
        float a0[8], a1[8];
        {
            typedef float f32x2_ __attribute__((ext_vector_type(2)));
            f32x2_ ac[8];
#pragma unroll
            for (int j = 0; j < 8; ++j) ac[j] = (f32x2_){cb0_, cb1_};
            unsigned rowv[38];
#pragma unroll
            for (int r = 0; r < 38; ++r) rowv[r] = Vs[(8 * th + r) * 256 + cp];
            __builtin_amdgcn_sched_barrier(0);
#pragma unroll
            for (int r = 0; r < 38; ++r) {
                const f32x2_ xv = (f32x2_){bf_lo(rowv[r]), bf_hi(rowv[r])};
#pragma unroll
                for (int j = 0; j < 8; ++j) { const int k = r - j; if (k >= 0 && k < CWID) ac[j] = __builtin_elementwise_fma(xv, (f32x2_){w0[k], w1[k]}, ac[j]); }
            }
#pragma unroll
            for (int j = 0; j < 8; ++j) { a0[j] = ac[j].x; a1[j] = ac[j].y; }
        }
        float sv[16];
#pragma unroll
        for (int j = 0; j < 8; ++j) { sv[j] = a0[j] + a1[j]; sv[8 + j] = a0[j] * a0[j] + a1[j] * a1[j]; }
        const float tot = wave_reduce16(sv, lane);
        if ((lane & 3) == 0) red[wave * 16 + (lane >> 2)] = tot;
        __syncthreads();
#pragma unroll
        for (int j = 0; j < 8; ++j) {
            float t1 = 0.f, t2 = 0.f;
#pragma unroll
            for (int w = 0; w < 4; ++w) { t1 += red[(4 * th + w) * 16 + j]; t2 += red[(4 * th + w) * 16 + 8 + j]; }
            const float mean = t1 * (1.0f / CD); float var = t2 * (1.0f / CD) - mean * mean; var = var > 0.f ? var : 0.f;
            const float rstd = rsqrtf(var + EPS);
            const float y0 = (a0[j] - mean) * rstd * lg0_ + lb0_, y1 = (a1[j] - mean) * rstd * lg1_ + lb1_;
            *(unsigned*)(CS + ((size_t)(t0 + 8 * th + j)) * CD + 2 * cp) = pk2(y0 * sigm(y0), y1 * sigm(y1));
        }
        switch (grp) {
            case 0: pool_unit<1>(Us, PDo, th, cp, t0, s0); break;
            case 1: pool_unit<2>(Us, PDo, th, cp, t0, s0); break;
            case 2: pool_unit<4>(Us, PDo, th, cp, t0, s0); break;
            default: pool_unit<8>(Us, PDo, th, cp, t0, s0); break;
        }
    }
#undef P2_FETCH
    __syncthreads();
}

__device__ __forceinline__ void phase6(const Args& a, LAS unsigned char* lds, int gw, int NGW, int lane) {
    unsigned char* ws = a.ws;
    constexpr int WST = DM + 8;
    LAS bf16_t* WH = (LAS bf16_t*)lds; LAS bf16_t* WL = WH + NE * WST;
    { int t_ = threadIdx.x; asm volatile("" : "+v"(t_));
      for (int q = t_; q < DM * NE; q += NTHREADS) { const int d = q >> 4, e = q & 15; const float w = a.in[I_WR][q] * a.in[I_N2G][d];
          const unsigned hi = f2bf(w); const float rem = w - __uint_as_float(hi << 16); WH[e * WST + d] = (bf16_t)hi; WL[e * WST + d] = (bf16_t)f2bf(rem); } }
    __syncthreads();
    const bf16_t* X1 = (const bf16_t*)(ws + WS_X1B); float* RS1 = (float*)(ws + WS_RSTD1); float* AFF = (float*)(ws + WS_AFF); unsigned char* X1Q = ws + WS_X1Q;
    const int fr = lane & 15, fq = lane >> 4;
    for (int grp = gw; grp < NT / 16; grp += NGW) {
        const int row0 = grp * 16;
        const bf16_t* xp = X1 + (size_t)(row0 + fr) * DM + 8 * fq;
        bf16x8 af[32];
#pragma unroll
        for (int sidx = 0; sidx < 32; ++sidx) af[sidx] = *(const bf16x8*)(xp + 32 * sidx);
        f32x4 acc = (f32x4){0.f, 0.f, 0.f, 0.f}; float ss = 0.f, mx = 0.f;
#pragma unroll
        for (int sidx = 0; sidx < 32; ++sidx) {
            if ((sidx & 3) == 0) asm volatile("" ::: "memory");
            const bf16x8 bh = *(const LAS bf16x8*)(WH + fr * WST + 32 * sidx + 8 * fq), bl = *(const LAS bf16x8*)(WL + fr * WST + 32 * sidx + 8 * fq);
            acc = __builtin_amdgcn_mfma_f32_16x16x32_bf16(af[sidx], bh, acc, 0, 0, 0);
            acc = __builtin_amdgcn_mfma_f32_16x16x32_bf16(af[sidx], bl, acc, 0, 0, 0);
#pragma unroll
            for (int j = 0; j < 8; ++j) { const float xv = __uint_as_float(((unsigned)(unsigned short)af[sidx][j]) << 16); ss += xv * xv; mx = fmaxf(mx, fabsf(xv)); }
        }
        ss += __shfl_xor(ss, 16); ss += __shfl_xor(ss, 32);
        const float rstd = rsqrtf(ss * (1.0f / DM) + EPS);
        mx = fmaxf(mx, __shfl_xor(mx, 16)); mx = fmaxf(mx, __shfl_xor(mx, 32)); mx = fmaxf(mx, 1e-30f);
        if (fq == 0) RS1[row0 + fr] = rstd * (mx * (1.0f / 127.0f)) * WQ_INV;
        { const float qs = 127.0f * __builtin_amdgcn_rcpf(mx); unsigned char* qp = X1Q + (size_t)(row0 + fr) * DM + 8 * fq;
#pragma unroll
          for (int sidx = 0; sidx < 32; ++sidx) { asm volatile("" : "+v"(af[sidx]));
              const u32x4 w = __builtin_bit_cast(u32x4, af[sidx]);
              u32x2 q; q.x = q8x4s((f32x4){bf_lo(w.x), bf_hi(w.x), bf_lo(w.y), bf_hi(w.y)}, qs); q.y = q8x4s((f32x4){bf_lo(w.z), bf_hi(w.z), bf_lo(w.w), bf_hi(w.w)}, qs); *(u32x2*)(qp + 32 * sidx) = q; } }
        f32x4 av;
#pragma unroll
        for (int r = 0; r < 4; ++r) {
            const float lg = acc[r] * __shfl(rstd, 4 * fq + r);
            float mx = lg;
#pragma unroll
            for (int o2 = 1; o2 < 16; o2 <<= 1) mx = fmaxf(mx, __shfl_xor(mx, o2));
            const float pe = __expf(lg - mx); float den = pe;
#pragma unroll
            for (int o2 = 1; o2 < 16; o2 <<= 1) den += __shfl_xor(den, o2);
            av[r] = pe / den;
        }
        *(f32x4*)(AFF + ((size_t)((row0 / SEQ) * NE + fr)) * SEQ + (row0 % SEQ) + 4 * fq) = av;
    }
    __syncthreads();
}

__device__ __forceinline__ void phase7(const Args& a, LAS unsigned char* lds, int G, int cidx) {
    unsigned char* ws = a.ws;
    const float* AFF = (const float*)(ws + WS_AFF); int* IDX = (int*)(ws + WS_IDX); float* VAL = (float*)(ws + WS_VAL); int* INV = (int*)(ws + WS_INV);
    const float* RS1 = (const float*)(ws + WS_RSTD1); float* RSV = (float*)(ws + WS_RSV);
    LAS int* cnt = (LAS int*)lds;
    LAS int* wtot = cnt + 48;
    int tid_ = threadIdx.x; asm volatile("" : "+v"(tid_));
    const int tid = tid_, wave = tid >> 6, lane = tid & 63;
    for (int be = cidx; be < NB * NE; be += G) {
        const int b = be >> 4, e = be & 15;
        __syncthreads();
        unsigned v[4];
        { const f32x4 t4 = *(const f32x4*)(AFF + (size_t)be * SEQ + 4 * tid); v[0] = __float_as_uint(t4.x); v[1] = __float_as_uint(t4.y); v[2] = __float_as_uint(t4.z); v[3] = __float_as_uint(t4.w); }
        unsigned T = 0u;
        {
            const unsigned cand = 1u << 30; int c = 0;
#pragma unroll
            for (int j = 0; j < 4; ++j) c += (int)__popcll(__ballot(v[j] >= cand));
            if (lane == 0) cnt[wave * 3] = c;
            __syncthreads();
            int tot = 0;
#pragma unroll
            for (int w = 0; w < 8; ++w) tot += cnt[w * 3];
            if (tot >= CAP) T = cand;
        }
        for (int step = 0; step < 15; ++step) {
            const int hi = 29 - 2 * step, lo = hi - 1;
            const unsigned c1 = T | (1u << lo), c2 = T | (1u << hi), c3 = c2 | (1u << lo);
            int n1 = 0, n2 = 0, n3 = 0;
#pragma unroll
            for (int j = 0; j < 4; ++j) { n1 += (int)__popcll(__ballot(v[j] >= c1)); n2 += (int)__popcll(__ballot(v[j] >= c2)); n3 += (int)__popcll(__ballot(v[j] >= c3)); }
            LAS int* slot = cnt + 24 * ((step + 1) & 1);
            if (lane == 0) { slot[wave * 3] = n1; slot[wave * 3 + 1] = n2; slot[wave * 3 + 2] = n3; }
            __syncthreads();
            int t1 = 0, t2 = 0, t3 = 0;
#pragma unroll
            for (int w = 0; w < 8; ++w) { t1 += slot[w * 3]; t2 += slot[w * 3 + 1]; t3 += slot[w * 3 + 2]; }
            T = (t3 >= CAP) ? c3 : (t2 >= CAP) ? c2 : (t1 >= CAP) ? c1 : T;
        }
        int mygt = 0, myeq = 0;
#pragma unroll
        for (int j = 0; j < 4; ++j) { mygt += (v[j] > T) ? 1 : 0; myeq += (v[j] == T) ? 1 : 0; }
        const int pk = mygt | (myeq << 16); int inc = pk;
#pragma unroll
        for (int o = 1; o < 64; o <<= 1) { const int t = __shfl_up(inc, o); if (lane >= o) inc += t; }
        __syncthreads();
        if (lane == 63) wtot[wave] = inc;
        __syncthreads();
        int base = 0, total = 0;
#pragma unroll
        for (int w = 0; w < 8; ++w) { const int t = wtot[w]; if (w < wave) base += t; total += t; }
        const int excl = base + inc - pk; int pg = excl & 0xffff, pq = excl >> 16;
        const int ngt = total & 0xffff, need = CAP - ngt;
#pragma unroll
        for (int j = 0; j < 4; ++j) {
            const int tok = 4 * tid + j; int slot = -1;
            if (v[j] > T) { slot = pg + (pq < need ? pq : need); ++pg; }
            else if (v[j] == T) { if (pq < need) slot = pg + pq; ++pq; }
            INV[((size_t)(b * SEQ + tok)) * NE + e] = slot;
            if (slot >= 0) { IDX[be * CAP + slot] = tok; VAL[be * CAP + slot] = __uint_as_float(v[j]) * W8_INV; RSV[be * CAP + slot] = RS1[b * SEQ + tok]; }
        }
    }
    __syncthreads();
}

__device__ __forceinline__ void r16_acc(f32x4 (&v)[4], const u32x4 (&w)[2]) {
#pragma unroll
    for (int j = 0; j < 2; ++j) {
        v[2 * j].x += bf_lo(w[j].x); v[2 * j].y += bf_hi(w[j].x); v[2 * j].z += bf_lo(w[j].y); v[2 * j].w += bf_hi(w[j].y);
        v[2 * j + 1].x += bf_lo(w[j].z); v[2 * j + 1].y += bf_hi(w[j].z); v[2 * j + 1].z += bf_lo(w[j].w); v[2 * j + 1].w += bf_hi(w[j].w);
    }
}
__device__ __forceinline__ void l16_acc_fp8(f32x4 (&v)[4], const u32x4 w) {
    typedef float f2_ __attribute__((ext_vector_type(2)));
    const unsigned wj[4] = {w.x, w.y, w.z, w.w};
#pragma unroll
    for (int j = 0; j < 4; ++j) { const f2_ lo = __builtin_amdgcn_cvt_pk_f32_fp8((int)wj[j], false), hi = __builtin_amdgcn_cvt_pk_f32_fp8((int)wj[j], true);
        v[j].x += lo.x; v[j].y += lo.y; v[j].z += hi.x; v[j].w += hi.y; }
}
__device__ __forceinline__ void phase10(const Args& a, int gw, int NGW, int lane, bf16_t* XO) {
    unsigned char* ws = a.ws;
    const int* INV = (const int*)(ws + WS_INV); const unsigned char* YE = (const unsigned char*)(ws + WS_YE); const bf16_t* X = (const bf16_t*)(ws + WS_X1B); float* RS = (float*)(ws + WS_RSTD2); unsigned char* X2Q = ws + WS_X2Q;
    u32x4 nx[2]; u32x4 ny[4]; int inv1 = -1, inv2 = -1; unsigned msk1 = 0u;
#define P10_ISSUE(mrow, invreg, mskout) do { const int b_ = (mrow) / SEQ; \
        mskout = (unsigned)__builtin_amdgcn_readfirstlane((int)(__ballot((invreg) >= 0) & 0xffffull)); \
        _Pragma("unroll") for (int j = 0; j < 2; ++j) nx[j] = *(const u32x4*)(X + (size_t)(mrow) * DM + 16 * lane + 8 * j); \
        unsigned mm_ = mskout; \
        _Pragma("unroll") for (int k = 0; k < 4; ++k) { const bool act_ = mm_ != 0u; const int e_ = act_ ? __builtin_ctz(mm_) : 0; mm_ &= mm_ - 1u; const int sl_ = __builtin_amdgcn_readlane((invreg), e_); \
            const unsigned char* yr_ = (act_ ? YE + ((size_t)(b_ * NE + e_) * CAP + sl_) * DM : (const unsigned char*)(X + (size_t)(mrow) * DM)) + 16 * lane;     \
            ny[k] = *(const u32x4*)yr_; } } while (0)
    if (gw < NT) inv1 = INV[(size_t)gw * NE + (lane & 15)];
    if (gw + NGW < NT) inv2 = INV[(size_t)(gw + NGW) * NE + (lane & 15)];
    if (gw < NT) P10_ISSUE(gw, inv1, msk1);
    for (int m = gw; m < NT; m += NGW) {
        const int b = m / SEQ;
        f32x4 v[4]; u32x4 y[4]; const int inv0 = inv1; const unsigned msk0 = msk1;
        r16_unpack(v, nx);
#pragma unroll
        for (int k = 0; k < 4; ++k) y[k] = ny[k];
        inv1 = inv2;
        if (m + 2 * NGW < NT) inv2 = INV[(size_t)(m + 2 * NGW) * NE + (lane & 15)];
        if (m + NGW < NT) P10_ISSUE(m + NGW, inv1, msk1);
        unsigned mm = msk0;
#pragma unroll
        for (int k = 0; k < 4; ++k) { if (mm) { mm &= mm - 1u; l16_acc_fp8(v, y[k]); } }
        while (mm) {
            const int e = __builtin_ctz(mm); mm &= mm - 1u; const int sl = __builtin_amdgcn_readlane(inv0, e);
            const u32x4 w = *(const u32x4*)(YE + ((size_t)(b * NE + e) * CAP + sl) * DM + 16 * lane); l16_acc_fp8(v, w);
        }
        float s = 0.f, mx = 0.f;
#pragma unroll
        for (int j = 0; j < 4; ++j) { s += (v[j].x * v[j].x + v[j].y * v[j].y) + (v[j].z * v[j].z + v[j].w * v[j].w);
            mx = fmaxf(fmaxf(mx, fmaxf(fabsf(v[j].x), fabsf(v[j].y))), fmaxf(fabsf(v[j].z), fabsf(v[j].w))); }
        const float rstd = rsqrtf(wave_sum(s) * (1.0f / DM) + EPS);
#pragma unroll
        for (int o = 1; o < 64; o <<= 1) mx = fmaxf(mx, __shfl_xor(mx, o));
        mx = fmaxf(mx, 1e-30f); const float qs = 127.0f * __builtin_amdgcn_rcpf(mx);
        if (lane == 0) RS[m] = rstd * (mx * (1.0f / 127.0f)) * WQ_INV;
#pragma unroll
        for (int j = 0; j < 2; ++j) store_bf8(XO + (size_t)m * DM + 16 * lane + 8 * j, v[2 * j], v[2 * j + 1]);
        u32x4 q;
        q.x = q8x4s(v[0], qs); q.y = q8x4s(v[1], qs); q.z = q8x4s(v[2], qs); q.w = q8x4s(v[3], qs);
        *(u32x4*)(X2Q + (size_t)m * DM + 16 * lane) = q;
    }
#undef P10_ISSUE
    const f32x4* P = (const f32x4*)a.in[I_P]; u32x2* PB = (u32x2*)(ws + WS_PBF);
    const size_t nq = (size_t)NT * PLE / 4, stride = (size_t)NGW * 64;
    for (size_t q0 = (size_t)gw * 64 + lane; q0 < nq; q0 += 8 * stride) {
        f32x4 t[8];
#pragma unroll
        for (int i = 0; i < 8; ++i) { const size_t q = q0 + i * stride; t[i] = P[q < nq ? q : q0]; }
#pragma unroll
        for (int i = 0; i < 8; ++i) { const size_t q = q0 + i * stride; if (q < nq) { u32x2 w; w.x = pk2(t[i].x, t[i].y); w.y = pk2(t[i].z, t[i].w); PB[q] = w; } }
    }
}

__device__ __forceinline__ void phase12(const Args& a, int gw, int NGW, int lane, float* XO) {
    unsigned char* ws = a.ws;
    const bf16_t* GL = (const bf16_t*)(ws + WS_GL); const bf16_t* ER = (const bf16_t*)(ws + WS_ERAW); const bf16_t* X = (const bf16_t*)(ws + WS_XN);
    f32x4 gp[4], gf[4];
#pragma unroll
    for (int j = 0; j < 2; ++j) { gp[2 * j] = *(const f32x4*)(a.in[I_PNG] + 512 * j + 8 * lane); gp[2 * j + 1] = *(const f32x4*)(a.in[I_PNG] + 512 * j + 8 * lane + 4);
        gf[2 * j] = *(const f32x4*)(a.in[I_FG] + 512 * j + 8 * lane); gf[2 * j + 1] = *(const f32x4*)(a.in[I_FG] + 512 * j + 8 * lane + 4); }
#pragma unroll
    for (int j = 0; j < 4; ++j) asm volatile("" : "+v"(gp[j]), "+v"(gf[j]));
    u32x4 nx[2]; u32x4 ne[2], ng[2];
#define P12_ISSUE(mrow) do { _Pragma("unroll") for (int j = 0; j < 2; ++j) { nx[j] = *(const u32x4*)(X + (size_t)(mrow) * DM + 512 * j + 8 * lane); \
        ne[j] = *(const u32x4*)(ER + (size_t)(mrow) * DM + 512 * j + 8 * lane); ng[j] = *(const u32x4*)(GL + (size_t)(mrow) * DM + 512 * j + 8 * lane); } } while (0)
    if (gw < NT) P12_ISSUE(gw);
    for (int m = gw; m < NT; m += NGW) {
        f32x4 v[4], ev[4], gv[4]; float se = 0.f;
        r16_unpack(v, nx); r16_unpack(ev, ne); r16_unpack(gv, ng);
        if (m + NGW < NT) P12_ISSUE(m + NGW);
#pragma unroll
        for (int j = 0; j < 4; ++j) se += (ev[j].x * ev[j].x + ev[j].y * ev[j].y) + (ev[j].z * ev[j].z + ev[j].w * ev[j].w);
        const float rse = rsqrtf(wave_sum(se) * (1.0f / DM) + EPS); float s = 0.f;
#pragma unroll
        for (int j = 0; j < 4; ++j) { v[j] = v[j] + gv[j] * (ev[j] * rse * gp[j]); s += (v[j].x * v[j].x + v[j].y * v[j].y) + (v[j].z * v[j].z + v[j].w * v[j].w); }
        const float rstd = rsqrtf(wave_sum(s) * (1.0f / DM) + EPS);
#pragma unroll
        for (int j = 0; j < 2; ++j) { *(f32x4*)(XO + (size_t)m * DM + 512 * j + 8 * lane) = v[2 * j] * rstd * gf[2 * j]; *(f32x4*)(XO + (size_t)m * DM + 512 * j + 8 * lane + 4) = v[2 * j + 1] * rstd * gf[2 * j + 1]; }
    }
#undef P12_ISSUE
}

constexpr int N_PHASES = 13;
template <int LO, int HI>
__global__ void __launch_bounds__(NTHREADS, 2) mk_fwd(Args a) {
    extern __shared__ __attribute__((aligned(16))) unsigned char lds_raw[];
    LAS unsigned char* lds = (LAS unsigned char*)lds_raw;
    const int tid = threadIdx.x, wave = __builtin_amdgcn_readfirstlane(tid >> 6);
    const int G = gridDim.x, bx = blockIdx.x;
    const int vcu = (G % 8 == 0) ? (bx % 8) * (G / 8) + bx / 8 : bx;
    const int gw = vcu * NWAVES + wave, NGW = G * NWAVES;
    unsigned char* ws = a.ws;
#ifndef MK_DUP_MASK
#define MK_DUP_MASK 0
#endif
#define REP(k) (((MK_DUP_MASK >> (k)) & 1) ? 2 : 1)
#define IN(k) (LO <= (k) && (k) < HI)
#define BOTH(k) (IN(k) && IN((k) + 1))
    XcdBarrier bar; bar.bar = (unsigned*)(ws + WS_CTL); bar.x = 0; bar.st = nullptr;
    if (HI - LO > 1) {
        if (tid < 16) ((LAS unsigned*)(lds + MISC_OFF))[tid] = 0u;
        __syncthreads();
        bar = xcd_barrier_post((unsigned*)(ws + WS_CTL), (volatile LAS unsigned*)(lds + MISC_OFF));
    }
#define GRID_BAR(k) do { if (BOTH(k)) { xcd_barrier(bar); if (MK_DUP_MASK & 0x10000) xcd_barrier(bar); } } while (0)
    if (IN(0)) for (int rep_ = 0; rep_ < REP(0); ++rep_) { int l_ = threadIdx.x; asm volatile("" : "+v"(l_)); l_ &= 63; const bool split = (G % 64 == 0); phase0(a, lds, gw, NGW, wave, l_, 0, IT_SMALL, IT_SMALL + (split ? IT_P1 : 0), 3 * IT_EXP - (split ? IT_P1 : 0), true); }
    GRID_BAR(0);
    if (IN(1)) for (int rep_ = 0; rep_ < REP(1); ++rep_) {
        const bool split = (G % 64 == 0);
        if (split && ((bx >> 3) & 7) == 7) {
            int l_ = threadIdx.x; asm volatile("" : "+v"(l_)); l_ &= 63;
            const int ci = (bx >> 6) * 8 + (bx & 7), nci = (G >> 6) * 8;
            phase0(a, lds, ci * NWAVES + wave, nci * NWAVES, wave, l_, IT_SMALL, IT_P1, 0, 0, false);
        } else {
            const int cg = split ? ((bx >> 6) * 56 + ((bx >> 3) & 7) * 8 + (bx & 7)) : bx, Gg = split ? (G >> 6) * 56 : G;
            GemmDesc g{(const bf16_t*)(ws + WS_XQ), (const bf16_t*)(ws + WS_WIN), DM / 2, DM / 2, NT / 256, INC / 256, 0, 0, 0, nullptr, nullptr};
            Epi1 E{(bf16_t*)(ws + WS_V), (bf16_t*)(ws + WS_U), (bf16_t*)(ws + WS_G), a.in[I_BGATE], (const float*)(ws + WS_RSTD0)};
            gemm_phase<1>(lds, g, Gg, cg, E);
        }
    }
    GRID_BAR(1);
    if (IN(2)) for (int rep_ = 0; rep_ < REP(2); ++rep_) phase2(a, lds, G, vcu);
    GRID_BAR(2);
    if (IN(4)) for (int rep_ = 0; rep_ < REP(4); ++rep_) {
        GemmDesc g{(const bf16_t*)(ws + WS_PD), (const bf16_t*)(ws + WS_WCAT), PDIM, 640, NT / 256, DM / 256, 128, 0, 0, nullptr, (const bf16_t*)(ws + WS_CS)};
        Epi23 E{(const bf16_t*)(ws + WS_G), a.in[I_PSCALE], (bf16_t*)(ws + WS_MERGED)};
        gemm_phase<3>(lds, g, G, bx, E);
    }
    GRID_BAR(4);
    if (IN(5)) for (int rep_ = 0; rep_ < REP(5); ++rep_) {
        GemmDesc g{(const bf16_t*)(ws + WS_MERGED), (const bf16_t*)(ws + WS_WOUT), DM, DM, NT / 256, DM / 256, 0, 0, 0, nullptr, nullptr};
        Epi4 E{(const bf16_t*)(ws + WS_XN), (bf16_t*)(ws + WS_X1B)};
        gemm_phase<4>(lds, g, G, bx, E);
    }
    GRID_BAR(5);
    if (IN(6)) for (int rep_ = 0; rep_ < REP(6); ++rep_) { int l_ = threadIdx.x; asm volatile("" : "+v"(l_)); l_ &= 63; phase6(a, lds, gw, NGW, l_); }
    GRID_BAR(6);
    if (IN(7)) for (int rep_ = 0; rep_ < REP(7); ++rep_) phase7(a, lds, G, vcu);
    GRID_BAR(7);
    if (IN(8)) for (int rep_ = 0; rep_ < REP(8); ++rep_) {
        GemmDesc g{(const bf16_t*)(ws + WS_X1Q), (const bf16_t*)(ws + WS_WGU), DM / 2, DM / 2, NB * NE, 2048 / 256, 0, 1, (size_t)2048 * DM / 2, (const int*)(ws + WS_IDX), nullptr};
        Epi5 E{ws + WS_HID, (const float*)(ws + WS_RSV)};
        gemm_phase<5>(lds, g, G, bx, E);
    }
    GRID_BAR(8);
    if (IN(9)) for (int rep_ = 0; rep_ < REP(9); ++rep_) {
        GemmDesc g{(const bf16_t*)(ws + WS_HID), (const bf16_t*)(ws + WS_WD), FF / 2, FF / 2, NB * NE, DM / 256, 0, 1, (size_t)DM * FF / 2, nullptr, nullptr};
        Epi6 E{(const float*)(ws + WS_VAL), (unsigned char*)(ws + WS_YE)};
        gemm_phase<6>(lds, g, G, bx, E);
    }
    GRID_BAR(9);
    if (IN(10)) for (int rep_ = 0; rep_ < REP(10); ++rep_) { int l_ = threadIdx.x; asm volatile("" : "+v"(l_)); l_ &= 63; phase10(a, gw, NGW, l_, (bf16_t*)(ws + WS_XN)); }
    GRID_BAR(10);
    if (IN(11)) for (int rep_ = 0; rep_ < REP(11); ++rep_) {
        { GemmDesc g{(const bf16_t*)(ws + WS_X2Q), (const bf16_t*)(ws + WS_WPG), DM / 2, DM / 2, NT / 256, DM / 256, 0, 0, 0, nullptr, nullptr};
          Epi7 E{a.in[I_BPG], (bf16_t*)(ws + WS_GL), (const float*)(ws + WS_RSTD2)};
          gemm_phase<7>(lds, g, G, bx, E); }
        { GemmDesc g{(const bf16_t*)(ws + WS_PBF), (const bf16_t*)(ws + WS_WPLE), PLE, PLE, NT / 256, DM / 256, 0, 0, 0, nullptr, nullptr};
          Epi8 E{(bf16_t*)(ws + WS_ERAW)};
          gemm_phase<8>(lds, g, G, bx, E); }
    }
    GRID_BAR(11);
    if (IN(12)) for (int rep_ = 0; rep_ < REP(12); ++rep_) { int l_ = threadIdx.x; asm volatile("" : "+v"(l_)); l_ &= 63; phase12(a, gw, NGW, l_, a.out); }
#undef IN
#undef BOTH
#undef GRID_BAR
}

#ifndef MK_ONE_LAUNCH
#define MK_ONE_LAUNCH 1
#endif
typedef void (*kern_t)(Args);
#if !MK_ONE_LAUNCH
template <int P> struct PhaseTab { static void fill(kern_t* t) { t[P] = mk_fwd<P, P + 1>; PhaseTab<P - 1>::fill(t); } };
template <> struct PhaseTab<-1> { static void fill(kern_t*) {} };
constexpr int N_KERNELS = N_PHASES;
#else
constexpr int N_KERNELS = 1;
#endif

extern "C" void kernel_launch(void* const* d_in, const int* in_sizes, int n_in, void* d_out, int out_size, void* d_ws, size_t ws_size, hipStream_t stream) {
    static int grid = 0; static kern_t tab[N_KERNELS];
    if (grid == 0) {
        if (n_in != 24 || in_sizes[0] != NT * DM || out_size != NT * DM || ws_size < WS_END) {
            fprintf(stderr, "kernel_launch: unexpected shapes: n_in %d in0 %d out %d ws %zu (need %zu)\n", n_in, n_in > 0 ? in_sizes[0] : -1, out_size, ws_size, (size_t)WS_END); grid = -1; return; }
        int dev = 0, cus = 0;
        if (hipGetDevice(&dev) != hipSuccess || hipDeviceGetAttribute(&cus, hipDeviceAttributeMultiprocessorCount, dev) != hipSuccess) { grid = -1; return; }
#if !MK_ONE_LAUNCH
        PhaseTab<N_PHASES - 1>::fill(tab);
#else
        tab[0] = mk_fwd<0, N_PHASES>;
#endif
        for (int p = 0; p < N_KERNELS; ++p) {
            int per_cu = 0;
            if (hipFuncSetAttribute((const void*)tab[p], hipFuncAttributeMaxDynamicSharedMemorySize, LDS_BYTES) != hipSuccess) { fprintf(stderr, "kernel_launch: hipFuncSetAttribute failed (kernel %d)\n", p); grid = -1; return; }
            if (hipOccupancyMaxActiveBlocksPerMultiprocessor(&per_cu, (const void*)tab[p], NTHREADS, LDS_BYTES) != hipSuccess || per_cu < 1) { fprintf(stderr, "kernel_launch: occupancy query says %d (kernel %d)\n", per_cu, p); grid = -1; (void)hipGetLastError(); return; }
        }
        grid = cus;
    }
    if (grid < 0) return;
    Args a{};
    for (int i = 0; i < 24; ++i) a.in[i] = (const float*)d_in[i];
    a.out = (float*)d_out; a.ws = (unsigned char*)d_ws;
#if MK_ONE_LAUNCH
    if (hipMemsetAsync((char*)d_ws + WS_CTL, 0, CTL_ZERO_BYTES, stream) != hipSuccess) { fprintf(stderr, "kernel_launch: memset failed\n"); return; }
#endif
    for (int p = 0; p < N_KERNELS; ++p) hipLaunchKernelGGL(tab[p], dim3(grid), dim3(NTHREADS), LDS_BYTES, stream, a);
}
```

```cpp
#include <hip/hip_runtime.h>
#include <cstdio>
#include <cstdint>

#define LAS __attribute__((address_space(3)))
typedef unsigned short bf16_t;
typedef float f32x4 __attribute__((ext_vector_type(4)));
typedef unsigned u32x2 __attribute__((ext_vector_type(2)));
typedef unsigned u32x4 __attribute__((ext_vector_type(4)));

constexpr int NB = 16, SEQ = 2048, DM = 1024, NT = NB * SEQ;
constexpr int PLE = 256, CD = 512, CWID = 31, PDIM = 512, NE = 16, FF = 1024, CAP = 256, INC = 3584;
constexpr float EPS = 1e-6f;
constexpr int NWAVES = 8, NTHREADS = 512;
constexpr int LDS_BYTES = 147456;

constexpr size_t MiB = 1u << 20;
constexpr size_t WS_CTL = 0;
constexpr size_t WS_WIN = 1 * MiB;
constexpr size_t WS_WCAT = 8 * MiB;
constexpr size_t WS_WPLE = 9 * MiB + 512 * 1024;
constexpr size_t WS_WOUT = 10 * MiB;
constexpr size_t WS_WPG = 12 * MiB;
constexpr size_t WS_WGU = 14 * MiB;
constexpr size_t WS_WD = 78 * MiB;
constexpr size_t WS_XN = 111 * MiB;
constexpr size_t WS_R1 = 175 * MiB;
constexpr size_t WS_V = WS_R1;
constexpr size_t WS_U = WS_R1 + 32 * MiB;
constexpr size_t WS_G = WS_R1 + 64 * MiB;
constexpr size_t WS_MERGED = WS_R1;
constexpr size_t WS_HID = WS_R1;
constexpr size_t WS_GL = WS_R1 + 64 * MiB;
constexpr size_t WS_PBF = WS_R1;
constexpr size_t WS_X2Q = WS_R1 + 16 * MiB;
constexpr size_t WS_X1B = WS_R1 + 128 * MiB;
constexpr size_t WS_R2 = 367 * MiB;
constexpr size_t WS_CS = WS_R2;
constexpr size_t WS_PD = WS_R2 + 32 * MiB;
constexpr size_t WS_XQ = WS_R2;
constexpr size_t WS_X1Q = WS_R2;
constexpr size_t WS_YE = WS_R2;
constexpr size_t WS_ERAW = WS_R2;
constexpr size_t WS_AFF = 495 * MiB;
constexpr size_t WS_IDX = 497 * MiB;
constexpr size_t WS_VAL = 497 * MiB + 512 * 1024;
constexpr size_t WS_INV = 498 * MiB;
constexpr size_t WS_RSTD2 = 500 * MiB;
constexpr size_t WS_RSTD0 = 502 * MiB;
constexpr size_t WS_RSTD1 = 501 * MiB;
constexpr size_t WS_RSV = 497 * MiB + 256 * 1024;
constexpr size_t WS_END = 512 * MiB;

#define LDS_WAIT() asm volatile("s_waitcnt lgkmcnt(0)" ::: "memory")
#define VM_WAIT() asm volatile("s_waitcnt vmcnt(0)" ::: "memory")
__device__ __forceinline__ unsigned f2bf(float f) { unsigned u = __float_as_uint(f); return (u + 0x7fffu + ((u >> 16) & 1u)) >> 16; }
typedef float f32x2p __attribute__((ext_vector_type(2))); typedef __bf16 bf16x2p __attribute__((ext_vector_type(2)));
__device__ __forceinline__ unsigned pk2(float lo, float hi) { const f32x2p v = {lo, hi}; const bf16x2p b = __builtin_convertvector(v, bf16x2p); return __builtin_bit_cast(unsigned, b); }
__device__ __forceinline__ float bf_lo(unsigned w) { return __uint_as_float(w << 16); }
__device__ __forceinline__ float bf_hi(unsigned w) { return __uint_as_float(w & 0xffff0000u); }
__device__ __forceinline__ float sigm(float x) { return __builtin_amdgcn_rcpf(1.0f + __expf(-x)); }
__device__ __forceinline__ f32x4 sigm4(f32x4 v) { f32x4 o; o.x = sigm(v.x); o.y = sigm(v.y); o.z = sigm(v.z); o.w = sigm(v.w); return o; }
__device__ __forceinline__ void store_bf4(bf16_t* p, f32x4 v) { u32x2 w; w.x = pk2(v.x, v.y); w.y = pk2(v.z, v.w); *(u32x2*)p = w; }
__device__ __forceinline__ f32x4 load_bf4(const bf16_t* p) { const u32x2 w = *(const u32x2*)p; f32x4 o; o.x = bf_lo(w.x); o.y = bf_hi(w.x); o.z = bf_lo(w.y); o.w = bf_hi(w.y); return o; }
__device__ __forceinline__ void store_bf8(bf16_t* p, f32x4 lo, f32x4 hi) { u32x4 w; w.x = pk2(lo.x, lo.y); w.y = pk2(lo.z, lo.w); w.z = pk2(hi.x, hi.y); w.w = pk2(hi.z, hi.w); *(u32x4*)p = w; }
__device__ __forceinline__ void load_bf8(const bf16_t* p, f32x4& lo, f32x4& hi) { const u32x4 w = *(const u32x4*)p; lo = (f32x4){bf_lo(w.x), bf_hi(w.x), bf_lo(w.y), bf_hi(w.y)}; hi = (f32x4){bf_lo(w.z), bf_hi(w.z), bf_lo(w.w), bf_hi(w.w)}; }
__device__ __forceinline__ void r16_unpack(f32x4 (&o)[4], const u32x4 (&w)[2]) {
#pragma unroll
    for (int j = 0; j < 2; ++j) { o[2 * j] = (f32x4){bf_lo(w[j].x), bf_hi(w[j].x), bf_lo(w[j].y), bf_hi(w[j].y)}; o[2 * j + 1] = (f32x4){bf_lo(w[j].z), bf_hi(w[j].z), bf_lo(w[j].w), bf_hi(w[j].w)}; }
}
__device__ __forceinline__ unsigned pk_fp8x4(float a, float b, float c, float d) { int p = __builtin_amdgcn_cvt_pk_fp8_f32(a, b, 0, false); p = __builtin_amdgcn_cvt_pk_fp8_f32(c, d, p, true); return (unsigned)p; }
__device__ __forceinline__ unsigned q8x4(float a, float b, float c, float d) {
    const float M = 12582912.0f; const unsigned ua = __float_as_uint(a + M), ub = __float_as_uint(b + M), uc = __float_as_uint(c + M), ud = __float_as_uint(d + M);
    return __builtin_amdgcn_perm(__builtin_amdgcn_perm(ud, uc, 0x0c0c0400u), __builtin_amdgcn_perm(ub, ua, 0x0c0c0400u), 0x05040100u); }
__device__ __forceinline__ unsigned q8x4s(f32x4 v, float s) {
    const f32x4 t = v * s + 12582912.0f; const unsigned ua = __float_as_uint(t.x), ub = __float_as_uint(t.y), uc = __float_as_uint(t.z), ud = __float_as_uint(t.w);
    return __builtin_amdgcn_perm(__builtin_amdgcn_perm(ud, uc, 0x0c0c0400u), __builtin_amdgcn_perm(ub, ua, 0x0c0c0400u), 0x05040100u); }
__device__ __forceinline__ float clamp127(float v) { return __builtin_amdgcn_fmed3f(v, -127.0f, 127.0f); }
constexpr float WQ_SCALE = 127.0f * 32.0f / 4.0f, WQ_INV = 4.0f / (127.0f * 32.0f);
constexpr float W8_SCALE = 32.0f, W8_INV = 1.0f / 32.0f;
__device__ __forceinline__ float wave_sum(float v) {
#pragma unroll
    for (int o = 1; o < 64; o <<= 1) v += __shfl_xor(v, o);
    return v;
}


#define XB_TMO      128
#define XB_XCNT(j)  (256  + 64 * (j))
#define XB_XSUB(j)  (1280 + 64 * (j))
#define XB_XGEN(j)  (2304 + 64 * (j))
#define XB_TOP      3328
#define XB_TOPGEN   3392
#define XCD_BAR_WORDS 3456
#define XB_SPIN_CAP (1u << 18)
__device__ __forceinline__ unsigned xb_ld(unsigned* p)              { return __hip_atomic_load(p, __ATOMIC_RELAXED, __HIP_MEMORY_SCOPE_AGENT); }
__device__ __forceinline__ unsigned xb_add(unsigned* p, unsigned v) { return __hip_atomic_fetch_add(p, v, __ATOMIC_RELAXED, __HIP_MEMORY_SCOPE_AGENT); }
__device__ __forceinline__ unsigned xb_xcc_id() { return (unsigned)__builtin_amdgcn_s_getreg((3 << 11) | 20) & 0xFu; }
#define XB_SPIN(cond, bar) do { unsigned _sp = 0; while (cond) { __builtin_amdgcn_s_sleep(1); \
    if ((++_sp & 255u) == 0u) { if (xb_ld(&(bar)[XB_TMO])) break; if (_sp > XB_SPIN_CAP) { atomicAdd(&(bar)[XB_TMO], 1u); break; } } } } while (0)
struct XcdBarrier { unsigned* bar; unsigned x; volatile LAS unsigned* st; };
__device__ __forceinline__ XcdBarrier xcd_barrier_post(unsigned* bar, volatile LAS unsigned* st) {
    XcdBarrier b; b.bar = bar; b.x = xb_xcc_id(); b.st = st;
    if (threadIdx.x == 0) (void)xb_add(&bar[XB_XCNT(b.x)], 1u);
    return b;
}
__device__ __forceinline__ void xcd_barrier_complete(unsigned* bar, unsigned x, unsigned& nloc, unsigned& nx) {
    const unsigned G = gridDim.x * gridDim.y * gridDim.z;
    unsigned sum, cnt, mine, sp = 0u;
    for (;;) {
        sum = 0u; cnt = 0u; mine = 0u;
#pragma unroll
        for (unsigned j = 0; j < 16; ++j) { const unsigned c = xb_ld(&bar[XB_XCNT(j)]); sum += c; cnt += (c > 0u) ? 1u : 0u; mine = (j == x) ? c : mine; }
        if (sum == G) break;
        __builtin_amdgcn_s_sleep(1);
        if ((++sp & 255u) == 0u) { if (xb_ld(&bar[XB_TMO])) break; if (sp > XB_SPIN_CAP) { atomicAdd(&bar[XB_TMO], 1u); break; } }
    }
    nloc = mine > 0u ? mine : 1u; nx = cnt > 0u ? cnt : 1u;
}
__device__ __forceinline__ void xcd_barrier(const XcdBarrier& b) {
    asm volatile("s_waitcnt vmcnt(0)" ::: "memory");
    __syncthreads();
    if (threadIdx.x == 0) {
        unsigned* bar = b.bar;
        __builtin_amdgcn_s_waitcnt(0);
        unsigned nloc = b.st[0], nx = b.st[1];
        if (nloc == 0u) { xcd_barrier_complete(bar, b.x, nloc, nx); b.st[0] = nloc; b.st[1] = nx; }
        const unsigned old = xb_add(&bar[XB_XSUB(b.x)], 1u);
        const unsigned gen = old / nloc;
        if (old + 1u == (gen + 1u) * nloc) {
            __builtin_amdgcn_fence(__ATOMIC_RELEASE, "agent");
            asm volatile("s_waitcnt vmcnt(0)" ::: "memory");
            const unsigned og = xb_add(&bar[XB_TOP], 1u);
            const unsigned tg = og / nx;
            if (og + 1u == (tg + 1u) * nx) xb_add(&bar[XB_TOPGEN], 1u);
            else XB_SPIN(xb_ld(&bar[XB_TOPGEN]) == tg, bar);
            __builtin_amdgcn_fence(__ATOMIC_ACQUIRE, "agent");
            xb_add(&bar[XB_XGEN(b.x)], 1u);
            asm volatile("s_waitcnt vmcnt(0)" ::: "memory");
        } else {
            XB_SPIN(xb_ld(&bar[XB_XGEN(b.x)]) == gen, bar);
            __builtin_amdgcn_fence(__ATOMIC_ACQUIRE, "agent");
            asm volatile("s_waitcnt vmcnt(0)" ::: "memory");
        }
    }
    __syncthreads();
}
constexpr int MISC_OFF = LDS_BYTES - 64;
constexpr size_t CTL_ZERO_BYTES = 65536;

struct Unit { int pm, pn; };
constexpr int NXCD = 8, WGM = 8;
struct StaticOrder {
    int nM, nN, nwg, G, c;
    __device__ void init(int nM_, int nN_, int G_, int c_) { nM = nM_; nN = nN_; nwg = nM * nN; G = G_; c = c_; }
    __device__ bool next(int i, Unit& u) const {
        const long L = (long)i * G + c; if (L >= nwg) return false;
        int wgid = (int)L; { const int q = nwg / NXCD, r = nwg % NXCD, xcd = wgid % NXCD, off = wgid / NXCD; wgid = (xcd < r ? xcd * (q + 1) : r * (q + 1) + (xcd - r) * q) + off; }
        const int nig = WGM * nN, gid = wgid / nig, fm = gid * WGM, gsz = (nM - fm) < WGM ? (nM - fm) : WGM;
        u.pm = fm + ((wgid % nig) % gsz); u.pn = (wgid % nig) / gsz; return true;
    }
};
struct GemmDesc {
    const bf16_t* A; const bf16_t* Bt; int lda, K, nM, nN, a_col_step, moe; size_t b_mat_stride; const int* rowidx; const bf16_t* A2;
    __device__ __forceinline__ int mem_pm(int pm) const { return moe ? ((pm & 15) * 16 + (pm >> 4)) : pm; }
    __device__ __forceinline__ const bf16_t* a_ptr(const Unit& u) const { return A + (size_t)mem_pm(u.pm) * 256 * lda + (size_t)u.pn * a_col_step; }
    __device__ __forceinline__ const bf16_t* a2_ptr(const Unit& u) const { return A2 + (size_t)mem_pm(u.pm) * 256 * lda; }
    __device__ __forceinline__ const bf16_t* b_ptr(const Unit& u) const { return Bt + (moe ? (size_t)(u.pm >> 4) * b_mat_stride : (size_t)0) + (size_t)u.pn * 256 * K; }
};

struct Epi1 { static constexpr bool DUAL = false;
    bf16_t* V; bf16_t* U; bf16_t* Gt; const float* bgate; const float* RS;
    struct Early { float r[8]; };
    __device__ __forceinline__ void early(Early& e, int mpm, int rbase) const {
#pragma unroll
        for (int g = 0; g < 8; ++g) e.r[g] = RS[(size_t)mpm * 256 + 128 * (g >> 2) + 16 * (g & 3) + rbase]; }
    struct Ctx { f32x4 b[4]; }; struct Pre {}; static constexpr int DIST = 0;
    __device__ __forceinline__ void begin(Ctx& c, int mpm, int pn, int c8, int rbase) const { const float* bp = bgate + (pn >= 6 ? 256 * (pn - 6) : 0) + c8;
        c.b[0] = *(const f32x4*)bp; c.b[1] = *(const f32x4*)(bp + 4); c.b[2] = *(const f32x4*)(bp + 128); c.b[3] = *(const f32x4*)(bp + 132); }
    __device__ __forceinline__ void prefetch(Pre&, int, int, int, int) const {}
    __device__ __forceinline__ void finish(const Early& ea, const Ctx& c, const Pre&, int g, int mpm, int pn, int r, int c8, f32x4 a0, f32x4 a1, f32x4 b0, f32x4 b1) const {
        const size_t row = (size_t)mpm * 256 + r; const float rs = ea.r[g]; a0 = a0 * rs; a1 = a1 * rs; b0 = b0 * rs; b1 = b1 * rs;
        if (pn < 4) { store_bf8(V + row * CD + 128 * pn + c8, a0 * sigm4(b0), a1 * sigm4(b1)); }
        else if (pn < 6) { bf16_t* p = U + row * PDIM + 256 * (pn - 4) + c8; store_bf8(p, a0, a1); store_bf8(p + 128, b0, b1); }
        else { bf16_t* p = Gt + row * 2048 + 256 * (pn - 6) + c8; store_bf8(p, sigm4(a0 + c.b[0]), sigm4(a1 + c.b[1])); store_bf8(p + 128, sigm4(b0 + c.b[2]), sigm4(b1 + c.b[3])); }
    }
};
struct Epi23 {
    static constexpr bool DUAL = true;
    const bf16_t* Gt; const float* scale; bf16_t* MG;
    struct TCtx { f32x4 s[4]; }; struct TPre { u32x4 g1[2], g2[2]; };
    __device__ __forceinline__ void t_begin(TCtx& c, int mpm, int pn, int c8) const { const float* sp = scale + 256 * pn + c8;
        c.s[0] = *(const f32x4*)sp; c.s[1] = *(const f32x4*)(sp + 4); c.s[2] = *(const f32x4*)(sp + 128); c.s[3] = *(const f32x4*)(sp + 132); }
    __device__ __forceinline__ void t_prefetch(TPre& p, int mpm, int pn, int r, int c8) const { const bf16_t* gp = Gt + ((size_t)mpm * 256 + r) * 2048 + 256 * pn + c8;
        p.g1[0] = *(const u32x4*)gp; p.g1[1] = *(const u32x4*)(gp + 128); p.g2[0] = *(const u32x4*)(gp + 1024); p.g2[1] = *(const u32x4*)(gp + 1024 + 128); }
    __device__ __forceinline__ static f32x4 ratio4(f32x4 g2, f32x4 sc, f32x4 g1) { f32x4 o;
        o.x = g2.x * sc.x * __builtin_amdgcn_rcpf(fmaxf(g1.x, 1e-30f)); o.y = g2.y * sc.y * __builtin_amdgcn_rcpf(fmaxf(g1.y, 1e-30f));
        o.z = g2.z * sc.z * __builtin_amdgcn_rcpf(fmaxf(g1.z, 1e-30f)); o.w = g2.w * sc.w * __builtin_amdgcn_rcpf(fmaxf(g1.w, 1e-30f)); return o; }
    __device__ __forceinline__ void t_apply(const TCtx& c, const TPre& p, f32x4& a0, f32x4& a1, f32x4& b0, f32x4& b1) const {
        f32x4 o1[4], o2[4]; r16_unpack(o1, p.g1); r16_unpack(o2, p.g2);
        a0 = a0 * ratio4(o2[0], c.s[0], o1[0]); a1 = a1 * ratio4(o2[1], c.s[1], o1[1]); b0 = b0 * ratio4(o2[2], c.s[2], o1[2]); b1 = b1 * ratio4(o2[3], c.s[3], o1[3]);
    }
    struct Early {}; __device__ __forceinline__ void early(Early&, int, int) const {}
    struct Ctx {}; struct Pre { u32x4 g[2]; }; static constexpr int DIST = 2;
    __device__ __forceinline__ void begin(Ctx&, int, int, int, int) const {}
    __device__ __forceinline__ void prefetch(Pre& p, int mpm, int pn, int r, int c8) const { const bf16_t* gp = Gt + ((size_t)mpm * 256 + r) * 2048 + 256 * pn + c8;
        p.g[0] = *(const u32x4*)gp; p.g[1] = *(const u32x4*)(gp + 128); }
    __device__ __forceinline__ void finish(const Early& ea, const Ctx&, const Pre& p, int g, int mpm, int pn, int r, int c8, f32x4 a0, f32x4 a1, f32x4 b0, f32x4 b1) const {
        f32x4 o[4]; r16_unpack(o, p.g); bf16_t* mp = MG + ((size_t)mpm * 256 + r) * DM + 256 * pn + c8;
        store_bf8(mp, o[0] * a0, o[1] * a1); store_bf8(mp + 128, o[2] * b0, o[3] * b1);
    }
};
struct Epi4 { static constexpr bool DUAL = false;
    const bf16_t* X; bf16_t* O;
    struct Early {}; __device__ __forceinline__ void early(Early&, int, int) const {}
    struct Ctx {}; struct Pre { u32x4 x[2]; }; static constexpr int DIST = 2;
    __device__ __forceinline__ void begin(Ctx&, int, int, int, int) const {}
    __device__ __forceinline__ void prefetch(Pre& p, int mpm, int pn, int r, int c8) const { const bf16_t* xp = X + ((size_t)mpm * 256 + r) * DM + 256 * pn + c8;
        p.x[0] = *(const u32x4*)xp; p.x[1] = *(const u32x4*)(xp + 128); }
    __device__ __forceinline__ void finish(const Early& ea, const Ctx&, const Pre& p, int g, int mpm, int pn, int r, int c8, f32x4 a0, f32x4 a1, f32x4 b0, f32x4 b1) const {
        f32x4 o[4]; r16_unpack(o, p.x); bf16_t* op = O + ((size_t)mpm * 256 + r) * DM + 256 * pn + c8; store_bf8(op, o[0] + a0, o[1] + a1); store_bf8(op + 128, o[2] + b0, o[3] + b1);
    }
};
struct Epi5 { static constexpr bool DUAL = false;
    unsigned char* H; const float* RSV;
    struct Early { float r[8]; };
    __device__ __forceinline__ void early(Early& e, int mpm, int rbase) const {
#pragma unroll
        for (int g = 0; g < 8; ++g) e.r[g] = RSV[(size_t)mpm * 256 + 128 * (g >> 2) + 16 * (g & 3) + rbase]; }
    struct Ctx {}; struct Pre {}; static constexpr int DIST = 0;
    __device__ __forceinline__ void begin(Ctx&, int, int, int, int) const {}
    __device__ __forceinline__ void prefetch(Pre&, int, int, int, int) const {}
    __device__ __forceinline__ void finish(const Early& ea, const Ctx& c, const Pre&, int g, int mpm, int pn, int r, int c8, f32x4 a0, f32x4 a1, f32x4 b0, f32x4 b1) const {
        const float rs = ea.r[g]; const f32x4 g0 = a0 * rs, g1 = a1 * rs;
        const f32x4 h0 = g0 * sigm4(g0) * (b0 * rs), h1 = g1 * sigm4(g1) * (b1 * rs); u32x2 w; w.x = pk_fp8x4(h0.x, h0.y, h0.z, h0.w); w.y = pk_fp8x4(h1.x, h1.y, h1.z, h1.w);
        *(u32x2*)(H + ((size_t)mpm * 256 + r) * FF + 128 * pn + c8) = w;
    }
};
struct Epi6 { static constexpr bool DUAL = false;
    const float* VAL; unsigned char* YE;
    __device__ __forceinline__ static unsigned pack_fp8x4(f32x4 v) { int p = __builtin_amdgcn_cvt_pk_fp8_f32(v.x, v.y, 0, false); p = __builtin_amdgcn_cvt_pk_fp8_f32(v.z, v.w, p, true); return (unsigned)p; }
    struct Early { float r[8]; };
    __device__ __forceinline__ void early(Early& e, int mpm, int rbase) const {
#pragma unroll
        for (int g = 0; g < 8; ++g) e.r[g] = VAL[(size_t)mpm * 256 + 128 * (g >> 2) + 16 * (g & 3) + rbase]; }
    struct Ctx {}; struct Pre {}; static constexpr int DIST = 0;
    __device__ __forceinline__ void begin(Ctx&, int, int, int, int) const {}
    __device__ __forceinline__ void prefetch(Pre&, int, int, int, int) const {}
    __device__ __forceinline__ void finish(const Early& ea, const Ctx& c, const Pre&, int g, int mpm, int pn, int r, int c8, f32x4 a0, f32x4 a1, f32x4 b0, f32x4 b1) const {
        const float tv = ea.r[g]; unsigned char* p = YE + ((size_t)mpm * 256 + r) * DM + 256 * pn + 2 * (c8 & ~31) + (c8 & 31);
        u32x2 w0, w1; w0.x = pack_fp8x4(a0 * tv); w0.y = pack_fp8x4(a1 * tv); w1.x = pack_fp8x4(b0 * tv); w1.y = pack_fp8x4(b1 * tv);
        const auto r0 = __builtin_amdgcn_permlane16_swap(w0.x, w1.x, false, false); const auto r1 = __builtin_amdgcn_permlane16_swap(w0.y, w1.y, false, false);
        u32x4 o; o.x = r0[0]; o.y = r1[0]; o.z = r0[1]; o.w = r1[1];
        *(u32x4*)((c8 & 8) ? p + 24 : p) = o;
    }
};
struct Epi7 { static constexpr bool DUAL = false;
    const float* bias; bf16_t* GL; const float* RS;
    struct Early { float r[8]; };
    __device__ __forceinline__ void early(Early& e, int mpm, int rbase) const {
#pragma unroll
        for (int g = 0; g < 8; ++g) e.r[g] = RS[(size_t)mpm * 256 + 128 * (g >> 2) + 16 * (g & 3) + rbase]; }
    struct Ctx { f32x4 b[4]; }; struct Pre {}; static constexpr int DIST = 0;
    __device__ __forceinline__ void begin(Ctx& c, int mpm, int pn, int c8, int rbase) const { const float* bp = bias + 256 * pn + c8;
        c.b[0] = *(const f32x4*)bp; c.b[1] = *(const f32x4*)(bp + 4); c.b[2] = *(const f32x4*)(bp + 128); c.b[3] = *(const f32x4*)(bp + 132); }
    __device__ __forceinline__ void prefetch(Pre&, int, int, int, int) const {}
    __device__ __forceinline__ void finish(const Early& ea, const Ctx& c, const Pre&, int g, int mpm, int pn, int r, int c8, f32x4 a0, f32x4 a1, f32x4 b0, f32x4 b1) const {
        const float rs = ea.r[g]; bf16_t* p = GL + ((size_t)mpm * 256 + r) * DM + 256 * pn + c8;
        store_bf8(p, sigm4(a0 * rs + c.b[0]), sigm4(a1 * rs + c.b[1])); store_bf8(p + 128, sigm4(b0 * rs + c.b[2]), sigm4(b1 * rs + c.b[3]));
    }
};
struct Epi8 { static constexpr bool DUAL = false;
    bf16_t* ER;
    struct Early {}; __device__ __forceinline__ void early(Early&, int, int) const {}
    struct Ctx {}; struct Pre {}; static constexpr int DIST = 0;
    __device__ __forceinline__ void begin(Ctx&, int, int, int, int) const {}
    __device__ __forceinline__ void prefetch(Pre&, int, int, int, int) const {}
    __device__ __forceinline__ void finish(const Early& ea, const Ctx&, const Pre&, int g, int mpm, int pn, int r, int c8, f32x4 a0, f32x4 a1, f32x4 b0, f32x4 b1) const {
        bf16_t* p = ER + ((size_t)mpm * 256 + r) * DM + 256 * pn + c8; store_bf8(p, a0, a1); store_bf8(p + 128, b0, b1);
    }
};

typedef short bf16x8 __attribute__((ext_vector_type(8)));
constexpr int BK = 64, HALF = 128, HTB = HALF * BK * 2, STAGE_BYTES = 8 * HTB;
__device__ __forceinline__ int lds_byte(int r, int c) { const int st = (r >> 4) * 2 + (c >> 5), rr = r & 15, cc = c & 31, ob = rr * 64 + cc * 2; return st * 1024 + (ob ^ (((ob >> 9) & 1) << 5)); }
__device__ __forceinline__ int perm32(int rho) { const int n = rho >> 4, i = rho & 15; return 8 * (i >> 2) + 4 * n + (i & 3); }
__device__ __forceinline__ void stage_rc(int b, int& R, int& C) { const int st = b / 1024, sb = b % 1024, swz = sb ^ (((sb >> 9) & 1) << 5); R = (st >> 1) * 16 + swz / 64; C = (st & 1) * 32 + (swz % 64) / 2; }

typedef int i32x4v __attribute__((ext_vector_type(4)));
typedef int i32x8v __attribute__((ext_vector_type(8)));
template <int MODE> struct AccT { typedef f32x4 type; }; template <> struct AccT<2> { typedef i32x4v type; };
__device__ __forceinline__ f32x4 acc_f32(f32x4 v) { return v; }
__device__ __forceinline__ f32x4 acc_f32(i32x4v v) { return __builtin_convertvector(v, f32x4); }
template <class Epi, bool ALIGN_EPI, bool SP2, bool GATHER, int MODE>
__device__ __forceinline__ void gemm_pg8(LAS unsigned char* lds, const GemmDesc& g, int G, int cidx, const Epi& E) {
    static_assert(SP2, "only the two-MFMA-blocks-per-barrier-pair loop carries the gather / dual-source staging");
    constexpr bool FP8 = (MODE == 1), I8 = (MODE == 2); typedef typename AccT<MODE>::type acc_t;
    int tid_ = threadIdx.x; asm volatile("" : "+v"(tid_));
    const int tid = tid_, wid = __builtin_amdgcn_readfirstlane(tid >> 6), lane = tid & 63, wr = wid >> 2, wc = wid & 3, fr = lane & 15, fq = lane >> 4;
    const int K = g.K, nt = K / BK, lda = g.lda;
    StaticOrder S; S.init(g.nM, g.nN, G, cidx);
    unsigned voffA[2], voffB[2];
    int stR[2], stC[2];
#pragma unroll
    for (int i = 0; i < 2; ++i) { stage_rc(tid * 16 + i * 8192, stR[i], stC[i]); voffA[i] = (unsigned)(stR[i] * lda + stC[i]) * 2u; voffB[i] = (unsigned)(((stR[i] & ~31) + perm32(stR[i] & 31)) * K + stC[i]) * 2u; }
    unsigned cv[2][2], nv[2][2];
#define PG8_ROWOFF(dst, u_) do { const int t_ = g.mem_pm((u_).pm); const int* ix_ = g.rowidx + t_ * 256; const int rb_ = (t_ >> 4) * SEQ; \
        _Pragma("unroll") for (int h_ = 0; h_ < 2; ++h_) _Pragma("unroll") for (int i_ = 0; i_ < 2; ++i_) dst[h_][i_] = (unsigned)((rb_ + ix_[128 * h_ + stR[i_]]) * lda + stC[i_]) * 2u; } while (0)
#define PG8_STAGE_A(bufoff, half, ptr, isnext) do { if constexpr (GATHER) { _Pragma("unroll") for (int _i = 0; _i < 2; ++_i) { const unsigned vo_ = (isnext) ? nv[half][_i] : cv[half][_i]; \
        __builtin_amdgcn_global_load_lds((const unsigned*)((const char*)(ptr) + vo_), (LAS unsigned*)(lds + (bufoff) + ldsw + _i * 8192), 16, 0, 0); } } \
        else { PG8_STAGE(bufoff, (ptr) + (half) * hstepA, voffA); } } while (0)
    const size_t kstep = (size_t)(BK * 2);
    const size_t hstepA = (size_t)HALF * lda * 2, hstepB = (size_t)HALF * K * 2;
    const unsigned ldsw = (unsigned)wid * 1024u;
    const int aoff = lds_byte(wr * 64 + fr, fq * 8), boff = lds_byte(wc * 32 + fr, fq * 8);
#define PG8_SA(b, h) (((b) * 2 + (h)) * HTB)
#define PG8_SB(b, h) ((4 + (b) * 2 + (h)) * HTB)
#define PG8_STAGE(bufoff, gbase, voff) do { _Pragma("unroll") for (int _i = 0; _i < 2; ++_i) \
        __builtin_amdgcn_global_load_lds((const unsigned*)((const char*)(gbase) + (voff)[_i]), (LAS unsigned*)(lds + (bufoff) + ldsw + _i * 8192), 16, 0, 0); } while (0)
#define PG8_LDA(dst, b, h) do { _Pragma("unroll") for (int m = 0; m < 4; ++m) _Pragma("unroll") for (int k = 0; k < 2; ++k) dst[m][k] = *(const LAS bf16x8*)(lds + PG8_SA(b, h) + aoff + m * 2048 + k * 1024); } while (0)
#define PG8_LDB(dst, b, h) do { _Pragma("unroll") for (int n = 0; n < 2; ++n) _Pragma("unroll") for (int k = 0; k < 2; ++k) dst[n][k] = *(const LAS bf16x8*)(lds + PG8_SB(b, h) + boff + n * 2048 + k * 1024); } while (0)
#define PG8_CAT(x) __builtin_shufflevector((i32x4v)(x)[0], (i32x4v)(x)[1], 0, 1, 2, 3, 4, 5, 6, 7)
#define PG8_MMA(ai, bj, At, Bt) do { __builtin_amdgcn_s_setprio(1); _Pragma("unroll") for (int m = 0; m < 4; ++m) _Pragma("unroll") for (int n = 0; n < 2; ++n) { \
        if constexpr (FP8) { const i32x8v b8_ = PG8_CAT(Bt[n]), a8_ = PG8_CAT(At[m]); asm volatile("v_mfma_scale_f32_16x16x128_f8f6f4 %0, %1, %2, %0, %3, %3 op_sel_hi:[0,0,0]" : "+v"(acc[ai][bj][m][n]) : "v"(b8_), "v"(a8_), "v"(sc127)); } \
        else if constexpr (I8) { _Pragma("unroll") for (int k = 0; k < 2; ++k) acc[ai][bj][m][n] = __builtin_amdgcn_mfma_i32_16x16x64_i8((i32x4v)Bt[n][k], (i32x4v)At[m][k], acc[ai][bj][m][n], 0, 0, 0); } \
        else { _Pragma("unroll") for (int k = 0; k < 2; ++k) acc[ai][bj][m][n] = __builtin_amdgcn_mfma_f32_16x16x32_bf16(Bt[n][k], At[m][k], acc[ai][bj][m][n], 0, 0, 0); } } __builtin_amdgcn_s_setprio(0); } while (0)
#define PG8_WAIT_V(n) asm volatile("s_waitcnt vmcnt(" #n ")" ::: "memory")
#define PG8_WAIT_L(n) asm volatile("s_waitcnt lgkmcnt(" #n ")" ::: "memory")
#define PG8_BAR __builtin_amdgcn_s_barrier()
#define PG8_SCHED __builtin_amdgcn_sched_barrier(0)
    Unit cur, nxt; int ui = 0;
    if (!S.next(0, cur)) return;
    acc_t acc[2][2][4][2];
#pragma unroll
    for (int a = 0; a < 2; ++a)
#pragma unroll
        for (int b = 0; b < 2; ++b)
#pragma unroll
            for (int m = 0; m < 4; ++m)
#pragma unroll
                for (int n = 0; n < 2; ++n) acc[a][b][m][n] = (acc_t){0, 0, 0, 0};
    bf16x8 At[4][2], B0[2][2], B1[2][2];
    int sc127 = 0x7f7f7f7f; asm volatile("" : "+v"(sc127));
    const char* cA = GATHER ? (const char*)g.A : (const char*)g.a_ptr(cur); const char* cB = (const char*)g.b_ptr(cur);
    const char* cA2 = cA; if constexpr (Epi::DUAL) cA2 = (const char*)g.a2_ptr(cur) - 2 * kstep;
    typename Epi::Early ea; E.early(ea, g.mem_pm(cur.pm), 64 * wr + fr);
    if constexpr (GATHER) {
        PG8_ROWOFF(cv, cur);
        if (S.next(1, nxt)) PG8_ROWOFF(nv, nxt); else { _Pragma("unroll") for (int h_ = 0; h_ < 2; ++h_) _Pragma("unroll") for (int i_ = 0; i_ < 2; ++i_) nv[h_][i_] = cv[h_][i_]; }
        asm volatile("" : "+v"(cv[0][0]), "+v"(cv[0][1]), "+v"(cv[1][0]), "+v"(cv[1][1]), "+v"(nv[0][0]), "+v"(nv[0][1]), "+v"(nv[1][0]), "+v"(nv[1][1]));
    }
    if constexpr (SP2) {
        PG8_STAGE(PG8_SB(0, 0), cB, voffB); PG8_STAGE(PG8_SB(0, 1), cB + hstepB, voffB); PG8_STAGE_A(PG8_SA(0, 0), 0, cA, false); PG8_STAGE_A(PG8_SA(0, 1), 1, cA, false);
        if (wr == 1) PG8_BAR;
        PG8_WAIT_V(2); PG8_BAR;
        PG8_STAGE(PG8_SB(1, 0), cB + kstep, voffB); PG8_STAGE_A(PG8_SA(1, 0), 0, cA + kstep, false); PG8_STAGE(PG8_SB(1, 1), cB + hstepB + kstep, voffB);
        PG8_WAIT_V(6); PG8_BAR;
    }
    for (;;) {
        const bool has_next = S.next(ui + 1, nxt);
        const char* nA = GATHER ? cA : (has_next ? (const char*)g.a_ptr(nxt) : cA); const char* nB = has_next ? (const char*)g.b_ptr(nxt) : cB;
        const char* nA2 = cA2; if constexpr (Epi::DUAL) { if (has_next) nA2 = (const char*)g.a2_ptr(nxt) - 2 * kstep; }
        for (int t = 0; t < nt; t += 2) {
            const bool last = (t == nt - 2);
            const char* a1 = ((Epi::DUAL && t >= 2) ? cA2 : cA) + (size_t)(t + 1) * kstep;
            const char* a2 = last ? nA : (Epi::DUAL ? cA2 : cA) + (size_t)(t + 2) * kstep; const char* b2 = last ? nB : cB + (size_t)(t + 2) * kstep;
            const char* a3 = a2 + kstep; const char* b3 = b2 + kstep;
            if constexpr (SP2) {
            PG8_LDB(B0, 0, 0); PG8_LDB(B1, 0, 1); PG8_SCHED; PG8_LDA(At, 0, 0); PG8_STAGE_A(PG8_SA(1, 1), 1, a1, false);
            PG8_WAIT_V(8); PG8_WAIT_L(0); PG8_BAR; PG8_MMA(0, 0, At, B0); PG8_MMA(0, 1, At, B1); PG8_BAR; PG8_SCHED;
            PG8_LDA(At, 0, 1); PG8_STAGE(PG8_SB(0, 0), b2, voffB); PG8_STAGE(PG8_SB(0, 1), b2 + hstepB, voffB); PG8_STAGE_A(PG8_SA(0, 0), 0, a2, last);
            PG8_WAIT_V(8); PG8_WAIT_L(0); PG8_BAR; PG8_MMA(1, 0, At, B0); PG8_MMA(1, 1, At, B1); PG8_BAR; PG8_SCHED;
            PG8_LDB(B0, 1, 0); PG8_LDB(B1, 1, 1); PG8_SCHED; PG8_LDA(At, 1, 0); PG8_STAGE_A(PG8_SA(0, 1), 1, a2, last);
            PG8_WAIT_V(8); PG8_WAIT_L(0); PG8_BAR; PG8_MMA(0, 0, At, B0); PG8_MMA(0, 1, At, B1); PG8_BAR; PG8_SCHED;
            PG8_LDA(At, 1, 1); PG8_STAGE(PG8_SB(1, 0), b3, voffB); PG8_STAGE(PG8_SB(1, 1), b3 + hstepB, voffB); PG8_STAGE_A(PG8_SA(1, 0), 0, a3, last);
            PG8_WAIT_V(8); PG8_WAIT_L(0); PG8_BAR; PG8_MMA(1, 0, At, B0); PG8_MMA(1, 1, At, B1); PG8_BAR; PG8_SCHED;
            }
            if constexpr (Epi::DUAL && MODE == 0) { if (t == 0) {
                const int mpm_t = g.mem_pm(cur.pm); int fr_t = fr, fq_t = fq; asm volatile("" : "+v"(fr_t), "+v"(fq_t));
                const int rbase = 64 * wr + fr_t, c8 = 32 * wc + 8 * fq_t, pn_ = cur.pn;
                typename Epi::TCtx tc; E.t_begin(tc, mpm_t, pn_, c8);
                typename Epi::TPre tp[3];
                E.t_prefetch(tp[0], mpm_t, pn_, rbase, c8); E.t_prefetch(tp[1], mpm_t, pn_, 16 + rbase, c8);
#pragma unroll
                for (int gi = 0; gi < 8; ++gi) {
                    if (gi + 2 < 8) { const int gn = gi + 2; E.t_prefetch(tp[gn % 3], mpm_t, pn_, 128 * (gn >> 2) + 16 * (gn & 3) + rbase, c8); }
                    E.t_apply(tc, tp[gi % 3], acc[gi >> 2][0][gi & 3][0], acc[gi >> 2][0][gi & 3][1], acc[gi >> 2][1][gi & 3][0], acc[gi >> 2][1][gi & 3][1]);
                    __builtin_amdgcn_sched_barrier(0);
                }
            } }
        }
        if constexpr (FP8) asm volatile("s_nop 15\n\ts_nop 15" ::: "memory");
        if constexpr (ALIGN_EPI) { if (wr == 0) PG8_BAR; }
        {
            const int mpm = g.mem_pm(cur.pm);
            int fr_e = fr, fq_e = fq; asm volatile("" : "+v"(fr_e), "+v"(fq_e));
            const int rbase = 64 * wr + fr_e, c8 = 32 * wc + 8 * fq_e, pn_ = cur.pn;
            typename Epi::Ctx ctx; E.begin(ctx, mpm, pn_, c8, rbase);
            typename Epi::Pre pre[3];
            if constexpr (Epi::DIST > 0) { E.prefetch(pre[0], mpm, pn_, rbase, c8); if constexpr (Epi::DIST > 1) E.prefetch(pre[1], mpm, pn_, 16 + rbase, c8); }
#pragma unroll
            for (int gi = 0; gi < 8; ++gi) {
                if constexpr (Epi::DIST > 0) { if (gi + Epi::DIST < 8) { const int gn = gi + Epi::DIST; E.prefetch(pre[gn % 3], mpm, pn_, 128 * (gn >> 2) + 16 * (gn & 3) + rbase, c8); } }
                E.finish(ea, ctx, pre[gi % 3], gi, mpm, pn_, 128 * (gi >> 2) + 16 * (gi & 3) + rbase, c8, acc_f32(acc[gi >> 2][0][gi & 3][0]), acc_f32(acc[gi >> 2][0][gi & 3][1]), acc_f32(acc[gi >> 2][1][gi & 3][0]), acc_f32(acc[gi >> 2][1][gi & 3][1]));
                __builtin_amdgcn_sched_barrier(0);
            }
        }
        if (!has_next) break;
        if constexpr (GATHER) {
            _Pragma("unroll") for (int h_ = 0; h_ < 2; ++h_) _Pragma("unroll") for (int i_ = 0; i_ < 2; ++i_) cv[h_][i_] = nv[h_][i_];
            Unit nn; if (S.next(ui + 2, nn)) { PG8_ROWOFF(nv, nn); }
            asm volatile("" : "+v"(nv[0][0]), "+v"(nv[0][1]), "+v"(nv[1][0]), "+v"(nv[1][1]));
        }
#pragma unroll
        for (int a = 0; a < 2; ++a)
#pragma unroll
            for (int b = 0; b < 2; ++b)
#pragma unroll
                for (int m = 0; m < 4; ++m)
#pragma unroll
                    for (int n = 0; n < 2; ++n) acc[a][b][m][n] = (acc_t){0, 0, 0, 0};
        cur = nxt; cA = nA; cB = nB; cA2 = nA2; ++ui;
        E.early(ea, g.mem_pm(cur.pm), 64 * wr + fr);
        if constexpr (ALIGN_EPI) { if (wr == 1) PG8_BAR; }
    }
    PG8_WAIT_V(0);
    if constexpr (!ALIGN_EPI) { if (wr == 0) PG8_BAR; }
    PG8_BAR;
#undef PG8_SA
#undef PG8_SB
#undef PG8_STAGE
#undef PG8_STAGE_A
#undef PG8_ROWOFF
#undef PG8_LDA
#undef PG8_LDB
#undef PG8_MMA
#undef PG8_CAT
#undef PG8_WAIT_V
#undef PG8_WAIT_L
#undef PG8_BAR
#undef PG8_SCHED
}

template <int ID, class Epi>
__device__ __forceinline__ void gemm_phase(LAS unsigned char* lds, const GemmDesc& g, int G, int cidx, const Epi& E) { gemm_pg8<Epi, true, true, ID == 5, ID == 6 ? 1 : ((ID == 1 || ID == 5 || ID == 7) ? 2 : 0)>(lds, g, G, cidx, E); }

struct Args { const float* in[24]; float* out; unsigned char* ws; };
enum { I_X = 0, I_P, I_N1G, I_WIN, I_BGATE, I_CONVW, I_CONVB, I_LNG, I_LNB, I_WCO, I_WPOOL, I_PSCALE, I_WOUT, I_N2G, I_WR, I_WEG, I_WEU, I_WED, I_N3G, I_WPG, I_BPG, I_WPLE, I_PNG, I_FG };

struct TrItem { const float* W; bf16_t* WT; const float* kscale; int K, N, k0, n0, drow0, ldt, kofs, f8; };
__device__ __forceinline__ void tr_load(const TrItem& t, f32x4 (&v)[16], float (&ks)[16], int lane) {
    const int cq = 4 * (lane & 15), rq = lane >> 4;
#pragma unroll
    for (int i = 0; i < 16; ++i) v[i] = __builtin_nontemporal_load((const f32x4*)(t.W + (size_t)(t.k0 + 4 * i + rq) * t.N + t.n0 + cq));
    const float* kp = t.kscale ? t.kscale : t.W;
#pragma unroll
    for (int i = 0; i < 16; ++i) ks[i] = kp[t.k0 + 4 * i + rq];
}
__device__ __forceinline__ void tr_store(const TrItem& t, const f32x4 (&v)[16], const float (&ks)[16], LAS float* scr, int lane) {
    const int cq = 4 * (lane & 15), rq = lane >> 4; const bool sc = t.kscale != nullptr; const float mul = t.f8 == 1 ? W8_SCALE : (t.f8 == 2 ? WQ_SCALE : 1.0f);
#pragma unroll
    for (int i = 0; i < 16; ++i) { const float f = (sc ? ks[i] : 1.0f) * mul; LAS float* p = scr + (4 * i + rq) * 65 + cq; p[0] = v[i].x * f; p[1] = v[i].y * f; p[2] = v[i].z * f; p[3] = v[i].w * f; }
    LDS_WAIT();
    if (t.f8) {
        const int c4 = lane & 3; unsigned char* W8 = (unsigned char*)t.WT;
#pragma unroll
        for (int j = 0; j < 4; ++j) { const int n = (lane >> 2) + 16 * j; const LAS float* sp = scr + (16 * c4) * 65 + n; u32x4 o;
            if (t.f8 == 1) { o.x = pk_fp8x4(sp[0 * 65], sp[1 * 65], sp[2 * 65], sp[3 * 65]); o.y = pk_fp8x4(sp[4 * 65], sp[5 * 65], sp[6 * 65], sp[7 * 65]);
                o.z = pk_fp8x4(sp[8 * 65], sp[9 * 65], sp[10 * 65], sp[11 * 65]); o.w = pk_fp8x4(sp[12 * 65], sp[13 * 65], sp[14 * 65], sp[15 * 65]); }
            else { o.x = q8x4(clamp127(sp[0 * 65]), clamp127(sp[1 * 65]), clamp127(sp[2 * 65]), clamp127(sp[3 * 65])); o.y = q8x4(clamp127(sp[4 * 65]), clamp127(sp[5 * 65]), clamp127(sp[6 * 65]), clamp127(sp[7 * 65]));
                o.z = q8x4(clamp127(sp[8 * 65]), clamp127(sp[9 * 65]), clamp127(sp[10 * 65]), clamp127(sp[11 * 65])); o.w = q8x4(clamp127(sp[12 * 65]), clamp127(sp[13 * 65]), clamp127(sp[14 * 65]), clamp127(sp[15 * 65])); }
            __builtin_nontemporal_store(o, (u32x4*)(W8 + (size_t)(t.drow0 + n) * t.ldt + t.kofs + t.k0 + 16 * c4)); }
        LDS_WAIT(); return;
    }
    const int c = lane & 7;
#pragma unroll
    for (int j = 0; j < 8; ++j) { const int n = (lane >> 3) + 8 * j; const LAS float* sp = scr + (8 * c) * 65 + n;
        u32x4 o; o.x = pk2(sp[0 * 65], sp[1 * 65]); o.y = pk2(sp[2 * 65], sp[3 * 65]); o.z = pk2(sp[4 * 65], sp[5 * 65]); o.w = pk2(sp[6 * 65], sp[7 * 65]);
        __builtin_nontemporal_store(o, (u32x4*)(t.WT + (size_t)(t.drow0 + n) * t.ldt + t.kofs + t.k0 + 8 * c)); }
    LDS_WAIT();
}
constexpr int IT_WIN = (DM / 64) * (INC / 64);
constexpr int IT_WC = (CD / 64) * (DM / 64);
constexpr int IT_WP = 4 * (128 / 64) * (256 / 64);
constexpr int IT_SQ = (DM / 64) * (DM / 64);
constexpr int IT_WPLE = (PLE / 64) * (DM / 64);
constexpr int IT_EXP = NE * IT_SQ;
constexpr int IT_TOTAL = IT_WIN + IT_WC + IT_WP + IT_SQ + IT_SQ + IT_WPLE + 3 * IT_EXP;
constexpr int IT_SMALL = IT_TOTAL - 3 * IT_EXP;
constexpr int IT_P1 = 4608;
__device__ __forceinline__ TrItem tr_decode(const Args& a, int it) {
    unsigned char* ws = a.ws; TrItem t; t.kscale = nullptr; t.f8 = 0;
    int r = it;
    if (r < IT_WIN) {
        const int nblk = INC / 64, kb = r / nblk, nb = r % nblk, n0 = 64 * nb; int d0;
        if (n0 < 512) d0 = 256 * (n0 >> 7) + (n0 & 127); else if (n0 < 1024) d0 = 256 * ((n0 - 512) >> 7) + 128 + (n0 & 127); else d0 = n0;
        t.W = a.in[I_WIN]; t.WT = (bf16_t*)(ws + WS_WIN); t.K = DM; t.N = INC; t.k0 = 64 * kb; t.n0 = n0; t.drow0 = d0; t.kscale = a.in[I_N1G]; t.ldt = t.K; t.kofs = 0; t.f8 = 2; return t; }
    r -= IT_WIN;
    if (r < IT_WC) { const int kb = r / 16, nb = r % 16; t.W = a.in[I_WCO]; t.WT = (bf16_t*)(ws + WS_WCAT); t.K = CD; t.N = DM; t.k0 = 64 * kb; t.n0 = 64 * nb; t.drow0 = 64 * nb; t.ldt = 640; t.kofs = 128; return t; }
    r -= IT_WC;
    if (r < IT_WP) { const int gi = r / 8, q = r % 8, kb = q / 4, nb = q % 4;
        t.W = a.in[I_WPOOL] + (size_t)gi * 128 * 256; t.WT = (bf16_t*)(ws + WS_WCAT); t.K = 128; t.N = 256; t.k0 = 64 * kb; t.n0 = 64 * nb; t.drow0 = 256 * gi + 64 * nb; t.ldt = 640; t.kofs = 0; return t; }
    r -= IT_WP;
    if (r < IT_SQ) { const int kb = r / 16, nb = r % 16; t.W = a.in[I_WOUT]; t.WT = (bf16_t*)(ws + WS_WOUT); t.K = DM; t.N = DM; t.k0 = 64 * kb; t.n0 = 64 * nb; t.drow0 = 64 * nb; t.ldt = t.K; t.kofs = 0; return t; }
    r -= IT_SQ;
    if (r < IT_SQ) { const int kb = r / 16, nb = r % 16; t.W = a.in[I_WPG]; t.WT = (bf16_t*)(ws + WS_WPG); t.K = DM; t.N = DM; t.k0 = 64 * kb; t.n0 = 64 * nb; t.drow0 = 64 * nb; t.kscale = a.in[I_N3G]; t.ldt = t.K; t.kofs = 0; t.f8 = 2; return t; }
    r -= IT_SQ;
    if (r < IT_WPLE) { const int kb = r / 16, nb = r % 16; t.W = a.in[I_WPLE]; t.WT = (bf16_t*)(ws + WS_WPLE); t.K = PLE; t.N = DM; t.k0 = 64 * kb; t.n0 = 64 * nb; t.drow0 = 64 * nb; t.ldt = t.K; t.kofs = 0; return t; }
    r -= IT_WPLE;
    if (r < IT_EXP) { const int e = r / IT_SQ, q = r % IT_SQ, kb = q / 16, nb = q % 16, n0 = 64 * nb;
        t.W = a.in[I_WEG] + (size_t)e * DM * FF; t.WT = (bf16_t*)(ws + WS_WGU + (size_t)e * 2048 * DM); t.K = DM; t.N = FF; t.k0 = 64 * kb; t.n0 = n0; t.drow0 = 256 * (n0 >> 7) + (n0 & 127); t.kscale = a.in[I_N2G]; t.ldt = t.K; t.kofs = 0; t.f8 = 2; return t; }
    r -= IT_EXP;
    if (r < IT_EXP) { const int e = r / IT_SQ, q = r % IT_SQ, kb = q / 16, nb = q % 16, n0 = 64 * nb;
        t.W = a.in[I_WEU] + (size_t)e * DM * FF; t.WT = (bf16_t*)(ws + WS_WGU + (size_t)e * 2048 * DM); t.K = DM; t.N = FF; t.k0 = 64 * kb; t.n0 = n0; t.drow0 = 256 * (n0 >> 7) + 128 + (n0 & 127); t.kscale = a.in[I_N2G]; t.ldt = t.K; t.kofs = 0; t.f8 = 2; return t; }
    r -= IT_EXP;
    { const int e = r / IT_SQ, q = r % IT_SQ, kb = q / 16, nb = q % 16;
        t.W = a.in[I_WED] + (size_t)e * FF * DM; t.WT = (bf16_t*)(ws + WS_WD + (size_t)e * DM * FF); t.K = FF; t.N = DM; t.k0 = 64 * kb; t.n0 = 64 * nb; t.drow0 = 64 * nb; t.ldt = t.K; t.kofs = 0; t.f8 = 1; return t; }
}
__device__ __forceinline__ void phase0(const Args& a, LAS unsigned char* lds, int gw, int NGW, int wave, int lane, int lo1, int n1, int lo2, int n2, bool do_rows) {
    unsigned char* ws = a.ws;
    LAS float* scr = (LAS float*)(lds + wave * 16640);
    {
        f32x4 v[16], vn[16]; float ks[16], ksn[16]; TrItem cur, nxt;
        const int nj = n1 + n2;
#define P0_JOB(j) ((j) < n1 ? lo1 + (j) : lo2 + ((j) - n1))
        int j = gw;
        if (j < nj) { cur = tr_decode(a, P0_JOB(j)); tr_load(cur, v, ks, lane); }
        for (; j < nj; j += NGW) {
            const bool has_next = j + NGW < nj;
            if (has_next) { nxt = tr_decode(a, P0_JOB(j + NGW)); tr_load(nxt, vn, ksn, lane); }
            tr_store(cur, v, ks, scr, lane);
            if (has_next) { cur = nxt;
#pragma unroll
                for (int i = 0; i < 16; ++i) { v[i] = vn[i]; ks[i] = ksn[i]; } }
        }
#undef P0_JOB
    }
    if (!do_rows) return;
    const float* x = a.in[I_X]; bf16_t* XN = (bf16_t*)(ws + WS_XN); float* RS0 = (float*)(ws + WS_RSTD0); unsigned char* XQ = ws + WS_XQ;
    f32x4 nx[4];
#define P0_ISSUE(mrow) do { _Pragma("unroll") for (int j = 0; j < 2; ++j) { nx[2 * j] = __builtin_nontemporal_load((const f32x4*)(x + (size_t)(mrow) * DM + 512 * j + 8 * lane)); nx[2 * j + 1] = __builtin_nontemporal_load((const f32x4*)(x + (size_t)(mrow) * DM + 512 * j + 8 * lane + 4)); } } while (0)
    if (gw < NT) P0_ISSUE(gw);
    for (int m = gw; m < NT; m += NGW) {
        f32x4 v[4]; float s = 0.f, mx = 0.f;
#pragma unroll
        for (int j = 0; j < 4; ++j) { v[j] = nx[j]; s += (v[j].x * v[j].x + v[j].y * v[j].y) + (v[j].z * v[j].z + v[j].w * v[j].w);
            mx = fmaxf(fmaxf(mx, fmaxf(fabsf(v[j].x), fabsf(v[j].y))), fmaxf(fabsf(v[j].z), fabsf(v[j].w))); }
        if (m + NGW < NT) P0_ISSUE(m + NGW);
        const float rstd = rsqrtf(wave_sum(s) * (1.0f / DM) + EPS);
#pragma unroll
        for (int o = 1; o < 64; o <<= 1) mx = fmaxf(mx, __shfl_xor(mx, o));
        mx = fmaxf(mx, 1e-30f); const float qs = 127.0f * __builtin_amdgcn_rcpf(mx);
        if (lane == 0) RS0[m] = rstd * (mx * (1.0f / 127.0f)) * WQ_INV;
#pragma unroll
        for (int j = 0; j < 2; ++j) { store_bf8(XN + (size_t)m * DM + 512 * j + 8 * lane, v[2 * j], v[2 * j + 1]);
            u32x2 q; q.x = q8x4s(v[2 * j], qs); q.y = q8x4s(v[2 * j + 1], qs);
            *(u32x2*)(XQ + (size_t)m * DM + 512 * j + 8 * lane) = q; }
    }
#undef P0_ISSUE
}

template <int HALF>
__device__ __forceinline__ void pool_unit(const LAS unsigned* Us, bf16_t* PDo, int th, int cp, int t0, int s0) {
    constexpr int NR = 7 + 2 * HALF;
    float r0[NR], r1[NR];
#pragma unroll
    for (int i = 0; i < NR; ++i) { const unsigned pu = Us[(8 * th + 8 - HALF + i) * 256 + cp]; r0[i] = bf_lo(pu); r1[i] = bf_hi(pu); }
    float p0 = 0.f, p1 = 0.f;
#pragma unroll
    for (int i = 0; i < 2 * HALF; ++i) { p0 += r0[i]; p1 += r1[i]; }
#pragma unroll
    for (int j = 0; j < 8; ++j) {
        const int s = s0 + 8 * th + j;
        const int lo = (s - HALF) > 0 ? (s - HALF) : 0, hi = (s + HALF - 1) < (SEQ - 1) ? (s + HALF - 1) : (SEQ - 1);
        const float inv = __builtin_amdgcn_rcpf((float)(hi - lo + 1));
        *(unsigned*)(PDo + ((size_t)(t0 + 8 * th + j)) * PDIM + 2 * cp) = pk2(p0 * inv - r0[j + HALF], p1 * inv - r1[j + HALF]);
        if (j < 7) { p0 += r0[j + 2 * HALF] - r0[j]; p1 += r1[j + 2 * HALF] - r1[j]; }
    }
}
__device__ __forceinline__ float wave_reduce16(const float (&v)[16], int lane) {
    float t8[8], t4[4], t2[2], t1;
    const bool b5 = (lane & 32) != 0, b4 = (lane & 16) != 0, b3 = (lane & 8) != 0, b2 = (lane & 4) != 0;
#pragma unroll
    for (int i = 0; i < 8; ++i) { const float send = b5 ? v[i] : v[i + 8], keep = b5 ? v[i + 8] : v[i]; t8[i] = keep + __shfl_xor(send, 32); }
#pragma unroll
    for (int i = 0; i < 4; ++i) { const float send = b4 ? t8[i] : t8[i + 4], keep = b4 ? t8[i + 4] : t8[i]; t4[i] = keep + __shfl_xor(send, 16); }
#pragma unroll
    for (int i = 0; i < 2; ++i) { const float send = b3 ? t4[i] : t4[i + 2], keep = b3 ? t4[i + 2] : t4[i]; t2[i] = keep + __shfl_xor(send, 8); }
    { const float send = b2 ? t2[0] : t2[1], keep = b2 ? t2[1] : t2[0]; t1 = keep + __shfl_xor(send, 4); }
    t1 += __shfl_xor(t1, 2); t1 += __shfl_xor(t1, 1);
    return t1;
}
__device__ __forceinline__ void phase2(const Args& a, LAS unsigned char* lds, int G, int cidx) {
    unsigned char* ws = a.ws;
    const bf16_t* V = (const bf16_t*)(ws + WS_V); const bf16_t* U = (const bf16_t*)(ws + WS_U);
    bf16_t* CS = (bf16_t*)(ws + WS_CS); bf16_t* PDo = (bf16_t*)(ws + WS_PD);
    LAS unsigned* Vs = (LAS unsigned*)lds;
    LAS unsigned* Us = Vs + 46 * 256;
    LAS float* red = (LAS float*)(Us + 31 * 256);
    int tid_ = threadIdx.x; asm volatile("" : "+v"(tid_));
    const int tid = tid_, cp = tid & 255, th = tid >> 8, wave = tid >> 6, lane = tid & 63;
    float w0[CWID], w1[CWID];
#pragma unroll
    for (int k = 0; k < CWID; ++k) { typedef float f32x2_ __attribute__((ext_vector_type(2))); const f32x2_ wv = *(const f32x2_*)(a.in[I_CONVW] + k * CD + 2 * cp); w0[k] = wv.x; w1[k] = wv.y; }
    const float cb0 = a.in[I_CONVB][2 * cp], cb1 = a.in[I_CONVB][2 * cp + 1];
    const float lg0 = a.in[I_LNG][2 * cp], lg1 = a.in[I_LNG][2 * cp + 1], lb0 = a.in[I_LNB][2 * cp], lb1 = a.in[I_LNB][2 * cp + 1];
    float cb0_ = cb0, cb1_ = cb1, lg0_ = lg0, lg1_ = lg1, lb0_ = lb0, lb1_ = lb1;
#pragma unroll
    for (int k = 0; k < CWID; ++k) asm volatile("" : "+v"(w0[k]), "+v"(w1[k]));
    asm volatile("" : "+v"(cb0_), "+v"(cb1_), "+v"(lg0_), "+v"(lg1_), "+v"(lb0_), "+v"(lb1_));
    const int grp = cp >> 6;
    const int NU = NT / 16, per = (NU + G - 1) / G;
    const int u_begin = cidx * per, u_end = (u_begin + per) < NU ? (u_begin + per) : NU;
    u32x4 pre[10];
#define P2_FETCH(unit) do { const int t0_ = (unit) * 16, b_ = t0_ / SEQ, s0_ = t0_ % SEQ; \
    _Pragma("unroll") for (int i = 0; i < 6; ++i) { const int q = tid + NTHREADS * i, r = (q >> 6) < 45 ? (q >> 6) : 45, ch = q & 63, sq = s0_ - 15 + r; \
        const int sc = sq < 0 ? 0 : (sq > SEQ - 1 ? SEQ - 1 : sq);     \
        pre[i] = *(const u32x4*)(V + ((size_t)(b_ * SEQ + sc)) * CD + ch * 8); } \
    _Pragma("unroll") for (int i = 0; i < 4; ++i) { const int q = tid + NTHREADS * i, r = (q >> 6) < 30 ? (q >> 6) : 30, ch = q & 63, sq = s0_ - 8 + r; \
        const int sc = sq < 0 ? 0 : (sq > SEQ - 1 ? SEQ - 1 : sq); \
        pre[6 + i] = *(const u32x4*)(U + ((size_t)(b_ * SEQ + sc)) * PDIM + ch * 8); } } while (0)
    if (u_begin < u_end) P2_FETCH(u_begin);
    for (int unit = u_begin; unit < u_end; ++unit) {
        const int t0 = unit * 16, s0 = t0 % SEQ;
        __syncthreads();
#pragma unroll
        for (int i = 0; i < 6; ++i) { const int q = tid + NTHREADS * i, sq = s0 - 15 + (q >> 6); const unsigned msk = (sq >= 0 && sq < SEQ) ? 0xffffffffu : 0u;
            if (q < 46 * 64) *(LAS u32x4*)(Vs + (q >> 6) * 256 + (q & 63) * 4) = (u32x4){pre[i].x & msk, pre[i].y & msk, pre[i].z & msk, pre[i].w & msk}; }
#pragma unroll
        for (int i = 0; i < 4; ++i) { const int q = tid + NTHREADS * i, sq = s0 - 8 + (q >> 6); const unsigned msk = (sq >= 0 && sq < SEQ) ? 0xffffffffu : 0u;
            if (q < 31 * 64) *(LAS u32x4*)(Us + (q >> 6) * 256 + (q & 63) * 4) = (u32x4){pre[6 + i].x & msk, pre[6 + i].y & msk, pre[6 + i].z & msk, pre[6 + i].w & msk}; }
        __syncthreads();
        if (unit + 1 < u_end) P2_FETCH(unit + 1);
        float a0[8], a1[8];
        {
            typedef float f32x2_ __attribute__((ext_vector_type(2)));
            f32x2_ ac[8];
#pragma unroll
            for (int j = 0; j < 8; ++j) ac[j] = (f32x2_){cb0_, cb1_};
            unsigned rowv[38];
#pragma unroll
            for (int r = 0; r < 38; ++r) rowv[r] = Vs[(8 * th + r) * 256 + cp];
            __builtin_amdgcn_sched_barrier(0);
#pragma unroll
            for (int r = 0; r < 38; ++r) {
                const f32x2_ xv = (f32x2_){bf_lo(rowv[r]), bf_hi(rowv[r])};
#pragma unroll
                for (int j = 0; j < 8; ++j) { const int k = r - j; if (k >= 0 && k < CWID) ac[j] = __builtin_elementwise_fma(xv, (f32x2_){w0[k], w1[k]}, ac[j]); }
            }
#pragma unroll
            for (int j = 0; j < 8; ++j) { a0[j] = ac[j].x; a1[j] = ac[j].y; }
        }
        float sv[16];
#pragma unroll
        for (int j = 0; j < 8; ++j) { sv[j] = a0[j] + a1[j]; sv[8 + j] = a0[j] * a0[j] + a1[j] * a1[j]; }
        const float tot = wave_reduce16(sv, lane);
        if ((lane & 3) == 0) red[wave * 16 + (lane >> 2)] = tot;
        __syncthreads();
#pragma unroll
        for (int j = 0; j < 8; ++j) {
            float t1 = 0.f, t2 = 0.f;
#pragma unroll
            for (int w = 0; w < 4; ++w) { t1 += red[(4 * th + w) * 16 + j]; t2 += red[(4 * th + w) * 16 + 8 + j]; }
            const float mean = t1 * (1.0f / CD); float var = t2 * (1.0f / CD) - mean * mean; var = var > 0.f ? var : 0.f;
            const float rstd = rsqrtf(var + EPS);
            const float y0 = (a0[j] - mean) * rstd * lg0_ + lb0_, y1 = (a1[j] - mean) * rstd * lg1_ + lb1_;
            *(unsigned*)(CS + ((size_t)(t0 + 8 * th + j)) * CD + 2 * cp) = pk2(y0 * sigm(y0), y1 * sigm(y1));
        }
        switch (grp) {
            case 0: pool_unit<1>(Us, PDo, th, cp, t0, s0); break;
            case 1: pool_unit<2>(Us, PDo, th, cp, t0, s0); break;
            case 2: pool_unit<4>(Us, PDo, th, cp, t0, s0); break;
            default: pool_unit<8>(Us, PDo, th, cp, t0, s0); break;
        }
    }
#undef P2_FETCH
    __syncthreads();
}

__device__ __forceinline__ void phase6(const Args& a, LAS unsigned char* lds, int gw, int NGW, int lane) {
    unsigned char* ws = a.ws;
    constexpr int WST = DM + 8;
    LAS bf16_t* WH = (LAS bf16_t*)lds; LAS bf16_t* WL = WH + NE * WST;
    { int t_ = threadIdx.x; asm volatile("" : "+v"(t_));
      for (int q = t_; q < DM * NE; q += NTHREADS) { const int d = q >> 4, e = q & 15; const float w = a.in[I_WR][q] * a.in[I_N2G][d];
          const unsigned hi = f2bf(w); const float rem = w - __uint_as_float(hi << 16); WH[e * WST + d] = (bf16_t)hi; WL[e * WST + d] = (bf16_t)f2bf(rem); } }
    __syncthreads();
    const bf16_t* X1 = (const bf16_t*)(ws + WS_X1B); float* RS1 = (float*)(ws + WS_RSTD1); float* AFF = (float*)(ws + WS_AFF); unsigned char* X1Q = ws + WS_X1Q;
    const int fr = lane & 15, fq = lane >> 4;
    for (int grp = gw; grp < NT / 16; grp += NGW) {
        const int row0 = grp * 16;
        const bf16_t* xp = X1 + (size_t)(row0 + fr) * DM + 8 * fq;
        bf16x8 af[32];
#pragma unroll
        for (int sidx = 0; sidx < 32; ++sidx) af[sidx] = *(const bf16x8*)(xp + 32 * sidx);
        f32x4 acc = (f32x4){0.f, 0.f, 0.f, 0.f}; float ss = 0.f, mx = 0.f;
#pragma unroll
        for (int sidx = 0; sidx < 32; ++sidx) {
            if ((sidx & 3) == 0) asm volatile("" ::: "memory");
            const bf16x8 bh = *(const LAS bf16x8*)(WH + fr * WST + 32 * sidx + 8 * fq), bl = *(const LAS bf16x8*)(WL + fr * WST + 32 * sidx + 8 * fq);
            acc = __builtin_amdgcn_mfma_f32_16x16x32_bf16(af[sidx], bh, acc, 0, 0, 0);
            acc = __builtin_amdgcn_mfma_f32_16x16x32_bf16(af[sidx], bl, acc, 0, 0, 0);
#pragma unroll
            for (int j = 0; j < 8; ++j) { const float xv = __uint_as_float(((unsigned)(unsigned short)af[sidx][j]) << 16); ss += xv * xv; mx = fmaxf(mx, fabsf(xv)); }
        }
        ss += __shfl_xor(ss, 16); ss += __shfl_xor(ss, 32);
        const float rstd = rsqrtf(ss * (1.0f / DM) + EPS);
        mx = fmaxf(mx, __shfl_xor(mx, 16)); mx = fmaxf(mx, __shfl_xor(mx, 32)); mx = fmaxf(mx, 1e-30f);
        if (fq == 0) RS1[row0 + fr] = rstd * (mx * (1.0f / 127.0f)) * WQ_INV;
        { const float qs = 127.0f * __builtin_amdgcn_rcpf(mx); unsigned char* qp = X1Q + (size_t)(row0 + fr) * DM + 8 * fq;
#pragma unroll
          for (int sidx = 0; sidx < 32; ++sidx) { asm volatile("" : "+v"(af[sidx]));
              const u32x4 w = __builtin_bit_cast(u32x4, af[sidx]);
              u32x2 q; q.x = q8x4s((f32x4){bf_lo(w.x), bf_hi(w.x), bf_lo(w.y), bf_hi(w.y)}, qs); q.y = q8x4s((f32x4){bf_lo(w.z), bf_hi(w.z), bf_lo(w.w), bf_hi(w.w)}, qs); *(u32x2*)(qp + 32 * sidx) = q; } }
        f32x4 av;
#pragma unroll
        for (int r = 0; r < 4; ++r) {
            const float lg = acc[r] * __shfl(rstd, 4 * fq + r);
            float mx = lg;
#pragma unroll
            for (int o2 = 1; o2 < 16; o2 <<= 1) mx = fmaxf(mx, __shfl_xor(mx, o2));
            const float pe = __expf(lg - mx); float den = pe;
#pragma unroll
            for (int o2 = 1; o2 < 16; o2 <<= 1) den += __shfl_xor(den, o2);
            av[r] = pe / den;
        }
        *(f32x4*)(AFF + ((size_t)((row0 / SEQ) * NE + fr)) * SEQ + (row0 % SEQ) + 4 * fq) = av;
    }
    __syncthreads();
}

__device__ __forceinline__ void phase7(const Args& a, LAS unsigned char* lds, int G, int cidx) {
    unsigned char* ws = a.ws;
    const float* AFF = (const float*)(ws + WS_AFF); int* IDX = (int*)(ws + WS_IDX); float* VAL = (float*)(ws + WS_VAL); int* INV = (int*)(ws + WS_INV);
    const float* RS1 = (const float*)(ws + WS_RSTD1); float* RSV = (float*)(ws + WS_RSV);
    LAS int* cnt = (LAS int*)lds;
    LAS int* wtot = cnt + 48;
    int tid_ = threadIdx.x; asm volatile("" : "+v"(tid_));
    const int tid = tid_, wave = tid >> 6, lane = tid & 63;
    for (int be = cidx; be < NB * NE; be += G) {
        const int b = be >> 4, e = be & 15;
        __syncthreads();
        unsigned v[4];
        { const f32x4 t4 = *(const f32x4*)(AFF + (size_t)be * SEQ + 4 * tid); v[0] = __float_as_uint(t4.x); v[1] = __float_as_uint(t4.y); v[2] = __float_as_uint(t4.z); v[3] = __float_as_uint(t4.w); }
        unsigned T = 0u;
        {
            const unsigned cand = 1u << 30; int c = 0;
#pragma unroll
            for (int j = 0; j < 4; ++j) c += (int)__popcll(__ballot(v[j] >= cand));
            if (lane == 0) cnt[wave * 3] = c;
            __syncthreads();
            int tot = 0;
#pragma unroll
            for (int w = 0; w < 8; ++w) tot += cnt[w * 3];
            if (tot >= CAP) T = cand;
        }
        for (int step = 0; step < 15; ++step) {
            const int hi = 29 - 2 * step, lo = hi - 1;
            const unsigned c1 = T | (1u << lo), c2 = T | (1u << hi), c3 = c2 | (1u << lo);
            int n1 = 0, n2 = 0, n3 = 0;
#pragma unroll
            for (int j = 0; j < 4; ++j) { n1 += (int)__popcll(__ballot(v[j] >= c1)); n2 += (int)__popcll(__ballot(v[j] >= c2)); n3 += (int)__popcll(__ballot(v[j] >= c3)); }
            LAS int* slot = cnt + 24 * ((step + 1) & 1);
            if (lane == 0) { slot[wave * 3] = n1; slot[wave * 3 + 1] = n2; slot[wave * 3 + 2] = n3; }
            __syncthreads();
            int t1 = 0, t2 = 0, t3 = 0;
#pragma unroll
            for (int w = 0; w < 8; ++w) { t1 += slot[w * 3]; t2 += slot[w * 3 + 1]; t3 += slot[w * 3 + 2]; }
            T = (t3 >= CAP) ? c3 : (t2 >= CAP) ? c2 : (t1 >= CAP) ? c1 : T;
        }
        int mygt = 0, myeq = 0;
#pragma unroll
        for (int j = 0; j < 4; ++j) { mygt += (v[j] > T) ? 1 : 0; myeq += (v[j] == T) ? 1 : 0; }
        const int pk = mygt | (myeq << 16); int inc = pk;
#pragma unroll
        for (int o = 1; o < 64; o <<= 1) { const int t = __shfl_up(inc, o); if (lane >= o) inc += t; }
        __syncthreads();
        if (lane == 63) wtot[wave] = inc;
        __syncthreads();
        int base = 0, total = 0;
#pragma unroll
        for (int w = 0; w < 8; ++w) { const int t = wtot[w]; if (w < wave) base += t; total += t; }
        const int excl = base + inc - pk; int pg = excl & 0xffff, pq = excl >> 16;
        const int ngt = total & 0xffff, need = CAP - ngt;
#pragma unroll
        for (int j = 0; j < 4; ++j) {
            const int tok = 4 * tid + j; int slot = -1;
            if (v[j] > T) { slot = pg + (pq < need ? pq : need); ++pg; }
            else if (v[j] == T) { if (pq < need) slot = pg + pq; ++pq; }
            INV[((size_t)(b * SEQ + tok)) * NE + e] = slot;
            if (slot >= 0) { IDX[be * CAP + slot] = tok; VAL[be * CAP + slot] = __uint_as_float(v[j]) * W8_INV; RSV[be * CAP + slot] = RS1[b * SEQ + tok]; }
        }
    }
    __syncthreads();
}

__device__ __forceinline__ void r16_acc(f32x4 (&v)[4], const u32x4 (&w)[2]) {
#pragma unroll
    for (int j = 0; j < 2; ++j) {
        v[2 * j].x += bf_lo(w[j].x); v[2 * j].y += bf_hi(w[j].x); v[2 * j].z += bf_lo(w[j].y); v[2 * j].w += bf_hi(w[j].y);
        v[2 * j + 1].x += bf_lo(w[j].z); v[2 * j + 1].y += bf_hi(w[j].z); v[2 * j + 1].z += bf_lo(w[j].w); v[2 * j + 1].w += bf_hi(w[j].w);
    }
}
__device__ __forceinline__ void l16_acc_fp8(f32x4 (&v)[4], const u32x4 w) {
    typedef float f2_ __attribute__((ext_vector_type(2)));
    const unsigned wj[4] = {w.x, w.y, w.z, w.w};
#pragma unroll
    for (int j = 0; j < 4; ++j) { const f2_ lo = __builtin_amdgcn_cvt_pk_f32_fp8((int)wj[j], false), hi = __builtin_amdgcn_cvt_pk_f32_fp8((int)wj[j], true);
        v[j].x += lo.x; v[j].y += lo.y; v[j].z += hi.x; v[j].w += hi.y; }
}
__device__ __forceinline__ void phase10(const Args& a, int gw, int NGW, int lane, bf16_t* XO) {
    unsigned char* ws = a.ws;
    const int* INV = (const int*)(ws + WS_INV); const unsigned char* YE = (const unsigned char*)(ws + WS_YE); const bf16_t* X = (const bf16_t*)(ws + WS_X1B); float* RS = (float*)(ws + WS_RSTD2); unsigned char* X2Q = ws + WS_X2Q;
    u32x4 nx[2]; u32x4 ny[4]; int inv1 = -1, inv2 = -1; unsigned msk1 = 0u;
    const int col0 = 256 * (lane >> 4) + 128 * ((lane & 3) >> 1) + 32 * ((lane & 15) >> 2) + 16 * (lane & 1);
#define P10_ISSUE(mrow, invreg, mskout) do { const int b_ = (mrow) / SEQ; \
        mskout = (unsigned)__builtin_amdgcn_readfirstlane((int)(__ballot((invreg) >= 0) & 0xffffull)); \
        _Pragma("unroll") for (int j = 0; j < 2; ++j) nx[j] = *(const u32x4*)(X + (size_t)(mrow) * DM + col0 + 8 * j); \
        unsigned mm_ = mskout; \
        _Pragma("unroll") for (int k = 0; k < 4; ++k) { const bool act_ = mm_ != 0u; const int e_ = act_ ? __builtin_ctz(mm_) : 0; mm_ &= mm_ - 1u; const int sl_ = __builtin_amdgcn_readlane((invreg), e_); \
            const unsigned char* yr_ = (act_ ? YE + ((size_t)(b_ * NE + e_) * CAP + sl_) * DM : (const unsigned char*)(X + (size_t)(mrow) * DM)) + 16 * lane;     \
            ny[k] = *(const u32x4*)yr_; } } while (0)
    if (gw < NT) inv1 = INV[(size_t)gw * NE + (lane & 15)];
    if (gw + NGW < NT) inv2 = INV[(size_t)(gw + NGW) * NE + (lane & 15)];
    if (gw < NT) P10_ISSUE(gw, inv1, msk1);
    for (int m = gw; m < NT; m += NGW) {
        const int b = m / SEQ;
        f32x4 v[4]; u32x4 y[4]; const int inv0 = inv1; const unsigned msk0 = msk1;
        r16_unpack(v, nx);
#pragma unroll
        for (int k = 0; k < 4; ++k) y[k] = ny[k];
        inv1 = inv2;
        if (m + 2 * NGW < NT) inv2 = INV[(size_t)(m + 2 * NGW) * NE + (lane & 15)];
        if (m + NGW < NT) P10_ISSUE(m + NGW, inv1, msk1);
        unsigned mm = msk0;
#pragma unroll
        for (int k = 0; k < 4; ++k) { if (mm) { mm &= mm - 1u; l16_acc_fp8(v, y[k]); } }
        while (mm) {
            const int e = __builtin_ctz(mm); mm &= mm - 1u; const int sl = __builtin_amdgcn_readlane(inv0, e);
            const u32x4 w = *(const u32x4*)(YE + ((size_t)(b * NE + e) * CAP + sl) * DM + 16 * lane); l16_acc_fp8(v, w);
        }
        float s = 0.f, mx = 0.f;
#pragma unroll
        for (int j = 0; j < 4; ++j) { s += (v[j].x * v[j].x + v[j].y * v[j].y) + (v[j].z * v[j].z + v[j].w * v[j].w);
            mx = fmaxf(fmaxf(mx, fmaxf(fabsf(v[j].x), fabsf(v[j].y))), fmaxf(fabsf(v[j].z), fabsf(v[j].w))); }
        const float rstd = rsqrtf(wave_sum(s) * (1.0f / DM) + EPS);
#pragma unroll
        for (int o = 1; o < 64; o <<= 1) mx = fmaxf(mx, __shfl_xor(mx, o));
        mx = fmaxf(mx, 1e-30f); const float qs = 127.0f * __builtin_amdgcn_rcpf(mx);
        if (lane == 0) RS[m] = rstd * (mx * (1.0f / 127.0f)) * WQ_INV;
#pragma unroll
        for (int j = 0; j < 2; ++j) store_bf8(XO + (size_t)m * DM + col0 + 8 * j, v[2 * j], v[2 * j + 1]);
        u32x4 q;
        q.x = q8x4s(v[0], qs); q.y = q8x4s(v[1], qs); q.z = q8x4s(v[2], qs); q.w = q8x4s(v[3], qs);
        *(u32x4*)(X2Q + (size_t)m * DM + col0) = q;
    }
#undef P10_ISSUE
    const f32x4* P = (const f32x4*)a.in[I_P]; u32x2* PB = (u32x2*)(ws + WS_PBF);
    const size_t nq = (size_t)NT * PLE / 4, stride = (size_t)NGW * 64;
    for (size_t q0 = (size_t)gw * 64 + lane; q0 < nq; q0 += 8 * stride) {
        f32x4 t[8];
#pragma unroll
        for (int i = 0; i < 8; ++i) { const size_t q = q0 + i * stride; t[i] = P[q < nq ? q : q0]; }
#pragma unroll
        for (int i = 0; i < 8; ++i) { const size_t q = q0 + i * stride; if (q < nq) { u32x2 w; w.x = pk2(t[i].x, t[i].y); w.y = pk2(t[i].z, t[i].w); PB[q] = w; } }
    }
}

__device__ __forceinline__ void phase12(const Args& a, int gw, int NGW, int lane, float* XO) {
    unsigned char* ws = a.ws;
    const bf16_t* GL = (const bf16_t*)(ws + WS_GL); const bf16_t* ER = (const bf16_t*)(ws + WS_ERAW); const bf16_t* X = (const bf16_t*)(ws + WS_XN);
    f32x4 gp[4], gf[4];
#pragma unroll
    for (int j = 0; j < 2; ++j) { gp[2 * j] = *(const f32x4*)(a.in[I_PNG] + 512 * j + 8 * lane); gp[2 * j + 1] = *(const f32x4*)(a.in[I_PNG] + 512 * j + 8 * lane + 4);
        gf[2 * j] = *(const f32x4*)(a.in[I_FG] + 512 * j + 8 * lane); gf[2 * j + 1] = *(const f32x4*)(a.in[I_FG] + 512 * j + 8 * lane + 4); }
#pragma unroll
    for (int j = 0; j < 4; ++j) asm volatile("" : "+v"(gp[j]), "+v"(gf[j]));
    u32x4 nx[2]; u32x4 ne[2], ng[2];
#define P12_ISSUE(mrow) do { _Pragma("unroll") for (int j = 0; j < 2; ++j) { nx[j] = *(const u32x4*)(X + (size_t)(mrow) * DM + 512 * j + 8 * lane); \
        ne[j] = *(const u32x4*)(ER + (size_t)(mrow) * DM + 512 * j + 8 * lane); ng[j] = *(const u32x4*)(GL + (size_t)(mrow) * DM + 512 * j + 8 * lane); } } while (0)
    if (gw < NT) P12_ISSUE(gw);
    for (int m = gw; m < NT; m += NGW) {
        f32x4 v[4], ev[4], gv[4]; float se = 0.f;
        r16_unpack(v, nx); r16_unpack(ev, ne); r16_unpack(gv, ng);
        if (m + NGW < NT) P12_ISSUE(m + NGW);
#pragma unroll
        for (int j = 0; j < 4; ++j) se += (ev[j].x * ev[j].x + ev[j].y * ev[j].y) + (ev[j].z * ev[j].z + ev[j].w * ev[j].w);
        const float rse = rsqrtf(wave_sum(se) * (1.0f / DM) + EPS); float s = 0.f;
#pragma unroll
        for (int j = 0; j < 4; ++j) { v[j] = v[j] + gv[j] * (ev[j] * rse * gp[j]); s += (v[j].x * v[j].x + v[j].y * v[j].y) + (v[j].z * v[j].z + v[j].w * v[j].w); }
        const float rstd = rsqrtf(wave_sum(s) * (1.0f / DM) + EPS);
#pragma unroll
        for (int j = 0; j < 2; ++j) { *(f32x4*)(XO + (size_t)m * DM + 512 * j + 8 * lane) = v[2 * j] * rstd * gf[2 * j]; *(f32x4*)(XO + (size_t)m * DM + 512 * j + 8 * lane + 4) = v[2 * j + 1] * rstd * gf[2 * j + 1]; }
    }
#undef P12_ISSUE
}

constexpr int N_PHASES = 13;
template <int LO, int HI>
__global__ void __launch_bounds__(NTHREADS, 2) mk_fwd(Args a) {
    extern __shared__ __attribute__((aligned(16))) unsigned char lds_raw[];
    LAS unsigned char* lds = (LAS unsigned char*)lds_raw;
    const int tid = threadIdx.x, wave = __builtin_amdgcn_readfirstlane(tid >> 6);
    const int G = gridDim.x, bx = blockIdx.x;
    const int vcu = (G % 8 == 0) ? (bx % 8) * (G / 8) + bx / 8 : bx;
    const int gw = vcu * NWAVES + wave, NGW = G * NWAVES;
    unsigned char* ws = a.ws;
#ifndef MK_DUP_MASK
#define MK_DUP_MASK 0
#endif
#define REP(k) (((MK_DUP_MASK >> (k)) & 1) ? 2 : 1)
#define IN(k) (LO <= (k) && (k) < HI)
#define BOTH(k) (IN(k) && IN((k) + 1))
    XcdBarrier bar; bar.bar = (unsigned*)(ws + WS_CTL); bar.x = 0; bar.st = nullptr;
    if (HI - LO > 1) {
        if (tid < 16) ((LAS unsigned*)(lds + MISC_OFF))[tid] = 0u;
        __syncthreads();
        bar = xcd_barrier_post((unsigned*)(ws + WS_CTL), (volatile LAS unsigned*)(lds + MISC_OFF));
    }
#define GRID_BAR(k) do { if (BOTH(k)) { xcd_barrier(bar); if (MK_DUP_MASK & 0x10000) xcd_barrier(bar); } } while (0)
    if (IN(0)) for (int rep_ = 0; rep_ < REP(0); ++rep_) { int l_ = threadIdx.x; asm volatile("" : "+v"(l_)); l_ &= 63; const bool split = (G % 64 == 0); phase0(a, lds, gw, NGW, wave, l_, 0, IT_SMALL, IT_SMALL + (split ? IT_P1 : 0), 3 * IT_EXP - (split ? IT_P1 : 0), true); }
    GRID_BAR(0);
    if (IN(1)) for (int rep_ = 0; rep_ < REP(1); ++rep_) {
        const bool split = (G % 64 == 0);
        if (split && ((bx >> 3) & 7) == 7) {
            int l_ = threadIdx.x; asm volatile("" : "+v"(l_)); l_ &= 63;
            const int ci = (bx >> 6) * 8 + (bx & 7), nci = (G >> 6) * 8;
            phase0(a, lds, ci * NWAVES + wave, nci * NWAVES, wave, l_, IT_SMALL, IT_P1, 0, 0, false);
        } else {
            const int cg = split ? ((bx >> 6) * 56 + ((bx >> 3) & 7) * 8 + (bx & 7)) : bx, Gg = split ? (G >> 6) * 56 : G;
            GemmDesc g{(const bf16_t*)(ws + WS_XQ), (const bf16_t*)(ws + WS_WIN), DM / 2, DM / 2, NT / 256, INC / 256, 0, 0, 0, nullptr, nullptr};
            Epi1 E{(bf16_t*)(ws + WS_V), (bf16_t*)(ws + WS_U), (bf16_t*)(ws + WS_G), a.in[I_BGATE], (const float*)(ws + WS_RSTD0)};
            gemm_phase<1>(lds, g, Gg, cg, E);
        }
    }
    GRID_BAR(1);
    if (IN(2)) for (int rep_ = 0; rep_ < REP(2); ++rep_) phase2(a, lds, G, vcu);
    GRID_BAR(2);
    if (IN(4)) for (int rep_ = 0; rep_ < REP(4); ++rep_) {
        GemmDesc g{(const bf16_t*)(ws + WS_PD), (const bf16_t*)(ws + WS_WCAT), PDIM, 640, NT / 256, DM / 256, 128, 0, 0, nullptr, (const bf16_t*)(ws + WS_CS)};
        Epi23 E{(const bf16_t*)(ws + WS_G), a.in[I_PSCALE], (bf16_t*)(ws + WS_MERGED)};
        gemm_phase<3>(lds, g, G, bx, E);
    }
    GRID_BAR(4);
    if (IN(5)) for (int rep_ = 0; rep_ < REP(5); ++rep_) {
        GemmDesc g{(const bf16_t*)(ws + WS_MERGED), (const bf16_t*)(ws + WS_WOUT), DM, DM, NT / 256, DM / 256, 0, 0, 0, nullptr, nullptr};
        Epi4 E{(const bf16_t*)(ws + WS_XN), (bf16_t*)(ws + WS_X1B)};
        gemm_phase<4>(lds, g, G, bx, E);
    }
    GRID_BAR(5);
    if (IN(6)) for (int rep_ = 0; rep_ < REP(6); ++rep_) { int l_ = threadIdx.x; asm volatile("" : "+v"(l_)); l_ &= 63; phase6(a, lds, gw, NGW, l_); }
    GRID_BAR(6);
    if (IN(7)) for (int rep_ = 0; rep_ < REP(7); ++rep_) phase7(a, lds, G, vcu);
    GRID_BAR(7);
    if (IN(8)) for (int rep_ = 0; rep_ < REP(8); ++rep_) {
        GemmDesc g{(const bf16_t*)(ws + WS_X1Q), (const bf16_t*)(ws + WS_WGU), DM / 2, DM / 2, NB * NE, 2048 / 256, 0, 1, (size_t)2048 * DM / 2, (const int*)(ws + WS_IDX), nullptr};
        Epi5 E{ws + WS_HID, (const float*)(ws + WS_RSV)};
        gemm_phase<5>(lds, g, G, bx, E);
    }
    GRID_BAR(8);
    if (IN(9)) for (int rep_ = 0; rep_ < REP(9); ++rep_) {
        GemmDesc g{(const bf16_t*)(ws + WS_HID), (const bf16_t*)(ws + WS_WD), FF / 2, FF / 2, NB * NE, DM / 256, 0, 1, (size_t)DM * FF / 2, nullptr, nullptr};
        Epi6 E{(const float*)(ws + WS_VAL), (unsigned char*)(ws + WS_YE)};
        gemm_phase<6>(lds, g, G, bx, E);
    }
    GRID_BAR(9);
    if (IN(10)) for (int rep_ = 0; rep_ < REP(10); ++rep_) { int l_ = threadIdx.x; asm volatile("" : "+v"(l_)); l_ &= 63; phase10(a, gw, NGW, l_, (bf16_t*)(ws + WS_XN)); }
    GRID_BAR(10);
    if (IN(11)) for (int rep_ = 0; rep_ < REP(11); ++rep_) {
        { GemmDesc g{(const bf16_t*)(ws + WS_X2Q), (const bf16_t*)(ws + WS_WPG), DM / 2, DM / 2, NT / 256, DM / 256, 0, 0, 0, nullptr, nullptr};
          Epi7 E{a.in[I_BPG], (bf16_t*)(ws + WS_GL), (const float*)(ws + WS_RSTD2)};
          gemm_phase<7>(lds, g, G, bx, E); }
        { GemmDesc g{(const bf16_t*)(ws + WS_PBF), (const bf16_t*)(ws + WS_WPLE), PLE, PLE, NT / 256, DM / 256, 0, 0, 0, nullptr, nullptr};
          Epi8 E{(bf16_t*)(ws + WS_ERAW)};
          gemm_phase<8>(lds, g, G, bx, E); }
    }
    GRID_BAR(11);
    if (IN(12)) for (int rep_ = 0; rep_ < REP(12); ++rep_) { int l_ = threadIdx.x; asm volatile("" : "+v"(l_)); l_ &= 63; phase12(a, gw, NGW, l_, a.out); }
#undef IN
#undef BOTH
#undef GRID_BAR
}

#ifndef MK_ONE_LAUNCH
#define MK_ONE_LAUNCH 1
#endif
typedef void (*kern_t)(Args);
#if !MK_ONE_LAUNCH
template <int P> struct PhaseTab { static void fill(kern_t* t) { t[P] = mk_fwd<P, P + 1>; PhaseTab<P - 1>::fill(t); } };
template <> struct PhaseTab<-1> { static void fill(kern_t*) {} };
constexpr int N_KERNELS = N_PHASES;
#else
constexpr int N_KERNELS = 1;
#endif

extern "C" void kernel_launch(void* const* d_in, const int* in_sizes, int n_in, void* d_out, int out_size, void* d_ws, size_t ws_size, hipStream_t stream) {
    static int grid = 0; static kern_t tab[N_KERNELS];
    if (grid == 0) {
        if (n_in != 24 || in_sizes[0] != NT * DM || out_size != NT * DM || ws_size < WS_END) {
            fprintf(stderr, "kernel_launch: unexpected shapes: n_in %d in0 %d out %d ws %zu (need %zu)\n", n_in, n_in > 0 ? in_sizes[0] : -1, out_size, ws_size, (size_t)WS_END); grid = -1; return; }
        int dev = 0, cus = 0;
        if (hipGetDevice(&dev) != hipSuccess || hipDeviceGetAttribute(&cus, hipDeviceAttributeMultiprocessorCount, dev) != hipSuccess) { grid = -1; return; }
#if !MK_ONE_LAUNCH
        PhaseTab<N_PHASES - 1>::fill(tab);
#else
        tab[0] = mk_fwd<0, N_PHASES>;
#endif
        for (int p = 0; p < N_KERNELS; ++p) {
            int per_cu = 0;
            if (hipFuncSetAttribute((const void*)tab[p], hipFuncAttributeMaxDynamicSharedMemorySize, LDS_BYTES) != hipSuccess) { fprintf(stderr, "kernel_launch: hipFuncSetAttribute failed (kernel %d)\n", p); grid = -1; return; }
            if (hipOccupancyMaxActiveBlocksPerMultiprocessor(&per_cu, (const void*)tab[p], NTHREADS, LDS_BYTES) != hipSuccess || per_cu < 1) { fprintf(stderr, "kernel_launch: occupancy query says %d (kernel %d)\n", per_cu, p); grid = -1; (void)hipGetLastError(); return; }
        }
        grid = cus;
    }
    if (grid < 0) return;
    Args a{};
    for (int i = 0; i < 24; ++i) a.in[i] = (const float*)d_in[i];
    a.out = (float*)d_out; a.ws = (unsigned char*)d_ws;
#if MK_ONE_LAUNCH
    if (hipMemsetAsync((char*)d_ws + WS_CTL, 0, CTL_ZERO_BYTES, stream) != hipSuccess) { fprintf(stderr, "kernel_launch: memset failed\n"); return; }
#endif
    for (int p = 0; p < N_KERNELS; ++p) hipLaunchKernelGGL(tab[p], dim3(grid), dim3(NTHREADS), LDS_BYTES, stream, a);
}
```

```cpp
#include <hip/hip_runtime.h>
#include <cstdio>
#include <cstdint>

#define LAS __attribute__((address_space(3)))
typedef unsigned short bf16_t;
typedef float f32x4 __attribute__((ext_vector_type(4)));
typedef unsigned u32x2 __attribute__((ext_vector_type(2)));
typedef unsigned u32x4 __attribute__((ext_vector_type(4)));

constexpr int NB = 16, SEQ = 2048, DM = 1024, NT = NB * SEQ;
constexpr int PLE = 256, CD = 512, CWID = 31, PDIM = 512, NE = 16, FF = 1024, CAP = 256, INC = 3584;
constexpr float EPS = 1e-6f;
constexpr int NWAVES = 8, NTHREADS = 512;
constexpr int LDS_BYTES = 147456;

constexpr size_t MiB = 1u << 20;
constexpr size_t WS_CTL = 0;
constexpr size_t WS_WIN = 1 * MiB;
constexpr size_t WS_WCAT = 8 * MiB;
constexpr size_t WS_WPLE = 9 * MiB + 512 * 1024;
constexpr size_t WS_WOUT = 10 * MiB;
constexpr size_t WS_WPG = 12 * MiB;
constexpr size_t WS_WGU = 14 * MiB;
constexpr size_t WS_WD = 78 * MiB;
constexpr size_t WS_XN = 111 * MiB;
constexpr size_t WS_R1 = 175 * MiB;
constexpr size_t WS_V = WS_R1;
constexpr size_t WS_U = WS_R1 + 32 * MiB;
constexpr size_t WS_G = WS_R1 + 64 * MiB;
constexpr size_t WS_MERGED = WS_R1;
constexpr size_t WS_HID = WS_R1;
constexpr size_t WS_GL = WS_R1 + 64 * MiB;
constexpr size_t WS_PBF = WS_R1;
constexpr size_t WS_X2Q = WS_R1 + 16 * MiB;
constexpr size_t WS_X1B = WS_R1 + 128 * MiB;
constexpr size_t WS_R2 = 367 * MiB;
constexpr size_t WS_CS = WS_R2;
constexpr size_t WS_PD = WS_R2 + 32 * MiB;
constexpr size_t WS_XQ = WS_R2;
constexpr size_t WS_X1Q = WS_R2;
constexpr size_t WS_YE = WS_R2;
constexpr size_t WS_ERAW = WS_R2;
constexpr size_t WS_AFF = 495 * MiB;
constexpr size_t WS_IDX = 497 * MiB;
constexpr size_t WS_VAL = 497 * MiB + 512 * 1024;
constexpr size_t WS_INV = 498 * MiB;
constexpr size_t WS_RSTD2 = 500 * MiB;
constexpr size_t WS_RSTD0 = 502 * MiB;
constexpr size_t WS_RSTD1 = 501 * MiB;
constexpr size_t WS_RSV = 497 * MiB + 256 * 1024;
constexpr size_t WS_END = 512 * MiB;

#define LDS_WAIT() asm volatile("s_waitcnt lgkmcnt(0)" ::: "memory")
#define VM_WAIT() asm volatile("s_waitcnt vmcnt(0)" ::: "memory")
__device__ __forceinline__ unsigned f2bf(float f) { unsigned u = __float_as_uint(f); return (u + 0x7fffu + ((u >> 16) & 1u)) >> 16; }
typedef float f32x2p __attribute__((ext_vector_type(2))); typedef __bf16 bf16x2p __attribute__((ext_vector_type(2)));
__device__ __forceinline__ unsigned pk2(float lo, float hi) { const f32x2p v = {lo, hi}; const bf16x2p b = __builtin_convertvector(v, bf16x2p); return __builtin_bit_cast(unsigned, b); }
__device__ __forceinline__ float bf_lo(unsigned w) { return __uint_as_float(w << 16); }
__device__ __forceinline__ float bf_hi(unsigned w) { return __uint_as_float(w & 0xffff0000u); }
__device__ __forceinline__ float sigm(float x) { return __builtin_amdgcn_rcpf(1.0f + __expf(-x)); }
__device__ __forceinline__ f32x4 sigm4(f32x4 v) { f32x4 o; o.x = sigm(v.x); o.y = sigm(v.y); o.z = sigm(v.z); o.w = sigm(v.w); return o; }
__device__ __forceinline__ void store_bf4(bf16_t* p, f32x4 v) { u32x2 w; w.x = pk2(v.x, v.y); w.y = pk2(v.z, v.w); *(u32x2*)p = w; }
__device__ __forceinline__ f32x4 load_bf4(const bf16_t* p) { const u32x2 w = *(const u32x2*)p; f32x4 o; o.x = bf_lo(w.x); o.y = bf_hi(w.x); o.z = bf_lo(w.y); o.w = bf_hi(w.y); return o; }
__device__ __forceinline__ void store_bf8(bf16_t* p, f32x4 lo, f32x4 hi) { u32x4 w; w.x = pk2(lo.x, lo.y); w.y = pk2(lo.z, lo.w); w.z = pk2(hi.x, hi.y); w.w = pk2(hi.z, hi.w); *(u32x4*)p = w; }
__device__ __forceinline__ void load_bf8(const bf16_t* p, f32x4& lo, f32x4& hi) { const u32x4 w = *(const u32x4*)p; lo = (f32x4){bf_lo(w.x), bf_hi(w.x), bf_lo(w.y), bf_hi(w.y)}; hi = (f32x4){bf_lo(w.z), bf_hi(w.z), bf_lo(w.w), bf_hi(w.w)}; }
__device__ __forceinline__ void r16_unpack(f32x4 (&o)[4], const u32x4 (&w)[2]) {
#pragma unroll
    for (int j = 0; j < 2; ++j) { o[2 * j] = (f32x4){bf_lo(w[j].x), bf_hi(w[j].x), bf_lo(w[j].y), bf_hi(w[j].y)}; o[2 * j + 1] = (f32x4){bf_lo(w[j].z), bf_hi(w[j].z), bf_lo(w[j].w), bf_hi(w[j].w)}; }
}
__device__ __forceinline__ unsigned pk_fp8x4(float a, float b, float c, float d) { int p = __builtin_amdgcn_cvt_pk_fp8_f32(a, b, 0, false); p = __builtin_amdgcn_cvt_pk_fp8_f32(c, d, p, true); return (unsigned)p; }
__device__ __forceinline__ unsigned q8x4(float a, float b, float c, float d) {
    const float M = 12582912.0f; const unsigned ua = __float_as_uint(a + M), ub = __float_as_uint(b + M), uc = __float_as_uint(c + M), ud = __float_as_uint(d + M);
    return __builtin_amdgcn_perm(__builtin_amdgcn_perm(ud, uc, 0x0c0c0400u), __builtin_amdgcn_perm(ub, ua, 0x0c0c0400u), 0x05040100u); }
__device__ __forceinline__ unsigned q8x4s(f32x4 v, float s) {
    const f32x4 t = v * s + 12582912.0f; const unsigned ua = __float_as_uint(t.x), ub = __float_as_uint(t.y), uc = __float_as_uint(t.z), ud = __float_as_uint(t.w);
    return __builtin_amdgcn_perm(__builtin_amdgcn_perm(ud, uc, 0x0c0c0400u), __builtin_amdgcn_perm(ub, ua, 0x0c0c0400u), 0x05040100u); }
__device__ __forceinline__ float clamp127(float v) { return __builtin_amdgcn_fmed3f(v, -127.0f, 127.0f); }
constexpr float WQ_SCALE = 127.0f * 32.0f / 4.0f, WQ_INV = 4.0f / (127.0f * 32.0f);
constexpr float W8_SCALE = 32.0f, W8_INV = 1.0f / 32.0f;
__device__ __forceinline__ float wave_sum(float v) {
#pragma unroll
    for (int o = 1; o < 64; o <<= 1) v += __shfl_xor(v, o);
    return v;
}


#define XB_TMO      128
#define XB_XCNT(j)  (256  + 64 * (j))
#define XB_XSUB(j)  (1280 + 64 * (j))
#define XB_XGEN(j)  (2304 + 64 * (j))
#define XB_TOP      3328
#define XB_TOPGEN   3392
#define XCD_BAR_WORDS 3456
#define XB_SPIN_CAP (1u << 18)
__device__ __forceinline__ unsigned xb_ld(unsigned* p)              { return __hip_atomic_load(p, __ATOMIC_RELAXED, __HIP_MEMORY_SCOPE_AGENT); }
__device__ __forceinline__ unsigned xb_add(unsigned* p, unsigned v) { return __hip_atomic_fetch_add(p, v, __ATOMIC_RELAXED, __HIP_MEMORY_SCOPE_AGENT); }
__device__ __forceinline__ unsigned xb_xcc_id() { return (unsigned)__builtin_amdgcn_s_getreg((3 << 11) | 20) & 0xFu; }
#define XB_SPIN(cond, bar) do { unsigned _sp = 0; while (cond) { __builtin_amdgcn_s_sleep(1); \
    if ((++_sp & 255u) == 0u) { if (xb_ld(&(bar)[XB_TMO])) break; if (_sp > XB_SPIN_CAP) { atomicAdd(&(bar)[XB_TMO], 1u); break; } } } } while (0)
struct XcdBarrier { unsigned* bar; unsigned x; volatile LAS unsigned* st; };
__device__ __forceinline__ XcdBarrier xcd_barrier_post(unsigned* bar, volatile LAS unsigned* st) {
    XcdBarrier b; b.bar = bar; b.x = xb_xcc_id(); b.st = st;
    if (threadIdx.x == 0) (void)xb_add(&bar[XB_XCNT(b.x)], 1u);
    return b;
}
__device__ __forceinline__ void xcd_barrier_complete(unsigned* bar, unsigned x, unsigned& nloc, unsigned& nx) {
    const unsigned G = gridDim.x * gridDim.y * gridDim.z;
    unsigned sum, cnt, mine, sp = 0u;
    for (;;) {
        sum = 0u; cnt = 0u; mine = 0u;
#pragma unroll
        for (unsigned j = 0; j < 16; ++j) { const unsigned c = xb_ld(&bar[XB_XCNT(j)]); sum += c; cnt += (c > 0u) ? 1u : 0u; mine = (j == x) ? c : mine; }
        if (sum == G) break;
        __builtin_amdgcn_s_sleep(1);
        if ((++sp & 255u) == 0u) { if (xb_ld(&bar[XB_TMO])) break; if (sp > XB_SPIN_CAP) { atomicAdd(&bar[XB_TMO], 1u); break; } }
    }
    nloc = mine > 0u ? mine : 1u; nx = cnt > 0u ? cnt : 1u;
}
__device__ __forceinline__ void xcd_barrier(const XcdBarrier& b) {
    asm volatile("s_waitcnt vmcnt(0)" ::: "memory");
    __syncthreads();
    if (threadIdx.x == 0) {
        unsigned* bar = b.bar;
        __builtin_amdgcn_s_waitcnt(0);
        unsigned nloc = b.st[0], nx = b.st[1];
        if (nloc == 0u) { xcd_barrier_complete(bar, b.x, nloc, nx); b.st[0] = nloc; b.st[1] = nx; }
        const unsigned old = xb_add(&bar[XB_XSUB(b.x)], 1u);
        const unsigned gen = old / nloc;
        if (old + 1u == (gen + 1u) * nloc) {
            __builtin_amdgcn_fence(__ATOMIC_RELEASE, "agent");
            asm volatile("s_waitcnt vmcnt(0)" ::: "memory");
            const unsigned og = xb_add(&bar[XB_TOP], 1u);
            const unsigned tg = og / nx;
            if (og + 1u == (tg + 1u) * nx) xb_add(&bar[XB_TOPGEN], 1u);
            else XB_SPIN(xb_ld(&bar[XB_TOPGEN]) == tg, bar);
            __builtin_amdgcn_fence(__ATOMIC_ACQUIRE, "agent");
            xb_add(&bar[XB_XGEN(b.x)], 1u);
            asm volatile("s_waitcnt vmcnt(0)" ::: "memory");
        } else {
            XB_SPIN(xb_ld(&bar[XB_XGEN(b.x)]) == gen, bar);
            __builtin_amdgcn_fence(__ATOMIC_ACQUIRE, "agent");
            asm volatile("s_waitcnt vmcnt(0)" ::: "memory");
        }
    }
    __syncthreads();
}
constexpr int MISC_OFF = LDS_BYTES - 64;
constexpr size_t CTL_ZERO_BYTES = 65536;

struct Unit { int pm, pn; };
constexpr int NXCD = 8, WGM = 8;
struct StaticOrder {
    int nM, nN, nwg, G, c;
    __device__ void init(int nM_, int nN_, int G_, int c_) { nM = nM_; nN = nN_; nwg = nM * nN; G = G_; c = c_; }
    __device__ bool next(int i, Unit& u) const {
        const long L = (long)i * G + c; if (L >= nwg) return false;
        int wgid = (int)L; { const int q = nwg / NXCD, r = nwg % NXCD, xcd = wgid % NXCD, off = wgid / NXCD; wgid = (xcd < r ? xcd * (q + 1) : r * (q + 1) + (xcd - r) * q) + off; }
        const int nig = WGM * nN, gid = wgid / nig, fm = gid * WGM, gsz = (nM - fm) < WGM ? (nM - fm) : WGM;
        u.pm = fm + ((wgid % nig) % gsz); u.pn = (wgid % nig) / gsz; return true;
    }
};
struct GemmDesc {
    const bf16_t* A; const bf16_t* Bt; int lda, K, nM, nN, a_col_step, moe; size_t b_mat_stride; const int* rowidx; const bf16_t* A2;
    __device__ __forceinline__ int mem_pm(int pm) const { return moe ? ((pm & 15) * 16 + (pm >> 4)) : pm; }
    __device__ __forceinline__ const bf16_t* a_ptr(const Unit& u) const { return A + (size_t)mem_pm(u.pm) * 256 * lda + (size_t)u.pn * a_col_step; }
    __device__ __forceinline__ const bf16_t* a2_ptr(const Unit& u) const { return A2 + (size_t)mem_pm(u.pm) * 256 * lda; }
    __device__ __forceinline__ const bf16_t* b_ptr(const Unit& u) const { return Bt + (moe ? (size_t)(u.pm >> 4) * b_mat_stride : (size_t)0) + (size_t)u.pn * 256 * K; }
};

struct Epi1 { static constexpr bool DUAL = false;
    bf16_t* V; bf16_t* U; bf16_t* Gt; const float* bgate; const float* RS;
    struct Early { float r[8]; };
    __device__ __forceinline__ void early(Early& e, int mpm, int rbase) const {
#pragma unroll
        for (int g = 0; g < 8; ++g) e.r[g] = RS[(size_t)mpm * 256 + 128 * (g >> 2) + 16 * (g & 3) + rbase]; }
    struct Ctx { f32x4 b[4]; }; struct Pre {}; static constexpr int DIST = 0;
    __device__ __forceinline__ void begin(Ctx& c, int mpm, int pn, int c8, int rbase) const { const float* bp = bgate + (pn >= 6 ? 256 * (pn - 6) : 0) + c8;
        c.b[0] = *(const f32x4*)bp; c.b[1] = *(const f32x4*)(bp + 4); c.b[2] = *(const f32x4*)(bp + 128); c.b[3] = *(const f32x4*)(bp + 132); }
    __device__ __forceinline__ void prefetch(Pre&, int, int, int, int) const {}
    __device__ __forceinline__ void finish(const Early& ea, const Ctx& c, const Pre&, int g, int mpm, int pn, int r, int c8, f32x4 a0, f32x4 a1, f32x4 b0, f32x4 b1) const {
        const size_t row = (size_t)mpm * 256 + r; const float rs = ea.r[g]; a0 = a0 * rs; a1 = a1 * rs; b0 = b0 * rs; b1 = b1 * rs;
        if (pn < 4) { store_bf8(V + row * CD + 128 * pn + c8, a0 * sigm4(b0), a1 * sigm4(b1)); }
        else if (pn < 6) { bf16_t* p = U + row * PDIM + 256 * (pn - 4) + c8; store_bf8(p, a0, a1); store_bf8(p + 128, b0, b1); }
        else { bf16_t* p = Gt + row * 2048 + 256 * (pn - 6) + c8; store_bf8(p, sigm4(a0 + c.b[0]), sigm4(a1 + c.b[1])); store_bf8(p + 128, sigm4(b0 + c.b[2]), sigm4(b1 + c.b[3])); }
    }
};
struct Epi23 {
    static constexpr bool DUAL = true;
    const bf16_t* Gt; const float* scale; bf16_t* MG;
    struct TCtx { f32x4 s[4]; }; struct TPre { u32x4 g1[2], g2[2]; };
    __device__ __forceinline__ void t_begin(TCtx& c, int mpm, int pn, int c8) const { const float* sp = scale + 256 * pn + c8;
        c.s[0] = *(const f32x4*)sp; c.s[1] = *(const f32x4*)(sp + 4); c.s[2] = *(const f32x4*)(sp + 128); c.s[3] = *(const f32x4*)(sp + 132); }
    __device__ __forceinline__ void t_prefetch(TPre& p, int mpm, int pn, int r, int c8) const { const bf16_t* gp = Gt + ((size_t)mpm * 256 + r) * 2048 + 256 * pn + c8;
        p.g1[0] = *(const u32x4*)gp; p.g1[1] = *(const u32x4*)(gp + 128); p.g2[0] = *(const u32x4*)(gp + 1024); p.g2[1] = *(const u32x4*)(gp + 1024 + 128); }
    __device__ __forceinline__ static f32x4 ratio4(f32x4 g2, f32x4 sc, f32x4 g1) { f32x4 o;
        o.x = g2.x * sc.x * __builtin_amdgcn_rcpf(fmaxf(g1.x, 1e-30f)); o.y = g2.y * sc.y * __builtin_amdgcn_rcpf(fmaxf(g1.y, 1e-30f));
        o.z = g2.z * sc.z * __builtin_amdgcn_rcpf(fmaxf(g1.z, 1e-30f)); o.w = g2.w * sc.w * __builtin_amdgcn_rcpf(fmaxf(g1.w, 1e-30f)); return o; }
    __device__ __forceinline__ void t_apply(const TCtx& c, const TPre& p, f32x4& a0, f32x4& a1, f32x4& b0, f32x4& b1) const {
        f32x4 o1[4], o2[4]; r16_unpack(o1, p.g1); r16_unpack(o2, p.g2);
        a0 = a0 * ratio4(o2[0], c.s[0], o1[0]); a1 = a1 * ratio4(o2[1], c.s[1], o1[1]); b0 = b0 * ratio4(o2[2], c.s[2], o1[2]); b1 = b1 * ratio4(o2[3], c.s[3], o1[3]);
    }
    struct Early {}; __device__ __forceinline__ void early(Early&, int, int) const {}
    struct Ctx {}; struct Pre { u32x4 g[2]; }; static constexpr int DIST = 2;
    __device__ __forceinline__ void begin(Ctx&, int, int, int, int) const {}
    __device__ __forceinline__ void prefetch(Pre& p, int mpm, int pn, int r, int c8) const { const bf16_t* gp = Gt + ((size_t)mpm * 256 + r) * 2048 + 256 * pn + c8;
        p.g[0] = *(const u32x4*)gp; p.g[1] = *(const u32x4*)(gp + 128); }
    __device__ __forceinline__ void finish(const Early& ea, const Ctx&, const Pre& p, int g, int mpm, int pn, int r, int c8, f32x4 a0, f32x4 a1, f32x4 b0, f32x4 b1) const {
        f32x4 o[4]; r16_unpack(o, p.g); bf16_t* mp = MG + ((size_t)mpm * 256 + r) * DM + 256 * pn + c8;
        store_bf8(mp, o[0] * a0, o[1] * a1); store_bf8(mp + 128, o[2] * b0, o[3] * b1);
    }
};
struct Epi4 { static constexpr bool DUAL = false;
    const bf16_t* X; bf16_t* O;
    struct Early {}; __device__ __forceinline__ void early(Early&, int, int) const {}
    struct Ctx {}; struct Pre { u32x4 x[2]; }; static constexpr int DIST = 2;
    __device__ __forceinline__ void begin(Ctx&, int, int, int, int) const {}
    __device__ __forceinline__ void prefetch(Pre& p, int mpm, int pn, int r, int c8) const { const bf16_t* xp = X + ((size_t)mpm * 256 + r) * DM + 256 * pn + c8;
        p.x[0] = *(const u32x4*)xp; p.x[1] = *(const u32x4*)(xp + 128); }
    __device__ __forceinline__ void finish(const Early& ea, const Ctx&, const Pre& p, int g, int mpm, int pn, int r, int c8, f32x4 a0, f32x4 a1, f32x4 b0, f32x4 b1) const {
        f32x4 o[4]; r16_unpack(o, p.x); bf16_t* op = O + ((size_t)mpm * 256 + r) * DM + 256 * pn + c8; store_bf8(op, o[0] + a0, o[1] + a1); store_bf8(op + 128, o[2] + b0, o[3] + b1);
    }
};
struct Epi5 { static constexpr bool DUAL = false;
    unsigned char* H; const float* RSV;
    struct Early { float r[8]; };
    __device__ __forceinline__ void early(Early& e, int mpm, int rbase) const {
#pragma unroll
        for (int g = 0; g < 8; ++g) e.r[g] = RSV[(size_t)mpm * 256 + 128 * (g >> 2) + 16 * (g & 3) + rbase]; }
    struct Ctx {}; struct Pre {}; static constexpr int DIST = 0;
    __device__ __forceinline__ void begin(Ctx&, int, int, int, int) const {}
    __device__ __forceinline__ void prefetch(Pre&, int, int, int, int) const {}
    __device__ __forceinline__ u32x2 hid8(float rs, f32x4 a0, f32x4 a1, f32x4 b0, f32x4 b1) const { const f32x4 g0 = a0 * rs, g1 = a1 * rs;
        const f32x4 h0 = g0 * sigm4(g0) * (b0 * rs), h1 = g1 * sigm4(g1) * (b1 * rs); u32x2 w; w.x = pk_fp8x4(h0.x, h0.y, h0.z, h0.w); w.y = pk_fp8x4(h1.x, h1.y, h1.z, h1.w); return w; }
    __device__ __forceinline__ void finish(const Early& ea, const Ctx& c, const Pre&, int g, int mpm, int pn, int r, int c8, f32x4 a0, f32x4 a1, f32x4 b0, f32x4 b1) const {
        *(u32x2*)(H + ((size_t)mpm * 256 + r) * FF + 128 * pn + c8) = hid8(ea.r[g], a0, a1, b0, b1);
    }
    static constexpr bool PAIR = true;
    __device__ __forceinline__ void finish2(const Early& ea, int g, int mpm, int pn, int r, int c8, f32x4 a0, f32x4 a1, f32x4 b0, f32x4 b1, f32x4 c0, f32x4 c1, f32x4 d0, f32x4 d1) const {
        const u32x2 w0 = hid8(ea.r[g], a0, a1, b0, b1), w1 = hid8(ea.r[g + 1], c0, c1, d0, d1);
        const auto s0 = __builtin_amdgcn_permlane16_swap(w0.x, w1.x, false, false); const auto s1 = __builtin_amdgcn_permlane16_swap(w0.y, w1.y, false, false);
        u32x4 o; o.x = s0[0]; o.y = s1[0]; o.z = s0[1]; o.w = s1[1];
        unsigned char* p = H + ((size_t)mpm * 256 + r) * FF + 128 * pn + c8;
        *(u32x4*)((c8 & 8) ? p + 16 * FF - 8 : p) = o;
    }
};
struct Epi6 { static constexpr bool DUAL = false;
    const float* VAL; unsigned char* YE;
    __device__ __forceinline__ static unsigned pack_fp8x4(f32x4 v) { int p = __builtin_amdgcn_cvt_pk_fp8_f32(v.x, v.y, 0, false); p = __builtin_amdgcn_cvt_pk_fp8_f32(v.z, v.w, p, true); return (unsigned)p; }
    struct Early { float r[8]; };
    __device__ __forceinline__ void early(Early& e, int mpm, int rbase) const {
#pragma unroll
        for (int g = 0; g < 8; ++g) e.r[g] = VAL[(size_t)mpm * 256 + 128 * (g >> 2) + 16 * (g & 3) + rbase]; }
    struct Ctx {}; struct Pre {}; static constexpr int DIST = 0;
    __device__ __forceinline__ void begin(Ctx&, int, int, int, int) const {}
    __device__ __forceinline__ void prefetch(Pre&, int, int, int, int) const {}
    __device__ __forceinline__ void finish(const Early& ea, const Ctx& c, const Pre&, int g, int mpm, int pn, int r, int c8, f32x4 a0, f32x4 a1, f32x4 b0, f32x4 b1) const {
        const float tv = ea.r[g]; unsigned char* p = YE + ((size_t)mpm * 256 + r) * DM + 256 * pn + 2 * (c8 & ~31) + (c8 & 31);
        u32x2 w0, w1; w0.x = pack_fp8x4(a0 * tv); w0.y = pack_fp8x4(a1 * tv); w1.x = pack_fp8x4(b0 * tv); w1.y = pack_fp8x4(b1 * tv);
        const auto r0 = __builtin_amdgcn_permlane16_swap(w0.x, w1.x, false, false); const auto r1 = __builtin_amdgcn_permlane16_swap(w0.y, w1.y, false, false);
        u32x4 o; o.x = r0[0]; o.y = r1[0]; o.z = r0[1]; o.w = r1[1];
        *(u32x4*)((c8 & 8) ? p + 24 : p) = o;
    }
};
struct Epi7 { static constexpr bool DUAL = false;
    const float* bias; bf16_t* GL; const float* RS;
    struct Early { float r[8]; };
    __device__ __forceinline__ void early(Early& e, int mpm, int rbase) const {
#pragma unroll
        for (int g = 0; g < 8; ++g) e.r[g] = RS[(size_t)mpm * 256 + 128 * (g >> 2) + 16 * (g & 3) + rbase]; }
    struct Ctx { f32x4 b[4]; }; struct Pre {}; static constexpr int DIST = 0;
    __device__ __forceinline__ void begin(Ctx& c, int mpm, int pn, int c8, int rbase) const { const float* bp = bias + 256 * pn + c8;
        c.b[0] = *(const f32x4*)bp; c.b[1] = *(const f32x4*)(bp + 4); c.b[2] = *(const f32x4*)(bp + 128); c.b[3] = *(const f32x4*)(bp + 132); }
    __device__ __forceinline__ void prefetch(Pre&, int, int, int, int) const {}
    __device__ __forceinline__ void finish(const Early& ea, const Ctx& c, const Pre&, int g, int mpm, int pn, int r, int c8, f32x4 a0, f32x4 a1, f32x4 b0, f32x4 b1) const {
        const float rs = ea.r[g]; bf16_t* p = GL + ((size_t)mpm * 256 + r) * DM + 256 * pn + c8;
        store_bf8(p, sigm4(a0 * rs + c.b[0]), sigm4(a1 * rs + c.b[1])); store_bf8(p + 128, sigm4(b0 * rs + c.b[2]), sigm4(b1 * rs + c.b[3]));
    }
};
struct Epi8 { static constexpr bool DUAL = false;
    bf16_t* ER;
    struct Early {}; __device__ __forceinline__ void early(Early&, int, int) const {}
    struct Ctx {}; struct Pre {}; static constexpr int DIST = 0;
    __device__ __forceinline__ void begin(Ctx&, int, int, int, int) const {}
    __device__ __forceinline__ void prefetch(Pre&, int, int, int, int) const {}
    __device__ __forceinline__ void finish(const Early& ea, const Ctx&, const Pre&, int g, int mpm, int pn, int r, int c8, f32x4 a0, f32x4 a1, f32x4 b0, f32x4 b1) const {
        bf16_t* p = ER + ((size_t)mpm * 256 + r) * DM + 256 * pn + c8; store_bf8(p, a0, a1); store_bf8(p + 128, b0, b1);
    }
};

typedef short bf16x8 __attribute__((ext_vector_type(8)));
constexpr int BK = 64, HALF = 128, HTB = HALF * BK * 2, STAGE_BYTES = 8 * HTB;
__device__ __forceinline__ int lds_byte(int r, int c) { const int st = (r >> 4) * 2 + (c >> 5), rr = r & 15, cc = c & 31, ob = rr * 64 + cc * 2; return st * 1024 + (ob ^ (((ob >> 9) & 1) << 5)); }
__device__ __forceinline__ int perm32(int rho) { const int n = rho >> 4, i = rho & 15; return 8 * (i >> 2) + 4 * n + (i & 3); }
__device__ __forceinline__ void stage_rc(int b, int& R, int& C) { const int st = b / 1024, sb = b % 1024, swz = sb ^ (((sb >> 9) & 1) << 5); R = (st >> 1) * 16 + swz / 64; C = (st & 1) * 32 + (swz % 64) / 2; }

typedef int i32x4v __attribute__((ext_vector_type(4)));
typedef int i32x8v __attribute__((ext_vector_type(8)));
template <class E, class = void> struct EpiPair { static constexpr bool value = false; };
template <class E> struct EpiPair<E, decltype((void)E::PAIR)> { static constexpr bool value = E::PAIR; };
template <int MODE> struct AccT { typedef f32x4 type; }; template <> struct AccT<2> { typedef i32x4v type; };
__device__ __forceinline__ f32x4 acc_f32(f32x4 v) { return v; }
__device__ __forceinline__ f32x4 acc_f32(i32x4v v) { return __builtin_convertvector(v, f32x4); }
template <class Epi, bool ALIGN_EPI, bool SP2, bool GATHER, int MODE>
__device__ __forceinline__ void gemm_pg8(LAS unsigned char* lds, const GemmDesc& g, int G, int cidx, const Epi& E) {
    static_assert(SP2, "only the two-MFMA-blocks-per-barrier-pair loop carries the gather / dual-source staging");
    constexpr bool FP8 = (MODE == 1), I8 = (MODE == 2); typedef typename AccT<MODE>::type acc_t;
    int tid_ = threadIdx.x; asm volatile("" : "+v"(tid_));
    const int tid = tid_, wid = __builtin_amdgcn_readfirstlane(tid >> 6), lane = tid & 63, wr = wid >> 2, wc = wid & 3, fr = lane & 15, fq = lane >> 4;
    const int K = g.K, nt = K / BK, lda = g.lda;
    StaticOrder S; S.init(g.nM, g.nN, G, cidx);
    unsigned voffA[2], voffB[2];
    int stR[2], stC[2];
#pragma unroll
    for (int i = 0; i < 2; ++i) { stage_rc(tid * 16 + i * 8192, stR[i], stC[i]); voffA[i] = (unsigned)(stR[i] * lda + stC[i]) * 2u; voffB[i] = (unsigned)(((stR[i] & ~31) + perm32(stR[i] & 31)) * K + stC[i]) * 2u; }
    unsigned cv[2][2], nv[2][2];
#define PG8_ROWOFF(dst, u_) do { const int t_ = g.mem_pm((u_).pm); const int* ix_ = g.rowidx + t_ * 256; const int rb_ = (t_ >> 4) * SEQ; \
        _Pragma("unroll") for (int h_ = 0; h_ < 2; ++h_) _Pragma("unroll") for (int i_ = 0; i_ < 2; ++i_) dst[h_][i_] = (unsigned)((rb_ + ix_[128 * h_ + stR[i_]]) * lda + stC[i_]) * 2u; } while (0)
#define PG8_STAGE_A(bufoff, half, ptr, isnext) do { if constexpr (GATHER) { _Pragma("unroll") for (int _i = 0; _i < 2; ++_i) { const unsigned vo_ = (isnext) ? nv[half][_i] : cv[half][_i]; \
        __builtin_amdgcn_global_load_lds((const unsigned*)((const char*)(ptr) + vo_), (LAS unsigned*)(lds + (bufoff) + ldsw + _i * 8192), 16, 0, 0); } } \
        else { PG8_STAGE(bufoff, (ptr) + (half) * hstepA, voffA); } } while (0)
    const size_t kstep = (size_t)(BK * 2);
    const size_t hstepA = (size_t)HALF * lda * 2, hstepB = (size_t)HALF * K * 2;
    const unsigned ldsw = (unsigned)wid * 1024u;
    const int aoff = lds_byte(wr * 64 + fr, fq * 8), boff = lds_byte(wc * 32 + fr, fq * 8);
#define PG8_SA(b, h) (((b) * 2 + (h)) * HTB)
#define PG8_SB(b, h) ((4 + (b) * 2 + (h)) * HTB)
#define PG8_STAGE(bufoff, gbase, voff) do { _Pragma("unroll") for (int _i = 0; _i < 2; ++_i) \
        __builtin_amdgcn_global_load_lds((const unsigned*)((const char*)(gbase) + (voff)[_i]), (LAS unsigned*)(lds + (bufoff) + ldsw + _i * 8192), 16, 0, 0); } while (0)
#define PG8_LDA(dst, b, h) do { _Pragma("unroll") for (int m = 0; m < 4; ++m) _Pragma("unroll") for (int k = 0; k < 2; ++k) dst[m][k] = *(const LAS bf16x8*)(lds + PG8_SA(b, h) + aoff + m * 2048 + k * 1024); } while (0)
#define PG8_LDB(dst, b, h) do { _Pragma("unroll") for (int n = 0; n < 2; ++n) _Pragma("unroll") for (int k = 0; k < 2; ++k) dst[n][k] = *(const LAS bf16x8*)(lds + PG8_SB(b, h) + boff + n * 2048 + k * 1024); } while (0)
#define PG8_CAT(x) __builtin_shufflevector((i32x4v)(x)[0], (i32x4v)(x)[1], 0, 1, 2, 3, 4, 5, 6, 7)
#define PG8_MMA(ai, bj, At, Bt) do { __builtin_amdgcn_s_setprio(1); _Pragma("unroll") for (int m = 0; m < 4; ++m) _Pragma("unroll") for (int n = 0; n < 2; ++n) { \
        if constexpr (FP8) { const i32x8v b8_ = PG8_CAT(Bt[n]), a8_ = PG8_CAT(At[m]); asm volatile("v_mfma_scale_f32_16x16x128_f8f6f4 %0, %1, %2, %0, %3, %3 op_sel_hi:[0,0,0]" : "+v"(acc[ai][bj][m][n]) : "v"(b8_), "v"(a8_), "v"(sc127)); } \
        else if constexpr (I8) { _Pragma("unroll") for (int k = 0; k < 2; ++k) acc[ai][bj][m][n] = __builtin_amdgcn_mfma_i32_16x16x64_i8((i32x4v)Bt[n][k], (i32x4v)At[m][k], acc[ai][bj][m][n], 0, 0, 0); } \
        else { _Pragma("unroll") for (int k = 0; k < 2; ++k) acc[ai][bj][m][n] = __builtin_amdgcn_mfma_f32_16x16x32_bf16(Bt[n][k], At[m][k], acc[ai][bj][m][n], 0, 0, 0); } } __builtin_amdgcn_s_setprio(0); } while (0)
#define PG8_WAIT_V(n) asm volatile("s_waitcnt vmcnt(" #n ")" ::: "memory")
#define PG8_WAIT_L(n) asm volatile("s_waitcnt lgkmcnt(" #n ")" ::: "memory")
#define PG8_BAR __builtin_amdgcn_s_barrier()
#define PG8_SCHED __builtin_amdgcn_sched_barrier(0)
    Unit cur, nxt; int ui = 0;
    if (!S.next(0, cur)) return;
    acc_t acc[2][2][4][2];
#pragma unroll
    for (int a = 0; a < 2; ++a)
#pragma unroll
        for (int b = 0; b < 2; ++b)
#pragma unroll
            for (int m = 0; m < 4; ++m)
#pragma unroll
                for (int n = 0; n < 2; ++n) acc[a][b][m][n] = (acc_t){0, 0, 0, 0};
    bf16x8 At[4][2], B0[2][2], B1[2][2];
    int sc127 = 0x7f7f7f7f; asm volatile("" : "+v"(sc127));
    const char* cA = GATHER ? (const char*)g.A : (const char*)g.a_ptr(cur); const char* cB = (const char*)g.b_ptr(cur);
    const char* cA2 = cA; if constexpr (Epi::DUAL) cA2 = (const char*)g.a2_ptr(cur) - 2 * kstep;
    typename Epi::Early ea; E.early(ea, g.mem_pm(cur.pm), 64 * wr + fr);
    if constexpr (GATHER) {
        PG8_ROWOFF(cv, cur);
        if (S.next(1, nxt)) PG8_ROWOFF(nv, nxt); else { _Pragma("unroll") for (int h_ = 0; h_ < 2; ++h_) _Pragma("unroll") for (int i_ = 0; i_ < 2; ++i_) nv[h_][i_] = cv[h_][i_]; }
        asm volatile("" : "+v"(cv[0][0]), "+v"(cv[0][1]), "+v"(cv[1][0]), "+v"(cv[1][1]), "+v"(nv[0][0]), "+v"(nv[0][1]), "+v"(nv[1][0]), "+v"(nv[1][1]));
    }
    if constexpr (SP2) {
        PG8_STAGE(PG8_SB(0, 0), cB, voffB); PG8_STAGE(PG8_SB(0, 1), cB + hstepB, voffB); PG8_STAGE_A(PG8_SA(0, 0), 0, cA, false); PG8_STAGE_A(PG8_SA(0, 1), 1, cA, false);
        if (wr == 1) PG8_BAR;
        PG8_WAIT_V(2); PG8_BAR;
        PG8_STAGE(PG8_SB(1, 0), cB + kstep, voffB); PG8_STAGE_A(PG8_SA(1, 0), 0, cA + kstep, false); PG8_STAGE(PG8_SB(1, 1), cB + hstepB + kstep, voffB);
        PG8_WAIT_V(6); PG8_BAR;
    }
    for (;;) {
        const bool has_next = S.next(ui + 1, nxt);
        const char* nA = GATHER ? cA : (has_next ? (const char*)g.a_ptr(nxt) : cA); const char* nB = has_next ? (const char*)g.b_ptr(nxt) : cB;
        const char* nA2 = cA2; if constexpr (Epi::DUAL) { if (has_next) nA2 = (const char*)g.a2_ptr(nxt) - 2 * kstep; }
        for (int t = 0; t < nt; t += 2) {
            const bool last = (t == nt - 2);
            const char* a1 = ((Epi::DUAL && t >= 2) ? cA2 : cA) + (size_t)(t + 1) * kstep;
            const char* a2 = last ? nA : (Epi::DUAL ? cA2 : cA) + (size_t)(t + 2) * kstep; const char* b2 = last ? nB : cB + (size_t)(t + 2) * kstep;
            const char* a3 = a2 + kstep; const char* b3 = b2 + kstep;
            if constexpr (SP2) {
            PG8_LDB(B0, 0, 0); PG8_LDB(B1, 0, 1); PG8_SCHED; PG8_LDA(At, 0, 0); PG8_STAGE_A(PG8_SA(1, 1), 1, a1, false);
            PG8_WAIT_V(8); PG8_WAIT_L(0); PG8_BAR; PG8_MMA(0, 0, At, B0); PG8_MMA(0, 1, At, B1); PG8_BAR; PG8_SCHED;
            PG8_LDA(At, 0, 1); PG8_STAGE(PG8_SB(0, 0), b2, voffB); PG8_STAGE(PG8_SB(0, 1), b2 + hstepB, voffB); PG8_STAGE_A(PG8_SA(0, 0), 0, a2, last);
            PG8_WAIT_V(8); PG8_WAIT_L(0); PG8_BAR; PG8_MMA(1, 0, At, B0); PG8_MMA(1, 1, At, B1); PG8_BAR; PG8_SCHED;
            PG8_LDB(B0, 1, 0); PG8_LDB(B1, 1, 1); PG8_SCHED; PG8_LDA(At, 1, 0); PG8_STAGE_A(PG8_SA(0, 1), 1, a2, last);
            PG8_WAIT_V(8); PG8_WAIT_L(0); PG8_BAR; PG8_MMA(0, 0, At, B0); PG8_MMA(0, 1, At, B1); PG8_BAR; PG8_SCHED;
            PG8_LDA(At, 1, 1); PG8_STAGE(PG8_SB(1, 0), b3, voffB); PG8_STAGE(PG8_SB(1, 1), b3 + hstepB, voffB); PG8_STAGE_A(PG8_SA(1, 0), 0, a3, last);
            PG8_WAIT_V(8); PG8_WAIT_L(0); PG8_BAR; PG8_MMA(1, 0, At, B0); PG8_MMA(1, 1, At, B1); PG8_BAR; PG8_SCHED;
            }
            if constexpr (Epi::DUAL && MODE == 0) { if (t == 0) {
                const int mpm_t = g.mem_pm(cur.pm); int fr_t = fr, fq_t = fq; asm volatile("" : "+v"(fr_t), "+v"(fq_t));
                const int rbase = 64 * wr + fr_t, c8 = 32 * wc + 8 * fq_t, pn_ = cur.pn;
                typename Epi::TCtx tc; E.t_begin(tc, mpm_t, pn_, c8);
                typename Epi::TPre tp[3];
                E.t_prefetch(tp[0], mpm_t, pn_, rbase, c8); E.t_prefetch(tp[1], mpm_t, pn_, 16 + rbase, c8);
#pragma unroll
                for (int gi = 0; gi < 8; ++gi) {
                    if (gi + 2 < 8) { const int gn = gi + 2; E.t_prefetch(tp[gn % 3], mpm_t, pn_, 128 * (gn >> 2) + 16 * (gn & 3) + rbase, c8); }
                    E.t_apply(tc, tp[gi % 3], acc[gi >> 2][0][gi & 3][0], acc[gi >> 2][0][gi & 3][1], acc[gi >> 2][1][gi & 3][0], acc[gi >> 2][1][gi & 3][1]);
                    __builtin_amdgcn_sched_barrier(0);
                }
            } }
        }
        if constexpr (FP8) asm volatile("s_nop 15\n\ts_nop 15" ::: "memory");
        if constexpr (ALIGN_EPI) { if (wr == 0) PG8_BAR; }
        {
            const int mpm = g.mem_pm(cur.pm);
            int fr_e = fr, fq_e = fq; asm volatile("" : "+v"(fr_e), "+v"(fq_e));
            const int rbase = 64 * wr + fr_e, c8 = 32 * wc + 8 * fq_e, pn_ = cur.pn;
            typename Epi::Ctx ctx; E.begin(ctx, mpm, pn_, c8, rbase);
            typename Epi::Pre pre[3];
            if constexpr (Epi::DIST > 0) { E.prefetch(pre[0], mpm, pn_, rbase, c8); if constexpr (Epi::DIST > 1) E.prefetch(pre[1], mpm, pn_, 16 + rbase, c8); }
            if constexpr (EpiPair<Epi>::value) {
#pragma unroll
                for (int gi = 0; gi < 8; gi += 2) {
                    E.finish2(ea, gi, mpm, pn_, 128 * (gi >> 2) + 16 * (gi & 3) + rbase, c8, acc_f32(acc[gi >> 2][0][gi & 3][0]), acc_f32(acc[gi >> 2][0][gi & 3][1]), acc_f32(acc[gi >> 2][1][gi & 3][0]), acc_f32(acc[gi >> 2][1][gi & 3][1]),
                              acc_f32(acc[gi >> 2][0][(gi & 3) + 1][0]), acc_f32(acc[gi >> 2][0][(gi & 3) + 1][1]), acc_f32(acc[gi >> 2][1][(gi & 3) + 1][0]), acc_f32(acc[gi >> 2][1][(gi & 3) + 1][1]));
                    __builtin_amdgcn_sched_barrier(0);
                }
            } else
#pragma unroll
            for (int gi = 0; gi < 8; ++gi) {
                if constexpr (Epi::DIST > 0) { if (gi + Epi::DIST < 8) { const int gn = gi + Epi::DIST; E.prefetch(pre[gn % 3], mpm, pn_, 128 * (gn >> 2) + 16 * (gn & 3) + rbase, c8); } }
                E.finish(ea, ctx, pre[gi % 3], gi, mpm, pn_, 128 * (gi >> 2) + 16 * (gi & 3) + rbase, c8, acc_f32(acc[gi >> 2][0][gi & 3][0]), acc_f32(acc[gi >> 2][0][gi & 3][1]), acc_f32(acc[gi >> 2][1][gi & 3][0]), acc_f32(acc[gi >> 2][1][gi & 3][1]));
                __builtin_amdgcn_sched_barrier(0);
            }
        }
        if (!has_next) break;
        if constexpr (GATHER) {
            _Pragma("unroll") for (int h_ = 0; h_ < 2; ++h_) _Pragma("unroll") for (int i_ = 0; i_ < 2; ++i_) cv[h_][i_] = nv[h_][i_];
            Unit nn; if (S.next(ui + 2, nn)) { PG8_ROWOFF(nv, nn); }
            asm volatile("" : "+v"(nv[0][0]), "+v"(nv[0][1]), "+v"(nv[1][0]), "+v"(nv[1][1]));
        }
#pragma unroll
        for (int a = 0; a < 2; ++a)
#pragma unroll
            for (int b = 0; b < 2; ++b)
#pragma unroll
                for (int m = 0; m < 4; ++m)
#pragma unroll
                    for (int n = 0; n < 2; ++n) acc[a][b][m][n] = (acc_t){0, 0, 0, 0};
        cur = nxt; cA = nA; cB = nB; cA2 = nA2; ++ui;
        E.early(ea, g.mem_pm(cur.pm), 64 * wr + fr);
        if constexpr (ALIGN_EPI) { if (wr == 1) PG8_BAR; }
    }
    PG8_WAIT_V(0);
    if constexpr (!ALIGN_EPI) { if (wr == 0) PG8_BAR; }
    PG8_BAR;
#undef PG8_SA
#undef PG8_SB
#undef PG8_STAGE
#undef PG8_STAGE_A
#undef PG8_ROWOFF
#undef PG8_LDA
#undef PG8_LDB
#undef PG8_MMA
#undef PG8_CAT
#undef PG8_WAIT_V
#undef PG8_WAIT_L
#undef PG8_BAR
#undef PG8_SCHED
}

template <int ID, class Epi>
__device__ __forceinline__ void gemm_phase(LAS unsigned char* lds, const GemmDesc& g, int G, int cidx, const Epi& E) { gemm_pg8<Epi, true, true, ID == 5, ID == 6 ? 1 : ((ID == 1 || ID == 5 || ID == 7) ? 2 : 0)>(lds, g, G, cidx, E); }

struct Args { const float* in[24]; float* out; unsigned char* ws; };
enum { I_X = 0, I_P, I_N1G, I_WIN, I_BGATE, I_CONVW, I_CONVB, I_LNG, I_LNB, I_WCO, I_WPOOL, I_PSCALE, I_WOUT, I_N2G, I_WR, I_WEG, I_WEU, I_WED, I_N3G, I_WPG, I_BPG, I_WPLE, I_PNG, I_FG };

struct TrItem { const float* W; bf16_t* WT; const float* kscale; int K, N, k0, n0, drow0, ldt, kofs, f8; };
__device__ __forceinline__ void tr_load(const TrItem& t, f32x4 (&v)[16], float (&ks)[16], int lane) {
    const int cq = 4 * (lane & 15), rq = lane >> 4;
#pragma unroll
    for (int i = 0; i < 16; ++i) v[i] = __builtin_nontemporal_load((const f32x4*)(t.W + (size_t)(t.k0 + 4 * i + rq) * t.N + t.n0 + cq));
    const float* kp = t.kscale ? t.kscale : t.W;
#pragma unroll
    for (int i = 0; i < 16; ++i) ks[i] = kp[t.k0 + 4 * i + rq];
}
__device__ __forceinline__ void tr_store(const TrItem& t, const f32x4 (&v)[16], const float (&ks)[16], LAS float* scr, int lane) {
    const int cq = 4 * (lane & 15), rq = lane >> 4; const bool sc = t.kscale != nullptr; const float mul = t.f8 == 1 ? W8_SCALE : (t.f8 == 2 ? WQ_SCALE : 1.0f);
#pragma unroll
    for (int i = 0; i < 16; ++i) { const float f = (sc ? ks[i] : 1.0f) * mul; LAS float* p = scr + (4 * i + rq) * 65 + cq; p[0] = v[i].x * f; p[1] = v[i].y * f; p[2] = v[i].z * f; p[3] = v[i].w * f; }
    LDS_WAIT();
    if (t.f8) {
        const int c4 = lane & 3; unsigned char* W8 = (unsigned char*)t.WT;
#pragma unroll
        for (int j = 0; j < 4; ++j) { const int n = (lane >> 2) + 16 * j; const LAS float* sp = scr + (16 * c4) * 65 + n; u32x4 o;
            if (t.f8 == 1) { o.x = pk_fp8x4(sp[0 * 65], sp[1 * 65], sp[2 * 65], sp[3 * 65]); o.y = pk_fp8x4(sp[4 * 65], sp[5 * 65], sp[6 * 65], sp[7 * 65]);
                o.z = pk_fp8x4(sp[8 * 65], sp[9 * 65], sp[10 * 65], sp[11 * 65]); o.w = pk_fp8x4(sp[12 * 65], sp[13 * 65], sp[14 * 65], sp[15 * 65]); }
            else { o.x = q8x4(clamp127(sp[0 * 65]), clamp127(sp[1 * 65]), clamp127(sp[2 * 65]), clamp127(sp[3 * 65])); o.y = q8x4(clamp127(sp[4 * 65]), clamp127(sp[5 * 65]), clamp127(sp[6 * 65]), clamp127(sp[7 * 65]));
                o.z = q8x4(clamp127(sp[8 * 65]), clamp127(sp[9 * 65]), clamp127(sp[10 * 65]), clamp127(sp[11 * 65])); o.w = q8x4(clamp127(sp[12 * 65]), clamp127(sp[13 * 65]), clamp127(sp[14 * 65]), clamp127(sp[15 * 65])); }
            __builtin_nontemporal_store(o, (u32x4*)(W8 + (size_t)(t.drow0 + n) * t.ldt + t.kofs + t.k0 + 16 * c4)); }
        LDS_WAIT(); return;
    }
    const int c = lane & 7;
#pragma unroll
    for (int j = 0; j < 8; ++j) { const int n = (lane >> 3) + 8 * j; const LAS float* sp = scr + (8 * c) * 65 + n;
        u32x4 o; o.x = pk2(sp[0 * 65], sp[1 * 65]); o.y = pk2(sp[2 * 65], sp[3 * 65]); o.z = pk2(sp[4 * 65], sp[5 * 65]); o.w = pk2(sp[6 * 65], sp[7 * 65]);
        __builtin_nontemporal_store(o, (u32x4*)(t.WT + (size_t)(t.drow0 + n) * t.ldt + t.kofs + t.k0 + 8 * c)); }
    LDS_WAIT();
}
constexpr int IT_WIN = (DM / 64) * (INC / 64);
constexpr int IT_WC = (CD / 64) * (DM / 64);
constexpr int IT_WP = 4 * (128 / 64) * (256 / 64);
constexpr int IT_SQ = (DM / 64) * (DM / 64);
constexpr int IT_WPLE = (PLE / 64) * (DM / 64);
constexpr int IT_EXP = NE * IT_SQ;
constexpr int IT_TOTAL = IT_WIN + IT_WC + IT_WP + IT_SQ + IT_SQ + IT_WPLE + 3 * IT_EXP;
constexpr int IT_SMALL = IT_TOTAL - 3 * IT_EXP;
constexpr int IT_P1 = 4608;
__device__ __forceinline__ TrItem tr_decode(const Args& a, int it) {
    unsigned char* ws = a.ws; TrItem t; t.kscale = nullptr; t.f8 = 0;
    int r = it;
    if (r < IT_WIN) {
        const int nblk = INC / 64, kb = r / nblk, nb = r % nblk, n0 = 64 * nb; int d0;
        if (n0 < 512) d0 = 256 * (n0 >> 7) + (n0 & 127); else if (n0 < 1024) d0 = 256 * ((n0 - 512) >> 7) + 128 + (n0 & 127); else d0 = n0;
        t.W = a.in[I_WIN]; t.WT = (bf16_t*)(ws + WS_WIN); t.K = DM; t.N = INC; t.k0 = 64 * kb; t.n0 = n0; t.drow0 = d0; t.kscale = a.in[I_N1G]; t.ldt = t.K; t.kofs = 0; t.f8 = 2; return t; }
    r -= IT_WIN;
    if (r < IT_WC) { const int kb = r / 16, nb = r % 16; t.W = a.in[I_WCO]; t.WT = (bf16_t*)(ws + WS_WCAT); t.K = CD; t.N = DM; t.k0 = 64 * kb; t.n0 = 64 * nb; t.drow0 = 64 * nb; t.ldt = 640; t.kofs = 128; return t; }
    r -= IT_WC;
    if (r < IT_WP) { const int gi = r / 8, q = r % 8, kb = q / 4, nb = q % 4;
        t.W = a.in[I_WPOOL] + (size_t)gi * 128 * 256; t.WT = (bf16_t*)(ws + WS_WCAT); t.K = 128; t.N = 256; t.k0 = 64 * kb; t.n0 = 64 * nb; t.drow0 = 256 * gi + 64 * nb; t.ldt = 640; t.kofs = 0; return t; }
    r -= IT_WP;
    if (r < IT_SQ) { const int kb = r / 16, nb = r % 16; t.W = a.in[I_WOUT]; t.WT = (bf16_t*)(ws + WS_WOUT); t.K = DM; t.N = DM; t.k0 = 64 * kb; t.n0 = 64 * nb; t.drow0 = 64 * nb; t.ldt = t.K; t.kofs = 0; return t; }
    r -= IT_SQ;
    if (r < IT_SQ) { const int kb = r / 16, nb = r % 16; t.W = a.in[I_WPG]; t.WT = (bf16_t*)(ws + WS_WPG); t.K = DM; t.N = DM; t.k0 = 64 * kb; t.n0 = 64 * nb; t.drow0 = 64 * nb; t.kscale = a.in[I_N3G]; t.ldt = t.K; t.kofs = 0; t.f8 = 2; return t; }
    r -= IT_SQ;
    if (r < IT_WPLE) { const int kb = r / 16, nb = r % 16; t.W = a.in[I_WPLE]; t.WT = (bf16_t*)(ws + WS_WPLE); t.K = PLE; t.N = DM; t.k0 = 64 * kb; t.n0 = 64 * nb; t.drow0 = 64 * nb; t.ldt = t.K; t.kofs = 0; return t; }
    r -= IT_WPLE;
    if (r < IT_EXP) { const int e = r / IT_SQ, q = r % IT_SQ, kb = q / 16, nb = q % 16, n0 = 64 * nb;
        t.W = a.in[I_WEG] + (size_t)e * DM * FF; t.WT = (bf16_t*)(ws + WS_WGU + (size_t)e * 2048 * DM); t.K = DM; t.N = FF; t.k0 = 64 * kb; t.n0 = n0; t.drow0 = 256 * (n0 >> 7) + (n0 & 127); t.kscale = a.in[I_N2G]; t.ldt = t.K; t.kofs = 0; t.f8 = 2; return t; }
    r -= IT_EXP;
    if (r < IT_EXP) { const int e = r / IT_SQ, q = r % IT_SQ, kb = q / 16, nb = q % 16, n0 = 64 * nb;
        t.W = a.in[I_WEU] + (size_t)e * DM * FF; t.WT = (bf16_t*)(ws + WS_WGU + (size_t)e * 2048 * DM); t.K = DM; t.N = FF; t.k0 = 64 * kb; t.n0 = n0; t.drow0 = 256 * (n0 >> 7) + 128 + (n0 & 127); t.kscale = a.in[I_N2G]; t.ldt = t.K; t.kofs = 0; t.f8 = 2; return t; }
    r -= IT_EXP;
    { const int e = r / IT_SQ, q = r % IT_SQ, kb = q / 16, nb = q % 16;
        t.W = a.in[I_WED] + (size_t)e * FF * DM; t.WT = (bf16_t*)(ws + WS_WD + (size_t)e * DM * FF); t.K = FF; t.N = DM; t.k0 = 64 * kb; t.n0 = 64 * nb; t.drow0 = 64 * nb; t.ldt = t.K; t.kofs = 0; t.f8 = 1; return t; }
}
__device__ __forceinline__ void phase0(const Args& a, LAS unsigned char* lds, int gw, int NGW, int wave, int lane, int lo1, int n1, int lo2, int n2, bool do_rows) {
    unsigned char* ws = a.ws;
    LAS float* scr = (LAS float*)(lds + wave * 16640);
    {
        f32x4 v[16], vn[16]; float ks[16], ksn[16]; TrItem cur, nxt;
        const int nj = n1 + n2;
#define P0_JOB(j) ((j) < n1 ? lo1 + (j) : lo2 + ((j) - n1))
        int j = gw;
        if (j < nj) { cur = tr_decode(a, P0_JOB(j)); tr_load(cur, v, ks, lane); }
        for (; j < nj; j += NGW) {
            const bool has_next = j + NGW < nj;
            if (has_next) { nxt = tr_decode(a, P0_JOB(j + NGW)); tr_load(nxt, vn, ksn, lane); }
            tr_store(cur, v, ks, scr, lane);
            if (has_next) { cur = nxt;
#pragma unroll
                for (int i = 0; i < 16; ++i) { v[i] = vn[i]; ks[i] = ksn[i]; } }
        }
#undef P0_JOB
    }
    if (!do_rows) return;
    const float* x = a.in[I_X]; bf16_t* XN = (bf16_t*)(ws + WS_XN); float* RS0 = (float*)(ws + WS_RSTD0); unsigned char* XQ = ws + WS_XQ;
    f32x4 nx[4];
#define P0_ISSUE(mrow) do { _Pragma("unroll") for (int j = 0; j < 2; ++j) { nx[2 * j] = __builtin_nontemporal_load((const f32x4*)(x + (size_t)(mrow) * DM + 512 * j + 8 * lane)); nx[2 * j + 1] = __builtin_nontemporal_load((const f32x4*)(x + (size_t)(mrow) * DM + 512 * j + 8 * lane + 4)); } } while (0)
    if (gw < NT) P0_ISSUE(gw);
    for (int m = gw; m < NT; m += NGW) {
        f32x4 v[4]; float s = 0.f, mx = 0.f;
#pragma unroll
        for (int j = 0; j < 4; ++j) { v[j] = nx[j]; s += (v[j].x * v[j].x + v[j].y * v[j].y) + (v[j].z * v[j].z + v[j].w * v[j].w);
            mx = fmaxf(fmaxf(mx, fmaxf(fabsf(v[j].x), fabsf(v[j].y))), fmaxf(fabsf(v[j].z), fabsf(v[j].w))); }
        if (m + NGW < NT) P0_ISSUE(m + NGW);
        const float rstd = rsqrtf(wave_sum(s) * (1.0f / DM) + EPS);
#pragma unroll
        for (int o = 1; o < 64; o <<= 1) mx = fmaxf(mx, __shfl_xor(mx, o));
        mx = fmaxf(mx, 1e-30f); const float qs = 127.0f * __builtin_amdgcn_rcpf(mx);
        if (lane == 0) RS0[m] = rstd * (mx * (1.0f / 127.0f)) * WQ_INV;
#pragma unroll
        for (int j = 0; j < 2; ++j) { store_bf8(XN + (size_t)m * DM + 512 * j + 8 * lane, v[2 * j], v[2 * j + 1]);
            u32x2 q; q.x = q8x4s(v[2 * j], qs); q.y = q8x4s(v[2 * j + 1], qs);
            *(u32x2*)(XQ + (size_t)m * DM + 512 * j + 8 * lane) = q; }
    }
#undef P0_ISSUE
}

template <int HALF>
__device__ __forceinline__ void pool_unit(const LAS unsigned* Us, bf16_t* PDo, int th, int cp, int t0, int s0) {
    constexpr int NR = 7 + 2 * HALF;
    float r0[NR], r1[NR];
#pragma unroll
    for (int i = 0; i < NR; ++i) { const unsigned pu = Us[(8 * th + 8 - HALF + i) * 256 + cp]; r0[i] = bf_lo(pu); r1[i] = bf_hi(pu); }
    float p0 = 0.f, p1 = 0.f;
#pragma unroll
    for (int i = 0; i < 2 * HALF; ++i) { p0 += r0[i]; p1 += r1[i]; }
#pragma unroll
    for (int j = 0; j < 8; ++j) {
        const int s = s0 + 8 * th + j;
        const int lo = (s - HALF) > 0 ? (s - HALF) : 0, hi = (s + HALF - 1) < (SEQ - 1) ? (s + HALF - 1) : (SEQ - 1);
        const float inv = __builtin_amdgcn_rcpf((float)(hi - lo + 1));
        *(unsigned*)(PDo + ((size_t)(t0 + 8 * th + j)) * PDIM + 2 * cp) = pk2(p0 * inv - r0[j + HALF], p1 * inv - r1[j + HALF]);
        if (j < 7) { p0 += r0[j + 2 * HALF] - r0[j]; p1 += r1[j + 2 * HALF] - r1[j]; }
    }
}
__device__ __forceinline__ float wave_reduce16(const float (&v)[16], int lane) {
    float t8[8], t4[4], t2[2], t1;
    const bool b5 = (lane & 32) != 0, b4 = (lane & 16) != 0, b3 = (lane & 8) != 0, b2 = (lane & 4) != 0;
#pragma unroll
    for (int i = 0; i < 8; ++i) { const float send = b5 ? v[i] : v[i + 8], keep = b5 ? v[i + 8] : v[i]; t8[i] = keep + __shfl_xor(send, 32); }
#pragma unroll
    for (int i = 0; i < 4; ++i) { const float send = b4 ? t8[i] : t8[i + 4], keep = b4 ? t8[i + 4] : t8[i]; t4[i] = keep + __shfl_xor(send, 16); }
#pragma unroll
    for (int i = 0; i < 2; ++i) { const float send = b3 ? t4[i] : t4[i + 2], keep = b3 ? t4[i + 2] : t4[i]; t2[i] = keep + __shfl_xor(send, 8); }
    { const float send = b2 ? t2[0] : t2[1], keep = b2 ? t2[1] : t2[0]; t1 = keep + __shfl_xor(send, 4); }
    t1 += __shfl_xor(t1, 2); t1 += __shfl_xor(t1, 1);
    return t1;
}
__device__ __forceinline__ void phase2(const Args& a, LAS unsigned char* lds, int G, int cidx) {
    unsigned char* ws = a.ws;
    const bf16_t* V = (const bf16_t*)(ws + WS_V); const bf16_t* U = (const bf16_t*)(ws + WS_U);
    bf16_t* CS = (bf16_t*)(ws + WS_CS); bf16_t* PDo = (bf16_t*)(ws + WS_PD);
    LAS unsigned* Vs = (LAS unsigned*)lds;
    LAS unsigned* Us = Vs + 46 * 256;
    LAS float* red = (LAS float*)(Us + 31 * 256);
    int tid_ = threadIdx.x; asm volatile("" : "+v"(tid_));
    const int tid = tid_, cp = tid & 255, th = tid >> 8, wave = tid >> 6, lane = tid & 63;
    float w0[CWID], w1[CWID];
#pragma unroll
    for (int k = 0; k < CWID; ++k) { typedef float f32x2_ __attribute__((ext_vector_type(2))); const f32x2_ wv = *(const f32x2_*)(a.in[I_CONVW] + k * CD + 2 * cp); w0[k] = wv.x; w1[k] = wv.y; }
    const float cb0 = a.in[I_CONVB][2 * cp], cb1 = a.in[I_CONVB][2 * cp + 1];
    const float lg0 = a.in[I_LNG][2 * cp], lg1 = a.in[I_LNG][2 * cp + 1], lb0 = a.in[I_LNB][2 * cp], lb1 = a.in[I_LNB][2 * cp + 1];
    float cb0_ = cb0, cb1_ = cb1, lg0_ = lg0, lg1_ = lg1, lb0_ = lb0, lb1_ = lb1;
#pragma unroll
    for (int k = 0; k < CWID; ++k) asm volatile("" : "+v"(w0[k]), "+v"(w1[k]));
    asm volatile("" : "+v"(cb0_), "+v"(cb1_), "+v"(lg0_), "+v"(lg1_), "+v"(lb0_), "+v"(lb1_));
    const int grp = cp >> 6;
    const int NU = NT / 16, per = (NU + G - 1) / G;
    const int u_begin = cidx * per, u_end = (u_begin + per) < NU ? (u_begin + per) : NU;
    u32x4 pre[10];
#define P2_FETCH(unit) do { const int t0_ = (unit) * 16, b_ = t0_ / SEQ, s0_ = t0_ % SEQ; \
    _Pragma("unroll") for (int i = 0; i < 6; ++i) { const int q = tid + NTHREADS * i, r = (q >> 6) < 45 ? (q >> 6) : 45, ch = q & 63, sq = s0_ - 15 + r; \
        const int sc = sq < 0 ? 0 : (sq > SEQ - 1 ? SEQ - 1 : sq);     \
        pre[i] = *(const u32x4*)(V + ((size_t)(b_ * SEQ + sc)) * CD + ch * 8); } \
    _Pragma("unroll") for (int i = 0; i < 4; ++i) { const int q = tid + NTHREADS * i, r = (q >> 6) < 30 ? (q >> 6) : 30, ch = q & 63, sq = s0_ - 8 + r; \
        const int sc = sq < 0 ? 0 : (sq > SEQ - 1 ? SEQ - 1 : sq); \
        pre[6 + i] = *(const u32x4*)(U + ((size_t)(b_ * SEQ + sc)) * PDIM + ch * 8); } } while (0)
    if (u_begin < u_end) P2_FETCH(u_begin);
    for (int unit = u_begin; unit < u_end; ++unit) {
        const int t0 = unit * 16, s0 = t0 % SEQ;
        __syncthreads();
#pragma unroll
        for (int i = 0; i < 6; ++i) { const int q = tid + NTHREADS * i, sq = s0 - 15 + (q >> 6); const unsigned msk = (sq >= 0 && sq < SEQ) ? 0xffffffffu : 0u;
            if (q < 46 * 64) *(LAS u32x4*)(Vs + (q >> 6) * 256 + (q & 63) * 4) = (u32x4){pre[i].x & msk, pre[i].y & msk, pre[i].z & msk, pre[i].w & msk}; }
#pragma unroll
        for (int i = 0; i < 4; ++i) { const int q = tid + NTHREADS * i, sq = s0 - 8 + (q >> 6); const unsigned msk = (sq >= 0 && sq < SEQ) ? 0xffffffffu : 0u;
            if (q < 31 * 64) *(LAS u32x4*)(Us + (q >> 6) * 256 + (q & 63) * 4) = (u32x4){pre[6 + i].x & msk, pre[6 + i].y & msk, pre[6 + i].z & msk, pre[6 + i].w & msk}; }
        __syncthreads();
        if (unit + 1 < u_end) P2_FETCH(unit + 1);
        float a0[8], a1[8];
        {
            typedef float f32x2_ __attribute__((ext_vector_type(2)));
            f32x2_ ac[8];
#pragma unroll
            for (int j = 0; j < 8; ++j) ac[j] = (f32x2_){cb0_, cb1_};
            unsigned rowv[38];
#pragma unroll
            for (int r = 0; r < 38; ++r) rowv[r] = Vs[(8 * th + r) * 256 + cp];
            __builtin_amdgcn_sched_barrier(0);
#pragma unroll
            for (int r = 0; r < 38; ++r) {
                const f32x2_ xv = (f32x2_){bf_lo(rowv[r]), bf_hi(rowv[r])};
#pragma unroll
                for (int j = 0; j < 8; ++j) { const int k = r - j; if (k >= 0 && k < CWID) ac[j] = __builtin_elementwise_fma(xv, (f32x2_){w0[k], w1[k]}, ac[j]); }
            }
#pragma unroll
            for (int j = 0; j < 8; ++j) { a0[j] = ac[j].x; a1[j] = ac[j].y; }
        }
        float sv[16];
#pragma unroll
        for (int j = 0; j < 8; ++j) { sv[j] = a0[j] + a1[j]; sv[8 + j] = a0[j] * a0[j] + a1[j] * a1[j]; }
        const float tot = wave_reduce16(sv, lane);
        if ((lane & 3) == 0) red[wave * 16 + (lane >> 2)] = tot;
        __syncthreads();
#pragma unroll
        for (int j = 0; j < 8; ++j) {
            float t1 = 0.f, t2 = 0.f;
#pragma unroll
            for (int w = 0; w < 4; ++w) { t1 += red[(4 * th + w) * 16 + j]; t2 += red[(4 * th + w) * 16 + 8 + j]; }
            const float mean = t1 * (1.0f / CD); float var = t2 * (1.0f / CD) - mean * mean; var = var > 0.f ? var : 0.f;
            const float rstd = rsqrtf(var + EPS);
            const float y0 = (a0[j] - mean) * rstd * lg0_ + lb0_, y1 = (a1[j] - mean) * rstd * lg1_ + lb1_;
            *(unsigned*)(CS + ((size_t)(t0 + 8 * th + j)) * CD + 2 * cp) = pk2(y0 * sigm(y0), y1 * sigm(y1));
        }
        switch (grp) {
            case 0: pool_unit<1>(Us, PDo, th, cp, t0, s0); break;
            case 1: pool_unit<2>(Us, PDo, th, cp, t0, s0); break;
            case 2: pool_unit<4>(Us, PDo, th, cp, t0, s0); break;
            default: pool_unit<8>(Us, PDo, th, cp, t0, s0); break;
        }
    }
#undef P2_FETCH
    __syncthreads();
}

__device__ __forceinline__ void phase6(const Args& a, LAS unsigned char* lds, int gw, int NGW, int lane) {
    unsigned char* ws = a.ws;
    constexpr int WST = DM + 8;
    LAS bf16_t* WH = (LAS bf16_t*)lds; LAS bf16_t* WL = WH + NE * WST;
    { int t_ = threadIdx.x; asm volatile("" : "+v"(t_));
      for (int q = t_; q < DM * NE; q += NTHREADS) { const int d = q >> 4, e = q & 15; const float w = a.in[I_WR][q] * a.in[I_N2G][d];
          const unsigned hi = f2bf(w); const float rem = w - __uint_as_float(hi << 16); WH[e * WST + d] = (bf16_t)hi; WL[e * WST + d] = (bf16_t)f2bf(rem); } }
    __syncthreads();
    const bf16_t* X1 = (const bf16_t*)(ws + WS_X1B); float* RS1 = (float*)(ws + WS_RSTD1); float* AFF = (float*)(ws + WS_AFF); unsigned char* X1Q = ws + WS_X1Q;
    const int fr = lane & 15, fq = lane >> 4;
    for (int grp = gw; grp < NT / 16; grp += NGW) {
        const int row0 = grp * 16;
        const bf16_t* xp = X1 + (size_t)(row0 + fr) * DM + 8 * fq;
        bf16x8 af[32];
#pragma unroll
        for (int sidx = 0; sidx < 32; ++sidx) af[sidx] = *(const bf16x8*)(xp + 32 * sidx);
        f32x4 acc = (f32x4){0.f, 0.f, 0.f, 0.f}; float ss = 0.f, mx = 0.f;
#pragma unroll
        for (int sidx = 0; sidx < 32; ++sidx) {
            if ((sidx & 3) == 0) asm volatile("" ::: "memory");
            const bf16x8 bh = *(const LAS bf16x8*)(WH + fr * WST + 32 * sidx + 8 * fq), bl = *(const LAS bf16x8*)(WL + fr * WST + 32 * sidx + 8 * fq);
            acc = __builtin_amdgcn_mfma_f32_16x16x32_bf16(af[sidx], bh, acc, 0, 0, 0);
            acc = __builtin_amdgcn_mfma_f32_16x16x32_bf16(af[sidx], bl, acc, 0, 0, 0);
#pragma unroll
            for (int j = 0; j < 8; ++j) { const float xv = __uint_as_float(((unsigned)(unsigned short)af[sidx][j]) << 16); ss += xv * xv; mx = fmaxf(mx, fabsf(xv)); }
        }
        ss += __shfl_xor(ss, 16); ss += __shfl_xor(ss, 32);
        const float rstd = rsqrtf(ss * (1.0f / DM) + EPS);
        mx = fmaxf(mx, __shfl_xor(mx, 16)); mx = fmaxf(mx, __shfl_xor(mx, 32)); mx = fmaxf(mx, 1e-30f);
        if (fq == 0) RS1[row0 + fr] = rstd * (mx * (1.0f / 127.0f)) * WQ_INV;
        { const float qs = 127.0f * __builtin_amdgcn_rcpf(mx); unsigned char* qp = X1Q + (size_t)(row0 + fr) * DM + 8 * fq;
#pragma unroll
          for (int sidx = 0; sidx < 32; ++sidx) { asm volatile("" : "+v"(af[sidx]));
              const u32x4 w = __builtin_bit_cast(u32x4, af[sidx]);
              u32x2 q; q.x = q8x4s((f32x4){bf_lo(w.x), bf_hi(w.x), bf_lo(w.y), bf_hi(w.y)}, qs); q.y = q8x4s((f32x4){bf_lo(w.z), bf_hi(w.z), bf_lo(w.w), bf_hi(w.w)}, qs); *(u32x2*)(qp + 32 * sidx) = q; } }
        f32x4 av;
#pragma unroll
        for (int r = 0; r < 4; ++r) {
            const float lg = acc[r] * __shfl(rstd, 4 * fq + r);
            float mx = lg;
#pragma unroll
            for (int o2 = 1; o2 < 16; o2 <<= 1) mx = fmaxf(mx, __shfl_xor(mx, o2));
            const float pe = __expf(lg - mx); float den = pe;
#pragma unroll
            for (int o2 = 1; o2 < 16; o2 <<= 1) den += __shfl_xor(den, o2);
            av[r] = pe / den;
        }
        *(f32x4*)(AFF + ((size_t)((row0 / SEQ) * NE + fr)) * SEQ + (row0 % SEQ) + 4 * fq) = av;
    }
    __syncthreads();
}

__device__ __forceinline__ void phase7(const Args& a, LAS unsigned char* lds, int G, int cidx) {
    unsigned char* ws = a.ws;
    const float* AFF = (const float*)(ws + WS_AFF); int* IDX = (int*)(ws + WS_IDX); float* VAL = (float*)(ws + WS_VAL); int* INV = (int*)(ws + WS_INV);
    const float* RS1 = (const float*)(ws + WS_RSTD1); float* RSV = (float*)(ws + WS_RSV);
    LAS int* cnt = (LAS int*)lds;
    LAS int* wtot = cnt + 48;
    int tid_ = threadIdx.x; asm volatile("" : "+v"(tid_));
    const int tid = tid_, wave = tid >> 6, lane = tid & 63;
    for (int be = cidx; be < NB * NE; be += G) {
        const int b = be >> 4, e = be & 15;
        __syncthreads();
        unsigned v[4];
        { const f32x4 t4 = *(const f32x4*)(AFF + (size_t)be * SEQ + 4 * tid); v[0] = __float_as_uint(t4.x); v[1] = __float_as_uint(t4.y); v[2] = __float_as_uint(t4.z); v[3] = __float_as_uint(t4.w); }
        unsigned T = 0u;
        {
            const unsigned cand = 1u << 30; int c = 0;
#pragma unroll
            for (int j = 0; j < 4; ++j) c += (int)__popcll(__ballot(v[j] >= cand));
            if (lane == 0) cnt[wave * 3] = c;
            __syncthreads();
            int tot = 0;
#pragma unroll
            for (int w = 0; w < 8; ++w) tot += cnt[w * 3];
            if (tot >= CAP) T = cand;
        }
        for (int step = 0; step < 15; ++step) {
            const int hi = 29 - 2 * step, lo = hi - 1;
            const unsigned c1 = T | (1u << lo), c2 = T | (1u << hi), c3 = c2 | (1u << lo);
            int n1 = 0, n2 = 0, n3 = 0;
#pragma unroll
            for (int j = 0; j < 4; ++j) { n1 += (int)__popcll(__ballot(v[j] >= c1)); n2 += (int)__popcll(__ballot(v[j] >= c2)); n3 += (int)__popcll(__ballot(v[j] >= c3)); }
            LAS int* slot = cnt + 24 * ((step + 1) & 1);
            if (lane == 0) { slot[wave * 3] = n1; slot[wave * 3 + 1] = n2; slot[wave * 3 + 2] = n3; }
            __syncthreads();
            int t1 = 0, t2 = 0, t3 = 0;
#pragma unroll
            for (int w = 0; w < 8; ++w) { t1 += slot[w * 3]; t2 += slot[w * 3 + 1]; t3 += slot[w * 3 + 2]; }
            T = (t3 >= CAP) ? c3 : (t2 >= CAP) ? c2 : (t1 >= CAP) ? c1 : T;
        }
        int mygt = 0, myeq = 0;
#pragma unroll
        for (int j = 0; j < 4; ++j) { mygt += (v[j] > T) ? 1 : 0; myeq += (v[j] == T) ? 1 : 0; }
        const int pk = mygt | (myeq << 16); int inc = pk;
#pragma unroll
        for (int o = 1; o < 64; o <<= 1) { const int t = __shfl_up(inc, o); if (lane >= o) inc += t; }
        __syncthreads();
        if (lane == 63) wtot[wave] = inc;
        __syncthreads();
        int base = 0, total = 0;
#pragma unroll
        for (int w = 0; w < 8; ++w) { const int t = wtot[w]; if (w < wave) base += t; total += t; }
        const int excl = base + inc - pk; int pg = excl & 0xffff, pq = excl >> 16;
        const int ngt = total & 0xffff, need = CAP - ngt;
#pragma unroll
        for (int j = 0; j < 4; ++j) {
            const int tok = 4 * tid + j; int slot = -1;
            if (v[j] > T) { slot = pg + (pq < need ? pq : need); ++pg; }
            else if (v[j] == T) { if (pq < need) slot = pg + pq; ++pq; }
            INV[((size_t)(b * SEQ + tok)) * NE + e] = slot;
            if (slot >= 0) { IDX[be * CAP + slot] = tok; VAL[be * CAP + slot] = __uint_as_float(v[j]) * W8_INV; RSV[be * CAP + slot] = RS1[b * SEQ + tok]; }
        }
    }
    __syncthreads();
}

__device__ __forceinline__ void r16_acc(f32x4 (&v)[4], const u32x4 (&w)[2]) {
#pragma unroll
    for (int j = 0; j < 2; ++j) {
        v[2 * j].x += bf_lo(w[j].x); v[2 * j].y += bf_hi(w[j].x); v[2 * j].z += bf_lo(w[j].y); v[2 * j].w += bf_hi(w[j].y);
        v[2 * j + 1].x += bf_lo(w[j].z); v[2 * j + 1].y += bf_hi(w[j].z); v[2 * j + 1].z += bf_lo(w[j].w); v[2 * j + 1].w += bf_hi(w[j].w);
    }
}
__device__ __forceinline__ void l16_acc_fp8(f32x4 (&v)[4], const u32x4 w) {
    typedef float f2_ __attribute__((ext_vector_type(2)));
    const unsigned wj[4] = {w.x, w.y, w.z, w.w};
#pragma unroll
    for (int j = 0; j < 4; ++j) { const f2_ lo = __builtin_amdgcn_cvt_pk_f32_fp8((int)wj[j], false), hi = __builtin_amdgcn_cvt_pk_f32_fp8((int)wj[j], true);
        v[j].x += lo.x; v[j].y += lo.y; v[j].z += hi.x; v[j].w += hi.y; }
}
__device__ __forceinline__ void phase10(const Args& a, int gw, int NGW, int lane, bf16_t* XO) {
    unsigned char* ws = a.ws;
    const int* INV = (const int*)(ws + WS_INV); const unsigned char* YE = (const unsigned char*)(ws + WS_YE); const bf16_t* X = (const bf16_t*)(ws + WS_X1B); float* RS = (float*)(ws + WS_RSTD2); unsigned char* X2Q = ws + WS_X2Q;
    u32x4 nx[2]; u32x4 ny[4]; int inv1 = -1, inv2 = -1; unsigned msk1 = 0u;
    const int col0 = 256 * (lane >> 4) + 128 * ((lane & 3) >> 1) + 32 * ((lane & 15) >> 2) + 16 * (lane & 1);
#define P10_ISSUE(mrow, invreg, mskout) do { const int b_ = (mrow) / SEQ; \
        mskout = (unsigned)__builtin_amdgcn_readfirstlane((int)(__ballot((invreg) >= 0) & 0xffffull)); \
        _Pragma("unroll") for (int j = 0; j < 2; ++j) nx[j] = *(const u32x4*)(X + (size_t)(mrow) * DM + col0 + 8 * j); \
        unsigned mm_ = mskout; \
        _Pragma("unroll") for (int k = 0; k < 4; ++k) { const bool act_ = mm_ != 0u; const int e_ = act_ ? __builtin_ctz(mm_) : 0; mm_ &= mm_ - 1u; const int sl_ = __builtin_amdgcn_readlane((invreg), e_); \
            const unsigned char* yr_ = (act_ ? YE + ((size_t)(b_ * NE + e_) * CAP + sl_) * DM : (const unsigned char*)(X + (size_t)(mrow) * DM)) + 16 * lane;     \
            ny[k] = *(const u32x4*)yr_; } } while (0)
    if (gw < NT) inv1 = INV[(size_t)gw * NE + (lane & 15)];
    if (gw + NGW < NT) inv2 = INV[(size_t)(gw + NGW) * NE + (lane & 15)];
    if (gw < NT) P10_ISSUE(gw, inv1, msk1);
    for (int m = gw; m < NT; m += NGW) {
        const int b = m / SEQ;
        f32x4 v[4]; u32x4 y[4]; const int inv0 = inv1; const unsigned msk0 = msk1;
        r16_unpack(v, nx);
#pragma unroll
        for (int k = 0; k < 4; ++k) y[k] = ny[k];
        inv1 = inv2;
        if (m + 2 * NGW < NT) inv2 = INV[(size_t)(m + 2 * NGW) * NE + (lane & 15)];
        if (m + NGW < NT) P10_ISSUE(m + NGW, inv1, msk1);
        unsigned mm = msk0;
#pragma unroll
        for (int k = 0; k < 4; ++k) { if (mm) { mm &= mm - 1u; l16_acc_fp8(v, y[k]); } }
        while (mm) {
            const int e = __builtin_ctz(mm); mm &= mm - 1u; const int sl = __builtin_amdgcn_readlane(inv0, e);
            const u32x4 w = *(const u32x4*)(YE + ((size_t)(b * NE + e) * CAP + sl) * DM + 16 * lane); l16_acc_fp8(v, w);
        }
        float s = 0.f, mx = 0.f;
#pragma unroll
        for (int j = 0; j < 4; ++j) { s += (v[j].x * v[j].x + v[j].y * v[j].y) + (v[j].z * v[j].z + v[j].w * v[j].w);
            mx = fmaxf(fmaxf(mx, fmaxf(fabsf(v[j].x), fabsf(v[j].y))), fmaxf(fabsf(v[j].z), fabsf(v[j].w))); }
        const float rstd = rsqrtf(wave_sum(s) * (1.0f / DM) + EPS);
#pragma unroll
        for (int o = 1; o < 64; o <<= 1) mx = fmaxf(mx, __shfl_xor(mx, o));
        mx = fmaxf(mx, 1e-30f); const float qs = 127.0f * __builtin_amdgcn_rcpf(mx);
        if (lane == 0) RS[m] = rstd * (mx * (1.0f / 127.0f)) * WQ_INV;
#pragma unroll
        for (int j = 0; j < 2; ++j) store_bf8(XO + (size_t)m * DM + col0 + 8 * j, v[2 * j], v[2 * j + 1]);
        u32x4 q;
        q.x = q8x4s(v[0], qs); q.y = q8x4s(v[1], qs); q.z = q8x4s(v[2], qs); q.w = q8x4s(v[3], qs);
        *(u32x4*)(X2Q + (size_t)m * DM + col0) = q;
    }
#undef P10_ISSUE
    const f32x4* P = (const f32x4*)a.in[I_P]; u32x2* PB = (u32x2*)(ws + WS_PBF);
    const size_t nq = (size_t)NT * PLE / 4, stride = (size_t)NGW * 64;
    for (size_t q0 = (size_t)gw * 64 + lane; q0 < nq; q0 += 8 * stride) {
        f32x4 t[8];
#pragma unroll
        for (int i = 0; i < 8; ++i) { const size_t q = q0 + i * stride; t[i] = P[q < nq ? q : q0]; }
#pragma unroll
        for (int i = 0; i < 8; ++i) { const size_t q = q0 + i * stride; if (q < nq) { u32x2 w; w.x = pk2(t[i].x, t[i].y); w.y = pk2(t[i].z, t[i].w); PB[q] = w; } }
    }
}

__device__ __forceinline__ void phase12(const Args& a, int gw, int NGW, int lane, float* XO) {
    unsigned char* ws = a.ws;
    const bf16_t* GL = (const bf16_t*)(ws + WS_GL); const bf16_t* ER = (const bf16_t*)(ws + WS_ERAW); const bf16_t* X = (const bf16_t*)(ws + WS_XN);
    f32x4 gp[4], gf[4];
#pragma unroll
    for (int j = 0; j < 2; ++j) { gp[2 * j] = *(const f32x4*)(a.in[I_PNG] + 512 * j + 8 * lane); gp[2 * j + 1] = *(const f32x4*)(a.in[I_PNG] + 512 * j + 8 * lane + 4);
        gf[2 * j] = *(const f32x4*)(a.in[I_FG] + 512 * j + 8 * lane); gf[2 * j + 1] = *(const f32x4*)(a.in[I_FG] + 512 * j + 8 * lane + 4); }
#pragma unroll
    for (int j = 0; j < 4; ++j) asm volatile("" : "+v"(gp[j]), "+v"(gf[j]));
    u32x4 nx[2]; u32x4 ne[2], ng[2];
#define P12_ISSUE(mrow) do { _Pragma("unroll") for (int j = 0; j < 2; ++j) { nx[j] = *(const u32x4*)(X + (size_t)(mrow) * DM + 512 * j + 8 * lane); \
        ne[j] = *(const u32x4*)(ER + (size_t)(mrow) * DM + 512 * j + 8 * lane); ng[j] = *(const u32x4*)(GL + (size_t)(mrow) * DM + 512 * j + 8 * lane); } } while (0)
    if (gw < NT) P12_ISSUE(gw);
    for (int m = gw; m < NT; m += NGW) {
        f32x4 v[4], ev[4], gv[4]; float se = 0.f;
        r16_unpack(v, nx); r16_unpack(ev, ne); r16_unpack(gv, ng);
        if (m + NGW < NT) P12_ISSUE(m + NGW);
#pragma unroll
        for (int j = 0; j < 4; ++j) se += (ev[j].x * ev[j].x + ev[j].y * ev[j].y) + (ev[j].z * ev[j].z + ev[j].w * ev[j].w);
        const float rse = rsqrtf(wave_sum(se) * (1.0f / DM) + EPS); float s = 0.f;
#pragma unroll
        for (int j = 0; j < 4; ++j) { v[j] = v[j] + gv[j] * (ev[j] * rse * gp[j]); s += (v[j].x * v[j].x + v[j].y * v[j].y) + (v[j].z * v[j].z + v[j].w * v[j].w); }
        const float rstd = rsqrtf(wave_sum(s) * (1.0f / DM) + EPS);
#pragma unroll
        for (int j = 0; j < 2; ++j) { *(f32x4*)(XO + (size_t)m * DM + 512 * j + 8 * lane) = v[2 * j] * rstd * gf[2 * j]; *(f32x4*)(XO + (size_t)m * DM + 512 * j + 8 * lane + 4) = v[2 * j + 1] * rstd * gf[2 * j + 1]; }
    }
#undef P12_ISSUE
}

constexpr int N_PHASES = 13;
template <int LO, int HI>
__global__ void __launch_bounds__(NTHREADS, 2) mk_fwd(Args a) {
    extern __shared__ __attribute__((aligned(16))) unsigned char lds_raw[];
    LAS unsigned char* lds = (LAS unsigned char*)lds_raw;
    const int tid = threadIdx.x, wave = __builtin_amdgcn_readfirstlane(tid >> 6);
    const int G = gridDim.x, bx = blockIdx.x;
    const int vcu = (G % 8 == 0) ? (bx % 8) * (G / 8) + bx / 8 : bx;
    const int gw = vcu * NWAVES + wave, NGW = G * NWAVES;
    unsigned char* ws = a.ws;
#ifndef MK_DUP_MASK
#define MK_DUP_MASK 0
#endif
#define REP(k) (((MK_DUP_MASK >> (k)) & 1) ? 2 : 1)
#define IN(k) (LO <= (k) && (k) < HI)
#define BOTH(k) (IN(k) && IN((k) + 1))
    XcdBarrier bar; bar.bar = (unsigned*)(ws + WS_CTL); bar.x = 0; bar.st = nullptr;
    if (HI - LO > 1) {
        if (tid < 16) ((LAS unsigned*)(lds + MISC_OFF))[tid] = 0u;
        __syncthreads();
        bar = xcd_barrier_post((unsigned*)(ws + WS_CTL), (volatile LAS unsigned*)(lds + MISC_OFF));
    }
#define GRID_BAR(k) do { if (BOTH(k)) { xcd_barrier(bar); if (MK_DUP_MASK & 0x10000) xcd_barrier(bar); } } while (0)
    if (IN(0)) for (int rep_ = 0; rep_ < REP(0); ++rep_) { int l_ = threadIdx.x; asm volatile("" : "+v"(l_)); l_ &= 63; const bool split = (G % 64 == 0); phase0(a, lds, gw, NGW, wave, l_, 0, IT_SMALL, IT_SMALL + (split ? IT_P1 : 0), 3 * IT_EXP - (split ? IT_P1 : 0), true); }
    GRID_BAR(0);
    if (IN(1)) for (int rep_ = 0; rep_ < REP(1); ++rep_) {
        const bool split = (G % 64 == 0);
        if (split && ((bx >> 3) & 7) == 7) {
            int l_ = threadIdx.x; asm volatile("" : "+v"(l_)); l_ &= 63;
            const int ci = (bx >> 6) * 8 + (bx & 7), nci = (G >> 6) * 8;
            phase0(a, lds, ci * NWAVES + wave, nci * NWAVES, wave, l_, IT_SMALL, IT_P1, 0, 0, false);
        } else {
            const int cg = split ? ((bx >> 6) * 56 + ((bx >> 3) & 7) * 8 + (bx & 7)) : bx, Gg = split ? (G >> 6) * 56 : G;
            GemmDesc g{(const bf16_t*)(ws + WS_XQ), (const bf16_t*)(ws + WS_WIN), DM / 2, DM / 2, NT / 256, INC / 256, 0, 0, 0, nullptr, nullptr};
            Epi1 E{(bf16_t*)(ws + WS_V), (bf16_t*)(ws + WS_U), (bf16_t*)(ws + WS_G), a.in[I_BGATE], (const float*)(ws + WS_RSTD0)};
            gemm_phase<1>(lds, g, Gg, cg, E);
        }
    }
    GRID_BAR(1);
    if (IN(2)) for (int rep_ = 0; rep_ < REP(2); ++rep_) phase2(a, lds, G, vcu);
    GRID_BAR(2);
    if (IN(4)) for (int rep_ = 0; rep_ < REP(4); ++rep_) {
        GemmDesc g{(const bf16_t*)(ws + WS_PD), (const bf16_t*)(ws + WS_WCAT), PDIM, 640, NT / 256, DM / 256, 128, 0, 0, nullptr, (const bf16_t*)(ws + WS_CS)};
        Epi23 E{(const bf16_t*)(ws + WS_G), a.in[I_PSCALE], (bf16_t*)(ws + WS_MERGED)};
        gemm_phase<3>(lds, g, G, bx, E);
    }
    GRID_BAR(4);
    if (IN(5)) for (int rep_ = 0; rep_ < REP(5); ++rep_) {
        GemmDesc g{(const bf16_t*)(ws + WS_MERGED), (const bf16_t*)(ws + WS_WOUT), DM, DM, NT / 256, DM / 256, 0, 0, 0, nullptr, nullptr};
        Epi4 E{(const bf16_t*)(ws + WS_XN), (bf16_t*)(ws + WS_X1B)};
        gemm_phase<4>(lds, g, G, bx, E);
    }
    GRID_BAR(5);
    if (IN(6)) for (int rep_ = 0; rep_ < REP(6); ++rep_) { int l_ = threadIdx.x; asm volatile("" : "+v"(l_)); l_ &= 63; phase6(a, lds, gw, NGW, l_); }
    GRID_BAR(6);
    if (IN(7)) for (int rep_ = 0; rep_ < REP(7); ++rep_) phase7(a, lds, G, vcu);
    GRID_BAR(7);
    if (IN(8)) for (int rep_ = 0; rep_ < REP(8); ++rep_) {
        GemmDesc g{(const bf16_t*)(ws + WS_X1Q), (const bf16_t*)(ws + WS_WGU), DM / 2, DM / 2, NB * NE, 2048 / 256, 0, 1, (size_t)2048 * DM / 2, (const int*)(ws + WS_IDX), nullptr};
        Epi5 E{ws + WS_HID, (const float*)(ws + WS_RSV)};
        gemm_phase<5>(lds, g, G, bx, E);
    }
    GRID_BAR(8);
    if (IN(9)) for (int rep_ = 0; rep_ < REP(9); ++rep_) {
        GemmDesc g{(const bf16_t*)(ws + WS_HID), (const bf16_t*)(ws + WS_WD), FF / 2, FF / 2, NB * NE, DM / 256, 0, 1, (size_t)DM * FF / 2, nullptr, nullptr};
        Epi6 E{(const float*)(ws + WS_VAL), (unsigned char*)(ws + WS_YE)};
        gemm_phase<6>(lds, g, G, bx, E);
    }
    GRID_BAR(9);
    if (IN(10)) for (int rep_ = 0; rep_ < REP(10); ++rep_) { int l_ = threadIdx.x; asm volatile("" : "+v"(l_)); l_ &= 63; phase10(a, gw, NGW, l_, (bf16_t*)(ws + WS_XN)); }
    GRID_BAR(10);
    if (IN(11)) for (int rep_ = 0; rep_ < REP(11); ++rep_) {
        { GemmDesc g{(const bf16_t*)(ws + WS_X2Q), (const bf16_t*)(ws + WS_WPG), DM / 2, DM / 2, NT / 256, DM / 256, 0, 0, 0, nullptr, nullptr};
          Epi7 E{a.in[I_BPG], (bf16_t*)(ws + WS_GL), (const float*)(ws + WS_RSTD2)};
          gemm_phase<7>(lds, g, G, bx, E); }
        { GemmDesc g{(const bf16_t*)(ws + WS_PBF), (const bf16_t*)(ws + WS_WPLE), PLE, PLE, NT / 256, DM / 256, 0, 0, 0, nullptr, nullptr};
          Epi8 E{(bf16_t*)(ws + WS_ERAW)};
          gemm_phase<8>(lds, g, G, bx, E); }
    }
    GRID_BAR(11);
    if (IN(12)) for (int rep_ = 0; rep_ < REP(12); ++rep_) { int l_ = threadIdx.x; asm volatile("" : "+v"(l_)); l_ &= 63; phase12(a, gw, NGW, l_, a.out); }
#undef IN
#undef BOTH
#undef GRID_BAR
}

#ifndef MK_ONE_LAUNCH
#define MK_ONE_LAUNCH 1
#endif
typedef void (*kern_t)(Args);
#if !MK_ONE_LAUNCH
template <int P> struct PhaseTab { static void fill(kern_t* t) { t[P] = mk_fwd<P, P + 1>; PhaseTab<P - 1>::fill(t); } };
template <> struct PhaseTab<-1> { static void fill(kern_t*) {} };
constexpr int N_KERNELS = N_PHASES;
#else
constexpr int N_KERNELS = 1;
#endif

extern "C" void kernel_launch(void* const* d_in, const int* in_sizes, int n_in, void* d_out, int out_size, void* d_ws, size_t ws_size, hipStream_t stream) {
    static int grid = 0; static kern_t tab[N_KERNELS];
    if (grid == 0) {
        if (n_in != 24 || in_sizes[0] != NT * DM || out_size != NT * DM || ws_size < WS_END) {
            fprintf(stderr, "kernel_launch: unexpected shapes: n_in %d in0 %d out %d ws %zu (need %zu)\n", n_in, n_in > 0 ? in_sizes[0] : -1, out_size, ws_size, (size_t)WS_END); grid = -1; return; }
        int dev = 0, cus = 0;
        if (hipGetDevice(&dev) != hipSuccess || hipDeviceGetAttribute(&cus, hipDeviceAttributeMultiprocessorCount, dev) != hipSuccess) { grid = -1; return; }
#if !MK_ONE_LAUNCH
        PhaseTab<N_PHASES - 1>::fill(tab);
#else
        tab[0] = mk_fwd<0, N_PHASES>;
#endif
        for (int p = 0; p < N_KERNELS; ++p) {
            int per_cu = 0;
            if (hipFuncSetAttribute((const void*)tab[p], hipFuncAttributeMaxDynamicSharedMemorySize, LDS_BYTES) != hipSuccess) { fprintf(stderr, "kernel_launch: hipFuncSetAttribute failed (kernel %d)\n", p); grid = -1; return; }
            if (hipOccupancyMaxActiveBlocksPerMultiprocessor(&per_cu, (const void*)tab[p], NTHREADS, LDS_BYTES) != hipSuccess || per_cu < 1) { fprintf(stderr, "kernel_launch: occupancy query says %d (kernel %d)\n", per_cu, p); grid = -1; (void)hipGetLastError(); return; }
        }
        grid = cus;
    }
    if (grid < 0) return;
    Args a{};
    for (int i = 0; i < 24; ++i) a.in[i] = (const float*)d_in[i];
    a.out = (float*)d_out; a.ws = (unsigned char*)d_ws;
#if MK_ONE_LAUNCH
    if (hipMemsetAsync((char*)d_ws + WS_CTL, 0, CTL_ZERO_BYTES, stream) != hipSuccess) { fprintf(stderr, "kernel_launch: memset failed\n"); return; }
#endif
    for (int p = 0; p < N_KERNELS; ++p) hipLaunchKernelGGL(tab[p], dim3(grid), dim3(NTHREADS), LDS_BYTES, stream, a);
}
```

```cpp
#include <hip/hip_runtime.h>
#include <cstdio>
#include <cstdint>

#define LAS __attribute__((address_space(3)))
typedef unsigned short bf16_t;
typedef float f32x4 __attribute__((ext_vector_type(4)));
typedef unsigned u32x2 __attribute__((ext_vector_type(2)));
typedef unsigned u32x4 __attribute__((ext_vector_type(4)));

constexpr int NB = 16, SEQ = 2048, DM = 1024, NT = NB * SEQ;
constexpr int PLE = 256, CD = 512, CWID = 31, PDIM = 512, NE = 16, FF = 1024, CAP = 256, INC = 3584;
constexpr float EPS = 1e-6f;
constexpr int NWAVES = 8, NTHREADS = 512;
constexpr int LDS_BYTES = 147456;

constexpr size_t MiB = 1u << 20;
constexpr size_t WS_CTL = 0;
constexpr size_t WS_WIN = 1 * MiB;
constexpr size_t WS_WCAT = 8 * MiB;
constexpr size_t WS_WPLE = 9 * MiB + 512 * 1024;
constexpr size_t WS_WOUT = 10 * MiB;
constexpr size_t WS_WPG = 12 * MiB;
constexpr size_t WS_WGU = 14 * MiB;
constexpr size_t WS_WD = 78 * MiB;
constexpr size_t WS_XN = 111 * MiB;
constexpr size_t WS_R1 = 175 * MiB;
constexpr size_t WS_V = WS_R1;
constexpr size_t WS_U = WS_R1 + 32 * MiB;
constexpr size_t WS_G = WS_R1 + 64 * MiB;
constexpr size_t WS_MERGED = WS_R1;
constexpr size_t WS_HID = WS_R1;
constexpr size_t WS_GL = WS_R1 + 64 * MiB;
constexpr size_t WS_PBF = WS_R1;
constexpr size_t WS_X2Q = WS_R1 + 16 * MiB;
constexpr size_t WS_X1B = WS_R1 + 128 * MiB;
constexpr size_t WS_R2 = 367 * MiB;
constexpr size_t WS_CS = WS_R2;
constexpr size_t WS_PD = WS_R2 + 32 * MiB;
constexpr size_t WS_XQ = WS_R2;
constexpr size_t WS_X1Q = WS_R2;
constexpr size_t WS_YE = WS_R2;
constexpr size_t WS_ERAW = WS_R2;
constexpr size_t WS_AFF = 495 * MiB;
constexpr size_t WS_IDX = 497 * MiB;
constexpr size_t WS_VAL = 497 * MiB + 512 * 1024;
constexpr size_t WS_INV = 498 * MiB;
constexpr size_t WS_RSTD2 = 500 * MiB;
constexpr size_t WS_RSTD0 = 502 * MiB;
constexpr size_t WS_RSTD1 = 501 * MiB;
constexpr size_t WS_RSV = 497 * MiB + 256 * 1024;
constexpr size_t WS_END = 512 * MiB;

#define LDS_WAIT() asm volatile("s_waitcnt lgkmcnt(0)" ::: "memory")
#define VM_WAIT() asm volatile("s_waitcnt vmcnt(0)" ::: "memory")
__device__ __forceinline__ unsigned f2bf(float f) { unsigned u = __float_as_uint(f); return (u + 0x7fffu + ((u >> 16) & 1u)) >> 16; }
typedef float f32x2p __attribute__((ext_vector_type(2))); typedef __bf16 bf16x2p __attribute__((ext_vector_type(2)));
__device__ __forceinline__ unsigned pk2(float lo, float hi) { const f32x2p v = {lo, hi}; const bf16x2p b = __builtin_convertvector(v, bf16x2p); return __builtin_bit_cast(unsigned, b); }
__device__ __forceinline__ float bf_lo(unsigned w) { return __uint_as_float(w << 16); }
__device__ __forceinline__ float bf_hi(unsigned w) { return __uint_as_float(w & 0xffff0000u); }
__device__ __forceinline__ float sigm(float x) { return __builtin_amdgcn_rcpf(1.0f + __expf(-x)); }
__device__ __forceinline__ f32x4 sigm4(f32x4 v) { f32x4 o; o.x = sigm(v.x); o.y = sigm(v.y); o.z = sigm(v.z); o.w = sigm(v.w); return o; }
__device__ __forceinline__ void store_bf4(bf16_t* p, f32x4 v) { u32x2 w; w.x = pk2(v.x, v.y); w.y = pk2(v.z, v.w); *(u32x2*)p = w; }
__device__ __forceinline__ f32x4 load_bf4(const bf16_t* p) { const u32x2 w = *(const u32x2*)p; f32x4 o; o.x = bf_lo(w.x); o.y = bf_hi(w.x); o.z = bf_lo(w.y); o.w = bf_hi(w.y); return o; }
__device__ __forceinline__ void store_bf8(bf16_t* p, f32x4 lo, f32x4 hi) { u32x4 w; w.x = pk2(lo.x, lo.y); w.y = pk2(lo.z, lo.w); w.z = pk2(hi.x, hi.y); w.w = pk2(hi.z, hi.w); *(u32x4*)p = w; }
__device__ __forceinline__ void load_bf8(const bf16_t* p, f32x4& lo, f32x4& hi) { const u32x4 w = *(const u32x4*)p; lo = (f32x4){bf_lo(w.x), bf_hi(w.x), bf_lo(w.y), bf_hi(w.y)}; hi = (f32x4){bf_lo(w.z), bf_hi(w.z), bf_lo(w.w), bf_hi(w.w)}; }
__device__ __forceinline__ void r16_unpack(f32x4 (&o)[4], const u32x4 (&w)[2]) {
#pragma unroll
    for (int j = 0; j < 2; ++j) { o[2 * j] = (f32x4){bf_lo(w[j].x), bf_hi(w[j].x), bf_lo(w[j].y), bf_hi(w[j].y)}; o[2 * j + 1] = (f32x4){bf_lo(w[j].z), bf_hi(w[j].z), bf_lo(w[j].w), bf_hi(w[j].w)}; }
}
__device__ __forceinline__ unsigned pk_fp8x4(float a, float b, float c, float d) { int p = __builtin_amdgcn_cvt_pk_fp8_f32(a, b, 0, false); p = __builtin_amdgcn_cvt_pk_fp8_f32(c, d, p, true); return (unsigned)p; }
__device__ __forceinline__ unsigned q8x4(float a, float b, float c, float d) {
    const float M = 12582912.0f; const unsigned ua = __float_as_uint(a + M), ub = __float_as_uint(b + M), uc = __float_as_uint(c + M), ud = __float_as_uint(d + M);
    return __builtin_amdgcn_perm(__builtin_amdgcn_perm(ud, uc, 0x0c0c0400u), __builtin_amdgcn_perm(ub, ua, 0x0c0c0400u), 0x05040100u); }
__device__ __forceinline__ unsigned q8x4s(f32x4 v, float s) {
    const f32x4 t = v * s + 12582912.0f; const unsigned ua = __float_as_uint(t.x), ub = __float_as_uint(t.y), uc = __float_as_uint(t.z), ud = __float_as_uint(t.w);
    return __builtin_amdgcn_perm(__builtin_amdgcn_perm(ud, uc, 0x0c0c0400u), __builtin_amdgcn_perm(ub, ua, 0x0c0c0400u), 0x05040100u); }
__device__ __forceinline__ float clamp127(float v) { return __builtin_amdgcn_fmed3f(v, -127.0f, 127.0f); }
constexpr float WQ_SCALE = 127.0f * 32.0f / 4.0f, WQ_INV = 4.0f / (127.0f * 32.0f);
constexpr float W8_SCALE = 32.0f, W8_INV = 1.0f / 32.0f;
__device__ __forceinline__ float wave_sum(float v) {
#pragma unroll
    for (int o = 1; o < 64; o <<= 1) v += __shfl_xor(v, o);
    return v;
}


#define XB_TMO      128
#define XB_XCNT(j)  (256  + 64 * (j))
#define XB_XSUB(j)  (1280 + 64 * (j))
#define XB_XGEN(j)  (2304 + 64 * (j))
#define XB_TOP      3328
#define XB_TOPGEN   3392
#define XCD_BAR_WORDS 3456
#define XB_SPIN_CAP (1u << 18)
__device__ __forceinline__ unsigned xb_ld(unsigned* p)              { return __hip_atomic_load(p, __ATOMIC_RELAXED, __HIP_MEMORY_SCOPE_AGENT); }
__device__ __forceinline__ unsigned xb_add(unsigned* p, unsigned v) { return __hip_atomic_fetch_add(p, v, __ATOMIC_RELAXED, __HIP_MEMORY_SCOPE_AGENT); }
__device__ __forceinline__ unsigned xb_xcc_id() { return (unsigned)__builtin_amdgcn_s_getreg((3 << 11) | 20) & 0xFu; }
#define XB_SPIN(cond, bar) do { unsigned _sp = 0; while (cond) { __builtin_amdgcn_s_sleep(1); \
    if ((++_sp & 255u) == 0u) { if (xb_ld(&(bar)[XB_TMO])) break; if (_sp > XB_SPIN_CAP) { atomicAdd(&(bar)[XB_TMO], 1u); break; } } } } while (0)
struct XcdBarrier { unsigned* bar; unsigned x; volatile LAS unsigned* st; };
__device__ __forceinline__ XcdBarrier xcd_barrier_post(unsigned* bar, volatile LAS unsigned* st) {
    XcdBarrier b; b.bar = bar; b.x = xb_xcc_id(); b.st = st;
    if (threadIdx.x == 0) (void)xb_add(&bar[XB_XCNT(b.x)], 1u);
    return b;
}
__device__ __forceinline__ void xcd_barrier_complete(unsigned* bar, unsigned x, unsigned& nloc, unsigned& nx) {
    const unsigned G = gridDim.x * gridDim.y * gridDim.z;
    unsigned sum, cnt, mine, sp = 0u;
    for (;;) {
        sum = 0u; cnt = 0u; mine = 0u;
#pragma unroll
        for (unsigned j = 0; j < 16; ++j) { const unsigned c = xb_ld(&bar[XB_XCNT(j)]); sum += c; cnt += (c > 0u) ? 1u : 0u; mine = (j == x) ? c : mine; }
        if (sum == G) break;
        __builtin_amdgcn_s_sleep(1);
        if ((++sp & 255u) == 0u) { if (xb_ld(&bar[XB_TMO])) break; if (sp > XB_SPIN_CAP) { atomicAdd(&bar[XB_TMO], 1u); break; } }
    }
    nloc = mine > 0u ? mine : 1u; nx = cnt > 0u ? cnt : 1u;
}
__device__ __forceinline__ void xcd_barrier(const XcdBarrier& b) {
    asm volatile("s_waitcnt vmcnt(0)" ::: "memory");
    __syncthreads();
    if (threadIdx.x == 0) {
        unsigned* bar = b.bar;
        __builtin_amdgcn_s_waitcnt(0);
        unsigned nloc = b.st[0], nx = b.st[1];
        if (nloc == 0u) { xcd_barrier_complete(bar, b.x, nloc, nx); b.st[0] = nloc; b.st[1] = nx; }
        const unsigned old = xb_add(&bar[XB_XSUB(b.x)], 1u);
        const unsigned gen = old / nloc;
        if (old + 1u == (gen + 1u) * nloc) {
            __builtin_amdgcn_fence(__ATOMIC_RELEASE, "agent");
            asm volatile("s_waitcnt vmcnt(0)" ::: "memory");
            const unsigned og = xb_add(&bar[XB_TOP], 1u);
            const unsigned tg = og / nx;
            if (og + 1u == (tg + 1u) * nx) xb_add(&bar[XB_TOPGEN], 1u);
            else XB_SPIN(xb_ld(&bar[XB_TOPGEN]) == tg, bar);
            __builtin_amdgcn_fence(__ATOMIC_ACQUIRE, "agent");
            xb_add(&bar[XB_XGEN(b.x)], 1u);
            asm volatile("s_waitcnt vmcnt(0)" ::: "memory");
        } else {
            XB_SPIN(xb_ld(&bar[XB_XGEN(b.x)]) == gen, bar);
            __builtin_amdgcn_fence(__ATOMIC_ACQUIRE, "agent");
            asm volatile("s_waitcnt vmcnt(0)" ::: "memory");
        }
    }
    __syncthreads();
}
constexpr int MISC_OFF = LDS_BYTES - 64;
constexpr size_t CTL_ZERO_BYTES = 65536;

struct Unit { int pm, pn; };
constexpr int NXCD = 8, WGM = 8;
struct StaticOrder {
    int nM, nN, nwg, G, c;
    __device__ void init(int nM_, int nN_, int G_, int c_) { nM = nM_; nN = nN_; nwg = nM * nN; G = G_; c = c_; }
    __device__ bool next(int i, Unit& u) const {
        const long L = (long)i * G + c; if (L >= nwg) return false;
        int wgid = (int)L; { const int q = nwg / NXCD, r = nwg % NXCD, xcd = wgid % NXCD, off = wgid / NXCD; wgid = (xcd < r ? xcd * (q + 1) : r * (q + 1) + (xcd - r) * q) + off; }
        const int nig = WGM * nN, gid = wgid / nig, fm = gid * WGM, gsz = (nM - fm) < WGM ? (nM - fm) : WGM;
        u.pm = fm + ((wgid % nig) % gsz); u.pn = (wgid % nig) / gsz; return true;
    }
};
struct GemmDesc {
    const bf16_t* A; const bf16_t* Bt; int lda, K, nM, nN, a_col_step, moe; size_t b_mat_stride; const int* rowidx; const bf16_t* A2;
    __device__ __forceinline__ int mem_pm(int pm) const { return moe ? ((pm & 15) * 16 + (pm >> 4)) : pm; }
    __device__ __forceinline__ const bf16_t* a_ptr(const Unit& u) const { return A + (size_t)mem_pm(u.pm) * 256 * lda + (size_t)u.pn * a_col_step; }
    __device__ __forceinline__ const bf16_t* a2_ptr(const Unit& u) const { return A2 + (size_t)mem_pm(u.pm) * 256 * lda; }
    __device__ __forceinline__ const bf16_t* b_ptr(const Unit& u) const { return Bt + (moe ? (size_t)(u.pm >> 4) * b_mat_stride : (size_t)0) + (size_t)u.pn * 256 * K; }
};

struct Epi1 { static constexpr bool DUAL = false;
    bf16_t* V; bf16_t* U; bf16_t* Gt; const float* bgate; const float* RS;
    struct Early { float r[8]; };
    __device__ __forceinline__ void early(Early& e, int mpm, int rbase) const {
#pragma unroll
        for (int g = 0; g < 8; ++g) e.r[g] = RS[(size_t)mpm * 256 + 128 * (g >> 2) + 16 * (g & 3) + rbase]; }
    struct Ctx { f32x4 b[4]; }; struct Pre {}; static constexpr int DIST = 0;
    __device__ __forceinline__ void begin(Ctx& c, int mpm, int pn, int c8, int rbase) const { const float* bp = bgate + (pn >= 6 ? 256 * (pn - 6) : 0) + c8;
        c.b[0] = *(const f32x4*)bp; c.b[1] = *(const f32x4*)(bp + 4); c.b[2] = *(const f32x4*)(bp + 128); c.b[3] = *(const f32x4*)(bp + 132); }
    __device__ __forceinline__ void prefetch(Pre&, int, int, int, int) const {}
    __device__ __forceinline__ void finish(const Early& ea, const Ctx& c, const Pre&, int g, int mpm, int pn, int r, int c8, f32x4 a0, f32x4 a1, f32x4 b0, f32x4 b1) const {
        const size_t row = (size_t)mpm * 256 + r; const float rs = ea.r[g]; a0 = a0 * rs; a1 = a1 * rs; b0 = b0 * rs; b1 = b1 * rs;
        if (pn < 4) { store_bf8(V + row * CD + 128 * pn + c8, a0 * sigm4(b0), a1 * sigm4(b1)); }
        else if (pn < 6) { bf16_t* p = U + row * PDIM + 256 * (pn - 4) + c8; store_bf8(p, a0, a1); store_bf8(p + 128, b0, b1); }
        else { bf16_t* p = Gt + row * 2048 + 256 * (pn - 6) + c8; store_bf8(p, sigm4(a0 + c.b[0]), sigm4(a1 + c.b[1])); store_bf8(p + 128, sigm4(b0 + c.b[2]), sigm4(b1 + c.b[3])); }
    }
};
struct Epi23 {
    static constexpr bool DUAL = true;
    const bf16_t* Gt; const float* scale; bf16_t* MG;
    struct TCtx { f32x4 s[4]; }; struct TPre { u32x4 g1[2], g2[2]; };
    __device__ __forceinline__ void t_begin(TCtx& c, int mpm, int pn, int c8) const { const float* sp = scale + 256 * pn + c8;
        c.s[0] = *(const f32x4*)sp; c.s[1] = *(const f32x4*)(sp + 4); c.s[2] = *(const f32x4*)(sp + 128); c.s[3] = *(const f32x4*)(sp + 132); }
    __device__ __forceinline__ void t_prefetch(TPre& p, int mpm, int pn, int r, int c8) const { const bf16_t* gp = Gt + ((size_t)mpm * 256 + r) * 2048 + 256 * pn + c8;
        p.g1[0] = *(const u32x4*)gp; p.g1[1] = *(const u32x4*)(gp + 128); p.g2[0] = *(const u32x4*)(gp + 1024); p.g2[1] = *(const u32x4*)(gp + 1024 + 128); }
    __device__ __forceinline__ static f32x4 ratio4(f32x4 g2, f32x4 sc, f32x4 g1) { f32x4 o;
        o.x = g2.x * sc.x * __builtin_amdgcn_rcpf(fmaxf(g1.x, 1e-30f)); o.y = g2.y * sc.y * __builtin_amdgcn_rcpf(fmaxf(g1.y, 1e-30f));
        o.z = g2.z * sc.z * __builtin_amdgcn_rcpf(fmaxf(g1.z, 1e-30f)); o.w = g2.w * sc.w * __builtin_amdgcn_rcpf(fmaxf(g1.w, 1e-30f)); return o; }
    __device__ __forceinline__ void t_apply(const TCtx& c, const TPre& p, f32x4& a0, f32x4& a1, f32x4& b0, f32x4& b1) const {
        f32x4 o1[4], o2[4]; r16_unpack(o1, p.g1); r16_unpack(o2, p.g2);
        a0 = a0 * ratio4(o2[0], c.s[0], o1[0]); a1 = a1 * ratio4(o2[1], c.s[1], o1[1]); b0 = b0 * ratio4(o2[2], c.s[2], o1[2]); b1 = b1 * ratio4(o2[3], c.s[3], o1[3]);
    }
    struct Early {}; __device__ __forceinline__ void early(Early&, int, int) const {}
    struct Ctx {}; struct Pre { u32x4 g[2]; }; static constexpr int DIST = 2;
    __device__ __forceinline__ void begin(Ctx&, int, int, int, int) const {}
    __device__ __forceinline__ void prefetch(Pre& p, int mpm, int pn, int r, int c8) const { const bf16_t* gp = Gt + ((size_t)mpm * 256 + r) * 2048 + 256 * pn + c8;
        p.g[0] = *(const u32x4*)gp; p.g[1] = *(const u32x4*)(gp + 128); }
    __device__ __forceinline__ void finish(const Early& ea, const Ctx&, const Pre& p, int g, int mpm, int pn, int r, int c8, f32x4 a0, f32x4 a1, f32x4 b0, f32x4 b1) const {
        f32x4 o[4]; r16_unpack(o, p.g); bf16_t* mp = MG + ((size_t)mpm * 256 + r) * DM + 256 * pn + c8;
        store_bf8(mp, o[0] * a0, o[1] * a1); store_bf8(mp + 128, o[2] * b0, o[3] * b1);
    }
};
struct Epi4 { static constexpr bool DUAL = false;
    const bf16_t* X; bf16_t* O;
    struct Early {}; __device__ __forceinline__ void early(Early&, int, int) const {}
    struct Ctx {}; struct Pre { u32x4 x[2]; }; static constexpr int DIST = 2;
    __device__ __forceinline__ void begin(Ctx&, int, int, int, int) const {}
    __device__ __forceinline__ void prefetch(Pre& p, int mpm, int pn, int r, int c8) const { const bf16_t* xp = X + ((size_t)mpm * 256 + r) * DM + 256 * pn + c8;
        p.x[0] = *(const u32x4*)xp; p.x[1] = *(const u32x4*)(xp + 128); }
    __device__ __forceinline__ void finish(const Early& ea, const Ctx&, const Pre& p, int g, int mpm, int pn, int r, int c8, f32x4 a0, f32x4 a1, f32x4 b0, f32x4 b1) const {
        f32x4 o[4]; r16_unpack(o, p.x); bf16_t* op = O + ((size_t)mpm * 256 + r) * DM + 256 * pn + c8; store_bf8(op, o[0] + a0, o[1] + a1); store_bf8(op + 128, o[2] + b0, o[3] + b1);
    }
};
struct Epi5 { static constexpr bool DUAL = false;
    unsigned char* H; const float* RSV;
    struct Early { float r[8]; };
    __device__ __forceinline__ void early(Early& e, int mpm, int rbase) const {
#pragma unroll
        for (int g = 0; g < 8; ++g) e.r[g] = RSV[(size_t)mpm * 256 + 128 * (g >> 2) + 16 * (g & 3) + rbase]; }
    struct Ctx {}; struct Pre {}; static constexpr int DIST = 0;
    __device__ __forceinline__ void begin(Ctx&, int, int, int, int) const {}
    __device__ __forceinline__ void prefetch(Pre&, int, int, int, int) const {}
    __device__ __forceinline__ u32x2 hid8(float rs, f32x4 a0, f32x4 a1, f32x4 b0, f32x4 b1) const { const f32x4 g0 = a0 * rs, g1 = a1 * rs;
        const f32x4 h0 = g0 * sigm4(g0) * (b0 * rs), h1 = g1 * sigm4(g1) * (b1 * rs); u32x2 w; w.x = pk_fp8x4(h0.x, h0.y, h0.z, h0.w); w.y = pk_fp8x4(h1.x, h1.y, h1.z, h1.w); return w; }
    __device__ __forceinline__ void finish(const Early& ea, const Ctx& c, const Pre&, int g, int mpm, int pn, int r, int c8, f32x4 a0, f32x4 a1, f32x4 b0, f32x4 b1) const {
        *(u32x2*)(H + ((size_t)mpm * 256 + r) * FF + 128 * pn + c8) = hid8(ea.r[g], a0, a1, b0, b1);
    }
    static constexpr bool PAIR = true;
    __device__ __forceinline__ void finish2(const Early& ea, int g, int mpm, int pn, int r, int c8, f32x4 a0, f32x4 a1, f32x4 b0, f32x4 b1, f32x4 c0, f32x4 c1, f32x4 d0, f32x4 d1) const {
        const u32x2 w0 = hid8(ea.r[g], a0, a1, b0, b1), w1 = hid8(ea.r[g + 1], c0, c1, d0, d1);
        const auto s0 = __builtin_amdgcn_permlane16_swap(w0.x, w1.x, false, false); const auto s1 = __builtin_amdgcn_permlane16_swap(w0.y, w1.y, false, false);
        u32x4 o; o.x = s0[0]; o.y = s1[0]; o.z = s0[1]; o.w = s1[1];
        unsigned char* p = H + ((size_t)mpm * 256 + r) * FF + 128 * pn + c8;
        *(u32x4*)((c8 & 8) ? p + 16 * FF - 8 : p) = o;
    }
};
struct Epi6 { static constexpr bool DUAL = false;
    const float* VAL; unsigned char* YE;
    __device__ __forceinline__ static unsigned pack_fp8x4(f32x4 v) { int p = __builtin_amdgcn_cvt_pk_fp8_f32(v.x, v.y, 0, false); p = __builtin_amdgcn_cvt_pk_fp8_f32(v.z, v.w, p, true); return (unsigned)p; }
    struct Early { float r[8]; };
    __device__ __forceinline__ void early(Early& e, int mpm, int rbase) const {
#pragma unroll
        for (int g = 0; g < 8; ++g) e.r[g] = VAL[(size_t)mpm * 256 + 128 * (g >> 2) + 16 * (g & 3) + rbase]; }
    struct Ctx {}; struct Pre {}; static constexpr int DIST = 0;
    __device__ __forceinline__ void begin(Ctx&, int, int, int, int) const {}
    __device__ __forceinline__ void prefetch(Pre&, int, int, int, int) const {}
    __device__ __forceinline__ void finish(const Early& ea, const Ctx& c, const Pre&, int g, int mpm, int pn, int r, int c8, f32x4 a0, f32x4 a1, f32x4 b0, f32x4 b1) const {
        const float tv = ea.r[g]; unsigned char* p = YE + ((size_t)mpm * 256 + r) * DM + 256 * pn + 2 * (c8 & ~31) + (c8 & 31);
        u32x2 w0, w1; w0.x = pack_fp8x4(a0 * tv); w0.y = pack_fp8x4(a1 * tv); w1.x = pack_fp8x4(b0 * tv); w1.y = pack_fp8x4(b1 * tv);
        const auto r0 = __builtin_amdgcn_permlane16_swap(w0.x, w1.x, false, false); const auto r1 = __builtin_amdgcn_permlane16_swap(w0.y, w1.y, false, false);
        u32x4 o; o.x = r0[0]; o.y = r1[0]; o.z = r0[1]; o.w = r1[1];
        *(u32x4*)((c8 & 8) ? p + 24 : p) = o;
    }
};
struct Epi7 { static constexpr bool DUAL = false;
    const float* bias; bf16_t* GL; const float* RS;
    struct Early { float r[8]; };
    __device__ __forceinline__ void early(Early& e, int mpm, int rbase) const {
#pragma unroll
        for (int g = 0; g < 8; ++g) e.r[g] = RS[(size_t)mpm * 256 + 128 * (g >> 2) + 16 * (g & 3) + rbase]; }
    struct Ctx { f32x4 b[4]; }; struct Pre {}; static constexpr int DIST = 0;
    __device__ __forceinline__ void begin(Ctx& c, int mpm, int pn, int c8, int rbase) const { const float* bp = bias + 256 * pn + c8;
        c.b[0] = *(const f32x4*)bp; c.b[1] = *(const f32x4*)(bp + 4); c.b[2] = *(const f32x4*)(bp + 128); c.b[3] = *(const f32x4*)(bp + 132); }
    __device__ __forceinline__ void prefetch(Pre&, int, int, int, int) const {}
    __device__ __forceinline__ void finish(const Early& ea, const Ctx& c, const Pre&, int g, int mpm, int pn, int r, int c8, f32x4 a0, f32x4 a1, f32x4 b0, f32x4 b1) const {
        const float rs = ea.r[g]; bf16_t* p = GL + ((size_t)mpm * 256 + r) * DM + 256 * pn + c8;
        store_bf8(p, sigm4(a0 * rs + c.b[0]), sigm4(a1 * rs + c.b[1])); store_bf8(p + 128, sigm4(b0 * rs + c.b[2]), sigm4(b1 * rs + c.b[3]));
    }
};
struct Epi8 { static constexpr bool DUAL = false;
    bf16_t* ER;
    struct Early {}; __device__ __forceinline__ void early(Early&, int, int) const {}
    struct Ctx {}; struct Pre {}; static constexpr int DIST = 0;
    __device__ __forceinline__ void begin(Ctx&, int, int, int, int) const {}
    __device__ __forceinline__ void prefetch(Pre&, int, int, int, int) const {}
    __device__ __forceinline__ void finish(const Early& ea, const Ctx&, const Pre&, int g, int mpm, int pn, int r, int c8, f32x4 a0, f32x4 a1, f32x4 b0, f32x4 b1) const {
        bf16_t* p = ER + ((size_t)mpm * 256 + r) * DM + 256 * pn + c8; store_bf8(p, a0, a1); store_bf8(p + 128, b0, b1);
    }
};

typedef short bf16x8 __attribute__((ext_vector_type(8)));
constexpr int BK = 64, HALF = 128, HTB = HALF * BK * 2, STAGE_BYTES = 8 * HTB;
__device__ __forceinline__ int lds_byte(int r, int c) { const int st = (r >> 4) * 2 + (c >> 5), rr = r & 15, cc = c & 31, ob = rr * 64 + cc * 2; return st * 1024 + (ob ^ (((ob >> 9) & 1) << 5)); }
__device__ __forceinline__ int perm32(int rho) { const int n = rho >> 4, i = rho & 15; return 8 * (i >> 2) + 4 * n + (i & 3); }
__device__ __forceinline__ void stage_rc(int b, int& R, int& C) { const int st = b / 1024, sb = b % 1024, swz = sb ^ (((sb >> 9) & 1) << 5); R = (st >> 1) * 16 + swz / 64; C = (st & 1) * 32 + (swz % 64) / 2; }

typedef int i32x4v __attribute__((ext_vector_type(4)));
typedef int i32x8v __attribute__((ext_vector_type(8)));
template <class E, class = void> struct EpiPair { static constexpr bool value = false; };
template <class E> struct EpiPair<E, decltype((void)E::PAIR)> { static constexpr bool value = E::PAIR; };
template <int MODE> struct AccT { typedef f32x4 type; }; template <> struct AccT<2> { typedef i32x4v type; };
__device__ __forceinline__ f32x4 acc_f32(f32x4 v) { return v; }
__device__ __forceinline__ f32x4 acc_f32(i32x4v v) { return __builtin_convertvector(v, f32x4); }
template <class Epi, bool ALIGN_EPI, bool SP2, bool GATHER, int MODE>
__device__ __forceinline__ void gemm_pg8(LAS unsigned char* lds, const GemmDesc& g, int G, int cidx, const Epi& E) {
    static_assert(SP2, "only the two-MFMA-blocks-per-barrier-pair loop carries the gather / dual-source staging");
    constexpr bool FP8 = (MODE == 1), I8 = (MODE == 2); typedef typename AccT<MODE>::type acc_t;
    int tid_ = threadIdx.x; asm volatile("" : "+v"(tid_));
    const int tid = tid_, wid = __builtin_amdgcn_readfirstlane(tid >> 6), lane = tid & 63, wr = wid >> 2, wc = wid & 3, fr = lane & 15, fq = lane >> 4;
    const int K = g.K, nt = K / BK, lda = g.lda;
    StaticOrder S; S.init(g.nM, g.nN, G, cidx);
    unsigned voffA[2], voffB[2];
    int stR[2], stC[2];
#pragma unroll
    for (int i = 0; i < 2; ++i) { stage_rc(tid * 16 + i * 8192, stR[i], stC[i]); voffA[i] = (unsigned)(stR[i] * lda + stC[i]) * 2u; voffB[i] = (unsigned)(((stR[i] & ~31) + perm32(stR[i] & 31)) * K + stC[i]) * 2u; }
    unsigned cv[2][2], nv[2][2];
#define PG8_ROWOFF(dst, u_) do { const int t_ = g.mem_pm((u_).pm); const int* ix_ = g.rowidx + t_ * 256; const int rb_ = (t_ >> 4) * SEQ; \
        _Pragma("unroll") for (int h_ = 0; h_ < 2; ++h_) _Pragma("unroll") for (int i_ = 0; i_ < 2; ++i_) dst[h_][i_] = (unsigned)((rb_ + ix_[128 * h_ + stR[i_]]) * lda + stC[i_]) * 2u; } while (0)
#define PG8_STAGE_A(bufoff, half, ptr, isnext) do { if constexpr (GATHER) { _Pragma("unroll") for (int _i = 0; _i < 2; ++_i) { const unsigned vo_ = (isnext) ? nv[half][_i] : cv[half][_i]; \
        __builtin_amdgcn_global_load_lds((const unsigned*)((const char*)(ptr) + vo_), (LAS unsigned*)(lds + (bufoff) + ldsw + _i * 8192), 16, 0, 0); } } \
        else { PG8_STAGE(bufoff, (ptr) + (half) * hstepA, voffA); } } while (0)
    const size_t kstep = (size_t)(BK * 2);
    const size_t hstepA = (size_t)HALF * lda * 2, hstepB = (size_t)HALF * K * 2;
    const unsigned ldsw = (unsigned)wid * 1024u;
    const int aoff = lds_byte(wr * 64 + fr, fq * 8), boff = lds_byte(wc * 32 + fr, fq * 8);
#define PG8_SA(b, h) (((b) * 2 + (h)) * HTB)
#define PG8_SB(b, h) ((4 + (b) * 2 + (h)) * HTB)
#define PG8_STAGE(bufoff, gbase, voff) do { _Pragma("unroll") for (int _i = 0; _i < 2; ++_i) \
        __builtin_amdgcn_global_load_lds((const unsigned*)((const char*)(gbase) + (voff)[_i]), (LAS unsigned*)(lds + (bufoff) + ldsw + _i * 8192), 16, 0, 0); } while (0)
#define PG8_LDA(dst, b, h) do { _Pragma("unroll") for (int m = 0; m < 4; ++m) _Pragma("unroll") for (int k = 0; k < 2; ++k) dst[m][k] = *(const LAS bf16x8*)(lds + PG8_SA(b, h) + aoff + m * 2048 + k * 1024); } while (0)
#define PG8_LDB(dst, b, h) do { _Pragma("unroll") for (int n = 0; n < 2; ++n) _Pragma("unroll") for (int k = 0; k < 2; ++k) dst[n][k] = *(const LAS bf16x8*)(lds + PG8_SB(b, h) + boff + n * 2048 + k * 1024); } while (0)
#define PG8_CAT(x) __builtin_shufflevector((i32x4v)(x)[0], (i32x4v)(x)[1], 0, 1, 2, 3, 4, 5, 6, 7)
#define PG8_MMA(ai, bj, At, Bt) do { __builtin_amdgcn_s_setprio(1); _Pragma("unroll") for (int m = 0; m < 4; ++m) _Pragma("unroll") for (int n = 0; n < 2; ++n) { \
        if constexpr (FP8) { const i32x8v b8_ = PG8_CAT(Bt[n]), a8_ = PG8_CAT(At[m]); asm volatile("v_mfma_scale_f32_16x16x128_f8f6f4 %0, %1, %2, %0, %3, %3 op_sel_hi:[0,0,0]" : "+v"(acc[ai][bj][m][n]) : "v"(b8_), "v"(a8_), "v"(sc127)); } \
        else if constexpr (I8) { _Pragma("unroll") for (int k = 0; k < 2; ++k) acc[ai][bj][m][n] = __builtin_amdgcn_mfma_i32_16x16x64_i8((i32x4v)Bt[n][k], (i32x4v)At[m][k], acc[ai][bj][m][n], 0, 0, 0); } \
        else { _Pragma("unroll") for (int k = 0; k < 2; ++k) acc[ai][bj][m][n] = __builtin_amdgcn_mfma_f32_16x16x32_bf16(Bt[n][k], At[m][k], acc[ai][bj][m][n], 0, 0, 0); } } __builtin_amdgcn_s_setprio(0); } while (0)
#define PG8_WAIT_V(n) asm volatile("s_waitcnt vmcnt(" #n ")" ::: "memory")
#define PG8_WAIT_L(n) asm volatile("s_waitcnt lgkmcnt(" #n ")" ::: "memory")
#define PG8_BAR __builtin_amdgcn_s_barrier()
#define PG8_SCHED __builtin_amdgcn_sched_barrier(0)
    Unit cur, nxt; int ui = 0;
    if (!S.next(0, cur)) return;
    acc_t acc[2][2][4][2];
#pragma unroll
    for (int a = 0; a < 2; ++a)
#pragma unroll
        for (int b = 0; b < 2; ++b)
#pragma unroll
            for (int m = 0; m < 4; ++m)
#pragma unroll
                for (int n = 0; n < 2; ++n) acc[a][b][m][n] = (acc_t){0, 0, 0, 0};
    bf16x8 At[4][2], B0[2][2], B1[2][2];
    int sc127 = 0x7f7f7f7f; asm volatile("" : "+v"(sc127));
    const char* cA = GATHER ? (const char*)g.A : (const char*)g.a_ptr(cur); const char* cB = (const char*)g.b_ptr(cur);
    const char* cA2 = cA; if constexpr (Epi::DUAL) cA2 = (const char*)g.a2_ptr(cur) - 2 * kstep;
    typename Epi::Early ea; E.early(ea, g.mem_pm(cur.pm), 64 * wr + fr);
    if constexpr (GATHER) {
        PG8_ROWOFF(cv, cur);
        if (S.next(1, nxt)) PG8_ROWOFF(nv, nxt); else { _Pragma("unroll") for (int h_ = 0; h_ < 2; ++h_) _Pragma("unroll") for (int i_ = 0; i_ < 2; ++i_) nv[h_][i_] = cv[h_][i_]; }
        asm volatile("" : "+v"(cv[0][0]), "+v"(cv[0][1]), "+v"(cv[1][0]), "+v"(cv[1][1]), "+v"(nv[0][0]), "+v"(nv[0][1]), "+v"(nv[1][0]), "+v"(nv[1][1]));
    }
    if constexpr (SP2) {
        PG8_STAGE(PG8_SB(0, 0), cB, voffB); PG8_STAGE(PG8_SB(0, 1), cB + hstepB, voffB); PG8_STAGE_A(PG8_SA(0, 0), 0, cA, false); PG8_STAGE_A(PG8_SA(0, 1), 1, cA, false);
        if (wr == 1) PG8_BAR;
        PG8_WAIT_V(2); PG8_BAR;
        PG8_STAGE(PG8_SB(1, 0), cB + kstep, voffB); PG8_STAGE_A(PG8_SA(1, 0), 0, cA + kstep, false); PG8_STAGE(PG8_SB(1, 1), cB + hstepB + kstep, voffB);
        PG8_WAIT_V(6); PG8_BAR;
    }
    for (;;) {
        const bool has_next = S.next(ui + 1, nxt);
        const char* nA = GATHER ? cA : (has_next ? (const char*)g.a_ptr(nxt) : cA); const char* nB = has_next ? (const char*)g.b_ptr(nxt) : cB;
        const char* nA2 = cA2; if constexpr (Epi::DUAL) { if (has_next) nA2 = (const char*)g.a2_ptr(nxt) - 2 * kstep; }
        for (int t = 0; t < nt; t += 2) {
            const bool last = (t == nt - 2);
            const char* a1 = ((Epi::DUAL && t >= 2) ? cA2 : cA) + (size_t)(t + 1) * kstep;
            const char* a2 = last ? nA : (Epi::DUAL ? cA2 : cA) + (size_t)(t + 2) * kstep; const char* b2 = last ? nB : cB + (size_t)(t + 2) * kstep;
            const char* a3 = a2 + kstep; const char* b3 = b2 + kstep;
            if constexpr (SP2) {
            PG8_LDB(B0, 0, 0); PG8_LDB(B1, 0, 1); PG8_SCHED; PG8_LDA(At, 0, 0); PG8_STAGE_A(PG8_SA(1, 1), 1, a1, false);
            PG8_WAIT_V(8); PG8_WAIT_L(0); PG8_BAR; PG8_MMA(0, 0, At, B0); PG8_MMA(0, 1, At, B1); PG8_BAR; PG8_SCHED;
            PG8_LDA(At, 0, 1); PG8_STAGE(PG8_SB(0, 0), b2, voffB); PG8_STAGE(PG8_SB(0, 1), b2 + hstepB, voffB); PG8_STAGE_A(PG8_SA(0, 0), 0, a2, last);
            PG8_WAIT_V(8); PG8_WAIT_L(0); PG8_BAR; PG8_MMA(1, 0, At, B0); PG8_MMA(1, 1, At, B1); PG8_BAR; PG8_SCHED;
            PG8_LDB(B0, 1, 0); PG8_LDB(B1, 1, 1); PG8_SCHED; PG8_LDA(At, 1, 0); PG8_STAGE_A(PG8_SA(0, 1), 1, a2, last);
            PG8_WAIT_V(8); PG8_WAIT_L(0); PG8_BAR; PG8_MMA(0, 0, At, B0); PG8_MMA(0, 1, At, B1); PG8_BAR; PG8_SCHED;
            PG8_LDA(At, 1, 1); PG8_STAGE(PG8_SB(1, 0), b3, voffB); PG8_STAGE(PG8_SB(1, 1), b3 + hstepB, voffB); PG8_STAGE_A(PG8_SA(1, 0), 0, a3, last);
            PG8_WAIT_V(8); PG8_WAIT_L(0); PG8_BAR; PG8_MMA(1, 0, At, B0); PG8_MMA(1, 1, At, B1); PG8_BAR; PG8_SCHED;
            }
            if constexpr (Epi::DUAL && MODE == 0) { if (t == 0) {
                const int mpm_t = g.mem_pm(cur.pm); int fr_t = fr, fq_t = fq; asm volatile("" : "+v"(fr_t), "+v"(fq_t));
                const int rbase = 64 * wr + fr_t, c8 = 32 * wc + 8 * fq_t, pn_ = cur.pn;
                typename Epi::TCtx tc; E.t_begin(tc, mpm_t, pn_, c8);
                typename Epi::TPre tp[3];
                E.t_prefetch(tp[0], mpm_t, pn_, rbase, c8); E.t_prefetch(tp[1], mpm_t, pn_, 16 + rbase, c8);
#pragma unroll
                for (int gi = 0; gi < 8; ++gi) {
                    if (gi + 2 < 8) { const int gn = gi + 2; E.t_prefetch(tp[gn % 3], mpm_t, pn_, 128 * (gn >> 2) + 16 * (gn & 3) + rbase, c8); }
                    E.t_apply(tc, tp[gi % 3], acc[gi >> 2][0][gi & 3][0], acc[gi >> 2][0][gi & 3][1], acc[gi >> 2][1][gi & 3][0], acc[gi >> 2][1][gi & 3][1]);
                    __builtin_amdgcn_sched_barrier(0);
                }
            } }
        }
        if constexpr (FP8) asm volatile("s_nop 15\n\ts_nop 15" ::: "memory");
        if constexpr (ALIGN_EPI) { if (wr == 0) PG8_BAR; }
        {
            const int mpm = g.mem_pm(cur.pm);
            int fr_e = fr, fq_e = fq; asm volatile("" : "+v"(fr_e), "+v"(fq_e));
            const int rbase = 64 * wr + fr_e, c8 = 32 * wc + 8 * fq_e, pn_ = cur.pn;
            typename Epi::Ctx ctx; E.begin(ctx, mpm, pn_, c8, rbase);
            typename Epi::Pre pre[3];
            if constexpr (Epi::DIST > 0) { E.prefetch(pre[0], mpm, pn_, rbase, c8); if constexpr (Epi::DIST > 1) E.prefetch(pre[1], mpm, pn_, 16 + rbase, c8); }
            if constexpr (EpiPair<Epi>::value) {
#pragma unroll
                for (int gi = 0; gi < 8; gi += 2) {
                    E.finish2(ea, gi, mpm, pn_, 128 * (gi >> 2) + 16 * (gi & 3) + rbase, c8, acc_f32(acc[gi >> 2][0][gi & 3][0]), acc_f32(acc[gi >> 2][0][gi & 3][1]), acc_f32(acc[gi >> 2][1][gi & 3][0]), acc_f32(acc[gi >> 2][1][gi & 3][1]),
                              acc_f32(acc[gi >> 2][0][(gi & 3) + 1][0]), acc_f32(acc[gi >> 2][0][(gi & 3) + 1][1]), acc_f32(acc[gi >> 2][1][(gi & 3) + 1][0]), acc_f32(acc[gi >> 2][1][(gi & 3) + 1][1]));
                    __builtin_amdgcn_sched_barrier(0);
                }
            } else
#pragma unroll
            for (int gi = 0; gi < 8; ++gi) {
                if constexpr (Epi::DIST > 0) { if (gi + Epi::DIST < 8) { const int gn = gi + Epi::DIST; E.prefetch(pre[gn % 3], mpm, pn_, 128 * (gn >> 2) + 16 * (gn & 3) + rbase, c8); } }
                E.finish(ea, ctx, pre[gi % 3], gi, mpm, pn_, 128 * (gi >> 2) + 16 * (gi & 3) + rbase, c8, acc_f32(acc[gi >> 2][0][gi & 3][0]), acc_f32(acc[gi >> 2][0][gi & 3][1]), acc_f32(acc[gi >> 2][1][gi & 3][0]), acc_f32(acc[gi >> 2][1][gi & 3][1]));
                __builtin_amdgcn_sched_barrier(0);
            }
        }
        if (!has_next) break;
        if constexpr (GATHER) {
            _Pragma("unroll") for (int h_ = 0; h_ < 2; ++h_) _Pragma("unroll") for (int i_ = 0; i_ < 2; ++i_) cv[h_][i_] = nv[h_][i_];
            Unit nn; if (S.next(ui + 2, nn)) { PG8_ROWOFF(nv, nn); }
            asm volatile("" : "+v"(nv[0][0]), "+v"(nv[0][1]), "+v"(nv[1][0]), "+v"(nv[1][1]));
        }
#pragma unroll
        for (int a = 0; a < 2; ++a)
#pragma unroll
            for (int b = 0; b < 2; ++b)
#pragma unroll
                for (int m = 0; m < 4; ++m)
#pragma unroll
                    for (int n = 0; n < 2; ++n) acc[a][b][m][n] = (acc_t){0, 0, 0, 0};
        cur = nxt; cA = nA; cB = nB; cA2 = nA2; ++ui;
        E.early(ea, g.mem_pm(cur.pm), 64 * wr + fr);
        if constexpr (ALIGN_EPI) { if (wr == 1) PG8_BAR; }
    }
    PG8_WAIT_V(0);
    if constexpr (!ALIGN_EPI) { if (wr == 0) PG8_BAR; }
    PG8_BAR;
#undef PG8_SA
#undef PG8_SB
#undef PG8_STAGE
#undef PG8_STAGE_A
#undef PG8_ROWOFF
#undef PG8_LDA
#undef PG8_LDB
#undef PG8_MMA
#undef PG8_CAT
#undef PG8_WAIT_V
#undef PG8_WAIT_L
#undef PG8_BAR
#undef PG8_SCHED
}

template <int ID, class Epi>
__device__ __forceinline__ void gemm_phase(LAS unsigned char* lds, const GemmDesc& g, int G, int cidx, const Epi& E) { gemm_pg8<Epi, true, true, ID == 5, ID == 6 ? 1 : ((ID == 1 || ID == 5 || ID == 7) ? 2 : 0)>(lds, g, G, cidx, E); }

struct Args { const float* in[24]; float* out; unsigned char* ws; };
enum { I_X = 0, I_P, I_N1G, I_WIN, I_BGATE, I_CONVW, I_CONVB, I_LNG, I_LNB, I_WCO, I_WPOOL, I_PSCALE, I_WOUT, I_N2G, I_WR, I_WEG, I_WEU, I_WED, I_N3G, I_WPG, I_BPG, I_WPLE, I_PNG, I_FG };

struct TrItem { const float* W; bf16_t* WT; const float* kscale; int K, N, k0, n0, drow0, ldt, kofs, f8; };
__device__ __forceinline__ void tr_load(const TrItem& t, f32x4 (&v)[16], float (&ks)[16], int lane) {
    const int cq = 4 * (lane & 15), rq = lane >> 4;
#pragma unroll
    for (int i = 0; i < 16; ++i) v[i] = __builtin_nontemporal_load((const f32x4*)(t.W + (size_t)(t.k0 + 4 * i + rq) * t.N + t.n0 + cq));
    const float* kp = t.kscale ? t.kscale : t.W;
#pragma unroll
    for (int i = 0; i < 16; ++i) ks[i] = kp[t.k0 + 4 * i + rq];
}
__device__ __forceinline__ void tr_store(const TrItem& t, const f32x4 (&v)[16], const float (&ks)[16], LAS float* scr, int lane) {
    const int cq = 4 * (lane & 15), rq = lane >> 4; const bool sc = t.kscale != nullptr; const float mul = t.f8 == 1 ? W8_SCALE : (t.f8 == 2 ? WQ_SCALE : 1.0f);
#pragma unroll
    for (int i = 0; i < 16; ++i) { const float f = (sc ? ks[i] : 1.0f) * mul; LAS float* p = scr + (4 * i + rq) * 65 + cq; p[0] = v[i].x * f; p[1] = v[i].y * f; p[2] = v[i].z * f; p[3] = v[i].w * f; }
    LDS_WAIT();
    if (t.f8) {
        const int c4 = lane & 3; unsigned char* W8 = (unsigned char*)t.WT;
#pragma unroll
        for (int j = 0; j < 4; ++j) { const int n = (lane >> 2) + 16 * j; const LAS float* sp = scr + (16 * c4) * 65 + n; u32x4 o;
            if (t.f8 == 1) { o.x = pk_fp8x4(sp[0 * 65], sp[1 * 65], sp[2 * 65], sp[3 * 65]); o.y = pk_fp8x4(sp[4 * 65], sp[5 * 65], sp[6 * 65], sp[7 * 65]);
                o.z = pk_fp8x4(sp[8 * 65], sp[9 * 65], sp[10 * 65], sp[11 * 65]); o.w = pk_fp8x4(sp[12 * 65], sp[13 * 65], sp[14 * 65], sp[15 * 65]); }
            else { o.x = q8x4(clamp127(sp[0 * 65]), clamp127(sp[1 * 65]), clamp127(sp[2 * 65]), clamp127(sp[3 * 65])); o.y = q8x4(clamp127(sp[4 * 65]), clamp127(sp[5 * 65]), clamp127(sp[6 * 65]), clamp127(sp[7 * 65]));
                o.z = q8x4(clamp127(sp[8 * 65]), clamp127(sp[9 * 65]), clamp127(sp[10 * 65]), clamp127(sp[11 * 65])); o.w = q8x4(clamp127(sp[12 * 65]), clamp127(sp[13 * 65]), clamp127(sp[14 * 65]), clamp127(sp[15 * 65])); }
            __builtin_nontemporal_store(o, (u32x4*)(W8 + (size_t)(t.drow0 + n) * t.ldt + t.kofs + t.k0 + 16 * c4)); }
        LDS_WAIT(); return;
    }
    const int c = lane & 7;
#pragma unroll
    for (int j = 0; j < 8; ++j) { const int n = (lane >> 3) + 8 * j; const LAS float* sp = scr + (8 * c) * 65 + n;
        u32x4 o; o.x = pk2(sp[0 * 65], sp[1 * 65]); o.y = pk2(sp[2 * 65], sp[3 * 65]); o.z = pk2(sp[4 * 65], sp[5 * 65]); o.w = pk2(sp[6 * 65], sp[7 * 65]);
        __builtin_nontemporal_store(o, (u32x4*)(t.WT + (size_t)(t.drow0 + n) * t.ldt + t.kofs + t.k0 + 8 * c)); }
    LDS_WAIT();
}
constexpr int IT_WIN = (DM / 64) * (INC / 64);
constexpr int IT_WC = (CD / 64) * (DM / 64);
constexpr int IT_WP = 4 * (128 / 64) * (256 / 64);
constexpr int IT_SQ = (DM / 64) * (DM / 64);
constexpr int IT_WPLE = (PLE / 64) * (DM / 64);
constexpr int IT_EXP = NE * IT_SQ;
constexpr int IT_TOTAL = IT_WIN + IT_WC + IT_WP + IT_SQ + IT_SQ + IT_WPLE + 3 * IT_EXP;
constexpr int IT_SMALL = IT_TOTAL - 3 * IT_EXP;
constexpr int IT_P1 = 4608;
__device__ __forceinline__ TrItem tr_decode(const Args& a, int it) {
    unsigned char* ws = a.ws; TrItem t; t.kscale = nullptr; t.f8 = 0;
    int r = it;
    if (r < IT_WIN) {
        const int nblk = INC / 64, kb = r / nblk, nb = r % nblk, n0 = 64 * nb; int d0;
        if (n0 < 512) d0 = 256 * (n0 >> 7) + (n0 & 127); else if (n0 < 1024) d0 = 256 * ((n0 - 512) >> 7) + 128 + (n0 & 127); else d0 = n0;
        t.W = a.in[I_WIN]; t.WT = (bf16_t*)(ws + WS_WIN); t.K = DM; t.N = INC; t.k0 = 64 * kb; t.n0 = n0; t.drow0 = d0; t.kscale = a.in[I_N1G]; t.ldt = t.K; t.kofs = 0; t.f8 = 2; return t; }
    r -= IT_WIN;
    if (r < IT_WC) { const int kb = r / 16, nb = r % 16; t.W = a.in[I_WCO]; t.WT = (bf16_t*)(ws + WS_WCAT); t.K = CD; t.N = DM; t.k0 = 64 * kb; t.n0 = 64 * nb; t.drow0 = 64 * nb; t.ldt = 640; t.kofs = 128; return t; }
    r -= IT_WC;
    if (r < IT_WP) { const int gi = r / 8, q = r % 8, kb = q / 4, nb = q % 4;
        t.W = a.in[I_WPOOL] + (size_t)gi * 128 * 256; t.WT = (bf16_t*)(ws + WS_WCAT); t.K = 128; t.N = 256; t.k0 = 64 * kb; t.n0 = 64 * nb; t.drow0 = 256 * gi + 64 * nb; t.ldt = 640; t.kofs = 0; return t; }
    r -= IT_WP;
    if (r < IT_SQ) { const int kb = r / 16, nb = r % 16; t.W = a.in[I_WOUT]; t.WT = (bf16_t*)(ws + WS_WOUT); t.K = DM; t.N = DM; t.k0 = 64 * kb; t.n0 = 64 * nb; t.drow0 = 64 * nb; t.ldt = t.K; t.kofs = 0; return t; }
    r -= IT_SQ;
    if (r < IT_SQ) { const int kb = r / 16, nb = r % 16; t.W = a.in[I_WPG]; t.WT = (bf16_t*)(ws + WS_WPG); t.K = DM; t.N = DM; t.k0 = 64 * kb; t.n0 = 64 * nb; t.drow0 = 64 * nb; t.kscale = a.in[I_N3G]; t.ldt = t.K; t.kofs = 0; t.f8 = 2; return t; }
    r -= IT_SQ;
    if (r < IT_WPLE) { const int kb = r / 16, nb = r % 16; t.W = a.in[I_WPLE]; t.WT = (bf16_t*)(ws + WS_WPLE); t.K = PLE; t.N = DM; t.k0 = 64 * kb; t.n0 = 64 * nb; t.drow0 = 64 * nb; t.ldt = t.K; t.kofs = 0; return t; }
    r -= IT_WPLE;
    if (r < IT_EXP) { const int e = r / IT_SQ, q = r % IT_SQ, kb = q / 16, nb = q % 16, n0 = 64 * nb;
        t.W = a.in[I_WEG] + (size_t)e * DM * FF; t.WT = (bf16_t*)(ws + WS_WGU + (size_t)e * 2048 * DM); t.K = DM; t.N = FF; t.k0 = 64 * kb; t.n0 = n0; t.drow0 = 256 * (n0 >> 7) + (n0 & 127); t.kscale = a.in[I_N2G]; t.ldt = t.K; t.kofs = 0; t.f8 = 2; return t; }
    r -= IT_EXP;
    if (r < IT_EXP) { const int e = r / IT_SQ, q = r % IT_SQ, kb = q / 16, nb = q % 16, n0 = 64 * nb;
        t.W = a.in[I_WEU] + (size_t)e * DM * FF; t.WT = (bf16_t*)(ws + WS_WGU + (size_t)e * 2048 * DM); t.K = DM; t.N = FF; t.k0 = 64 * kb; t.n0 = n0; t.drow0 = 256 * (n0 >> 7) + 128 + (n0 & 127); t.kscale = a.in[I_N2G]; t.ldt = t.K; t.kofs = 0; t.f8 = 2; return t; }
    r -= IT_EXP;
    { const int e = r / IT_SQ, q = r % IT_SQ, kb = q / 16, nb = q % 16;
        t.W = a.in[I_WED] + (size_t)e * FF * DM; t.WT = (bf16_t*)(ws + WS_WD + (size_t)e * DM * FF); t.K = FF; t.N = DM; t.k0 = 64 * kb; t.n0 = 64 * nb; t.drow0 = 64 * nb; t.ldt = t.K; t.kofs = 0; t.f8 = 1; return t; }
}
__device__ __forceinline__ void phase0(const Args& a, LAS unsigned char* lds, int gw, int NGW, int wave, int lane, int lo1, int n1, int lo2, int n2, bool do_rows) {
    unsigned char* ws = a.ws;
    LAS float* scr = (LAS float*)(lds + wave * 16640);
    {
        f32x4 v[16], vn[16]; float ks[16], ksn[16]; TrItem cur, nxt;
        const int nj = n1 + n2;
#define P0_JOB(j) ((j) < n1 ? lo1 + (j) : lo2 + ((j) - n1))
        int j = gw;
        if (j < nj) { cur = tr_decode(a, P0_JOB(j)); tr_load(cur, v, ks, lane); }
        for (; j < nj; j += NGW) {
            const bool has_next = j + NGW < nj;
            if (has_next) { nxt = tr_decode(a, P0_JOB(j + NGW)); tr_load(nxt, vn, ksn, lane); }
            tr_store(cur, v, ks, scr, lane);
            if (has_next) { cur = nxt;
#pragma unroll
                for (int i = 0; i < 16; ++i) { v[i] = vn[i]; ks[i] = ksn[i]; } }
        }
#undef P0_JOB
    }
    if (!do_rows) return;
    const float* x = a.in[I_X]; bf16_t* XN = (bf16_t*)(ws + WS_XN); float* RS0 = (float*)(ws + WS_RSTD0); unsigned char* XQ = ws + WS_XQ;
    f32x4 nx[4];
#define P0_ISSUE(mrow) do { _Pragma("unroll") for (int j = 0; j < 2; ++j) { nx[2 * j] = __builtin_nontemporal_load((const f32x4*)(x + (size_t)(mrow) * DM + 512 * j + 8 * lane)); nx[2 * j + 1] = __builtin_nontemporal_load((const f32x4*)(x + (size_t)(mrow) * DM + 512 * j + 8 * lane + 4)); } } while (0)
    if (gw < NT) P0_ISSUE(gw);
    for (int m = gw; m < NT; m += NGW) {
        f32x4 v[4]; float s = 0.f, mx = 0.f;
#pragma unroll
        for (int j = 0; j < 4; ++j) { v[j] = nx[j]; s += (v[j].x * v[j].x + v[j].y * v[j].y) + (v[j].z * v[j].z + v[j].w * v[j].w);
            mx = fmaxf(fmaxf(mx, fmaxf(fabsf(v[j].x), fabsf(v[j].y))), fmaxf(fabsf(v[j].z), fabsf(v[j].w))); }
        if (m + NGW < NT) P0_ISSUE(m + NGW);
        const float rstd = rsqrtf(wave_sum(s) * (1.0f / DM) + EPS);
#pragma unroll
        for (int o = 1; o < 64; o <<= 1) mx = fmaxf(mx, __shfl_xor(mx, o));
        mx = fmaxf(mx, 1e-30f); const float qs = 127.0f * __builtin_amdgcn_rcpf(mx);
        if (lane == 0) RS0[m] = rstd * (mx * (1.0f / 127.0f)) * WQ_INV;
#pragma unroll
        for (int j = 0; j < 2; ++j) { { u32x4 w_; w_.x = pk2(v[2 * j].x, v[2 * j].y); w_.y = pk2(v[2 * j].z, v[2 * j].w); w_.z = pk2(v[2 * j + 1].x, v[2 * j + 1].y); w_.w = pk2(v[2 * j + 1].z, v[2 * j + 1].w); __builtin_nontemporal_store(w_, (u32x4*)(XN + (size_t)m * DM + 512 * j + 8 * lane)); }
            u32x2 q; q.x = q8x4s(v[2 * j], qs); q.y = q8x4s(v[2 * j + 1], qs);
            *(u32x2*)(XQ + (size_t)m * DM + 512 * j + 8 * lane) = q; }
    }
#undef P0_ISSUE
}

template <int HALF>
__device__ __forceinline__ void pool_unit(const LAS unsigned* Us, bf16_t* PDo, int th, int cp, int t0, int s0) {
    constexpr int NR = 7 + 2 * HALF;
    float r0[NR], r1[NR];
#pragma unroll
    for (int i = 0; i < NR; ++i) { const unsigned pu = Us[(8 * th + 8 - HALF + i) * 256 + cp]; r0[i] = bf_lo(pu); r1[i] = bf_hi(pu); }
    float p0 = 0.f, p1 = 0.f;
#pragma unroll
    for (int i = 0; i < 2 * HALF; ++i) { p0 += r0[i]; p1 += r1[i]; }
#pragma unroll
    for (int j = 0; j < 8; ++j) {
        const int s = s0 + 8 * th + j;
        const int lo = (s - HALF) > 0 ? (s - HALF) : 0, hi = (s + HALF - 1) < (SEQ - 1) ? (s + HALF - 1) : (SEQ - 1);
        const float inv = __builtin_amdgcn_rcpf((float)(hi - lo + 1));
        *(unsigned*)(PDo + ((size_t)(t0 + 8 * th + j)) * PDIM + 2 * cp) = pk2(p0 * inv - r0[j + HALF], p1 * inv - r1[j + HALF]);
        if (j < 7) { p0 += r0[j + 2 * HALF] - r0[j]; p1 += r1[j + 2 * HALF] - r1[j]; }
    }
}
__device__ __forceinline__ float wave_reduce16(const float (&v)[16], int lane) {
    float t8[8], t4[4], t2[2], t1;
    const bool b5 = (lane & 32) != 0, b4 = (lane & 16) != 0, b3 = (lane & 8) != 0, b2 = (lane & 4) != 0;
#pragma unroll
    for (int i = 0; i < 8; ++i) { const float send = b5 ? v[i] : v[i + 8], keep = b5 ? v[i + 8] : v[i]; t8[i] = keep + __shfl_xor(send, 32); }
#pragma unroll
    for (int i = 0; i < 4; ++i) { const float send = b4 ? t8[i] : t8[i + 4], keep = b4 ? t8[i + 4] : t8[i]; t4[i] = keep + __shfl_xor(send, 16); }
#pragma unroll
    for (int i = 0; i < 2; ++i) { const float send = b3 ? t4[i] : t4[i + 2], keep = b3 ? t4[i + 2] : t4[i]; t2[i] = keep + __shfl_xor(send, 8); }
    { const float send = b2 ? t2[0] : t2[1], keep = b2 ? t2[1] : t2[0]; t1 = keep + __shfl_xor(send, 4); }
    t1 += __shfl_xor(t1, 2); t1 += __shfl_xor(t1, 1);
    return t1;
}
__device__ __forceinline__ void phase2(const Args& a, LAS unsigned char* lds, int G, int cidx) {
    unsigned char* ws = a.ws;
    const bf16_t* V = (const bf16_t*)(ws + WS_V); const bf16_t* U = (const bf16_t*)(ws + WS_U);
    bf16_t* CS = (bf16_t*)(ws + WS_CS); bf16_t* PDo = (bf16_t*)(ws + WS_PD);
    LAS unsigned* Vs = (LAS unsigned*)lds;
    LAS unsigned* Us = Vs + 46 * 256;
    LAS float* red = (LAS float*)(Us + 31 * 256);
    int tid_ = threadIdx.x; asm volatile("" : "+v"(tid_));
    const int tid = tid_, cp = tid & 255, th = tid >> 8, wave = tid >> 6, lane = tid & 63;
    float w0[CWID], w1[CWID];
#pragma unroll
    for (int k = 0; k < CWID; ++k) { typedef float f32x2_ __attribute__((ext_vector_type(2))); const f32x2_ wv = *(const f32x2_*)(a.in[I_CONVW] + k * CD + 2 * cp); w0[k] = wv.x; w1[k] = wv.y; }
    const float cb0 = a.in[I_CONVB][2 * cp], cb1 = a.in[I_CONVB][2 * cp + 1];
    const float lg0 = a.in[I_LNG][2 * cp], lg1 = a.in[I_LNG][2 * cp + 1], lb0 = a.in[I_LNB][2 * cp], lb1 = a.in[I_LNB][2 * cp + 1];
    float cb0_ = cb0, cb1_ = cb1, lg0_ = lg0, lg1_ = lg1, lb0_ = lb0, lb1_ = lb1;
#pragma unroll
    for (int k = 0; k < CWID; ++k) asm volatile("" : "+v"(w0[k]), "+v"(w1[k]));
    asm volatile("" : "+v"(cb0_), "+v"(cb1_), "+v"(lg0_), "+v"(lg1_), "+v"(lb0_), "+v"(lb1_));
    const int grp = cp >> 6;
    const int NU = NT / 16, per = (NU + G - 1) / G;
    const int u_begin = cidx * per, u_end = (u_begin + per) < NU ? (u_begin + per) : NU;
    u32x4 pre[10];
#define P2_FETCH(unit) do { const int t0_ = (unit) * 16, b_ = t0_ / SEQ, s0_ = t0_ % SEQ; \
    _Pragma("unroll") for (int i = 0; i < 6; ++i) { const int q = tid + NTHREADS * i, r = (q >> 6) < 45 ? (q >> 6) : 45, ch = q & 63, sq = s0_ - 15 + r; \
        const int sc = sq < 0 ? 0 : (sq > SEQ - 1 ? SEQ - 1 : sq);     \
        pre[i] = *(const u32x4*)(V + ((size_t)(b_ * SEQ + sc)) * CD + ch * 8); } \
    _Pragma("unroll") for (int i = 0; i < 4; ++i) { const int q = tid + NTHREADS * i, r = (q >> 6) < 30 ? (q >> 6) : 30, ch = q & 63, sq = s0_ - 8 + r; \
        const int sc = sq < 0 ? 0 : (sq > SEQ - 1 ? SEQ - 1 : sq); \
        pre[6 + i] = *(const u32x4*)(U + ((size_t)(b_ * SEQ + sc)) * PDIM + ch * 8); } } while (0)
    if (u_begin < u_end) P2_FETCH(u_begin);
    for (int unit = u_begin; unit < u_end; ++unit) {
        const int t0 = unit * 16, s0 = t0 % SEQ;
        __syncthreads();
#pragma unroll
        for (int i = 0; i < 6; ++i) { const int q = tid + NTHREADS * i, sq = s0 - 15 + (q >> 6); const unsigned msk = (sq >= 0 && sq < SEQ) ? 0xffffffffu : 0u;
            if (q < 46 * 64) *(LAS u32x4*)(Vs + (q >> 6) * 256 + (q & 63) * 4) = (u32x4){pre[i].x & msk, pre[i].y & msk, pre[i].z & msk, pre[i].w & msk}; }
#pragma unroll
        for (int i = 0; i < 4; ++i) { const int q = tid + NTHREADS * i, sq = s0 - 8 + (q >> 6); const unsigned msk = (sq >= 0 && sq < SEQ) ? 0xffffffffu : 0u;
            if (q < 31 * 64) *(LAS u32x4*)(Us + (q >> 6) * 256 + (q & 63) * 4) = (u32x4){pre[6 + i].x & msk, pre[6 + i].y & msk, pre[6 + i].z & msk, pre[6 + i].w & msk}; }
        __syncthreads();
        if (unit + 1 < u_end) P2_FETCH(unit + 1);
        float a0[8], a1[8];
        {
            typedef float f32x2_ __attribute__((ext_vector_type(2)));
            f32x2_ ac[8];
#pragma unroll
            for (int j = 0; j < 8; ++j) ac[j] = (f32x2_){cb0_, cb1_};
            unsigned rowv[38];
#pragma unroll
            for (int r = 0; r < 38; ++r) rowv[r] = Vs[(8 * th + r) * 256 + cp];
            __builtin_amdgcn_sched_barrier(0);
#pragma unroll
            for (int r = 0; r < 38; ++r) {
                const f32x2_ xv = (f32x2_){bf_lo(rowv[r]), bf_hi(rowv[r])};
#pragma unroll
                for (int j = 0; j < 8; ++j) { const int k = r - j; if (k >= 0 && k < CWID) ac[j] = __builtin_elementwise_fma(xv, (f32x2_){w0[k], w1[k]}, ac[j]); }
            }
#pragma unroll
            for (int j = 0; j < 8; ++j) { a0[j] = ac[j].x; a1[j] = ac[j].y; }
        }
        float sv[16];
#pragma unroll
        for (int j = 0; j < 8; ++j) { sv[j] = a0[j] + a1[j]; sv[8 + j] = a0[j] * a0[j] + a1[j] * a1[j]; }
        const float tot = wave_reduce16(sv, lane);
        if ((lane & 3) == 0) red[wave * 16 + (lane >> 2)] = tot;
        __syncthreads();
#pragma unroll
        for (int j = 0; j < 8; ++j) {
            float t1 = 0.f, t2 = 0.f;
#pragma unroll
            for (int w = 0; w < 4; ++w) { t1 += red[(4 * th + w) * 16 + j]; t2 += red[(4 * th + w) * 16 + 8 + j]; }
            const float mean = t1 * (1.0f / CD); float var = t2 * (1.0f / CD) - mean * mean; var = var > 0.f ? var : 0.f;
            const float rstd = rsqrtf(var + EPS);
            const float y0 = (a0[j] - mean) * rstd * lg0_ + lb0_, y1 = (a1[j] - mean) * rstd * lg1_ + lb1_;
            *(unsigned*)(CS + ((size_t)(t0 + 8 * th + j)) * CD + 2 * cp) = pk2(y0 * sigm(y0), y1 * sigm(y1));
        }
        switch (grp) {
            case 0: pool_unit<1>(Us, PDo, th, cp, t0, s0); break;
            case 1: pool_unit<2>(Us, PDo, th, cp, t0, s0); break;
            case 2: pool_unit<4>(Us, PDo, th, cp, t0, s0); break;
            default: pool_unit<8>(Us, PDo, th, cp, t0, s0); break;
        }
    }
#undef P2_FETCH
    __syncthreads();
}

__device__ __forceinline__ void phase6(const Args& a, LAS unsigned char* lds, int gw, int NGW, int lane) {
    unsigned char* ws = a.ws;
    constexpr int WST = DM + 8;
    LAS bf16_t* WH = (LAS bf16_t*)lds; LAS bf16_t* WL = WH + NE * WST;
    { int t_ = threadIdx.x; asm volatile("" : "+v"(t_));
      for (int q = t_; q < DM * NE; q += NTHREADS) { const int d = q >> 4, e = q & 15; const float w = a.in[I_WR][q] * a.in[I_N2G][d];
          const unsigned hi = f2bf(w); const float rem = w - __uint_as_float(hi << 16); WH[e * WST + d] = (bf16_t)hi; WL[e * WST + d] = (bf16_t)f2bf(rem); } }
    __syncthreads();
    const bf16_t* X1 = (const bf16_t*)(ws + WS_X1B); float* RS1 = (float*)(ws + WS_RSTD1); float* AFF = (float*)(ws + WS_AFF); unsigned char* X1Q = ws + WS_X1Q;
    const int fr = lane & 15, fq = lane >> 4;
    for (int grp = gw; grp < NT / 16; grp += NGW) {
        const int row0 = grp * 16;
        const bf16_t* xp = X1 + (size_t)(row0 + fr) * DM + 8 * fq;
        bf16x8 af[32];
#pragma unroll
        for (int sidx = 0; sidx < 32; ++sidx) af[sidx] = *(const bf16x8*)(xp + 32 * sidx);
        f32x4 acc = (f32x4){0.f, 0.f, 0.f, 0.f}; float ss = 0.f, mx = 0.f;
#pragma unroll
        for (int sidx = 0; sidx < 32; ++sidx) {
            if ((sidx & 3) == 0) asm volatile("" ::: "memory");
            const bf16x8 bh = *(const LAS bf16x8*)(WH + fr * WST + 32 * sidx + 8 * fq), bl = *(const LAS bf16x8*)(WL + fr * WST + 32 * sidx + 8 * fq);
            acc = __builtin_amdgcn_mfma_f32_16x16x32_bf16(af[sidx], bh, acc, 0, 0, 0);
            acc = __builtin_amdgcn_mfma_f32_16x16x32_bf16(af[sidx], bl, acc, 0, 0, 0);
#pragma unroll
            for (int j = 0; j < 8; ++j) { const float xv = __uint_as_float(((unsigned)(unsigned short)af[sidx][j]) << 16); ss += xv * xv; mx = fmaxf(mx, fabsf(xv)); }
        }
        ss += __shfl_xor(ss, 16); ss += __shfl_xor(ss, 32);
        const float rstd = rsqrtf(ss * (1.0f / DM) + EPS);
        mx = fmaxf(mx, __shfl_xor(mx, 16)); mx = fmaxf(mx, __shfl_xor(mx, 32)); mx = fmaxf(mx, 1e-30f);
        if (fq == 0) RS1[row0 + fr] = rstd * (mx * (1.0f / 127.0f)) * WQ_INV;
        { const float qs = 127.0f * __builtin_amdgcn_rcpf(mx); unsigned char* qp = X1Q + (size_t)(row0 + fr) * DM + 8 * fq;
#pragma unroll
          for (int sidx = 0; sidx < 32; ++sidx) { asm volatile("" : "+v"(af[sidx]));
              const u32x4 w = __builtin_bit_cast(u32x4, af[sidx]);
              u32x2 q; q.x = q8x4s((f32x4){bf_lo(w.x), bf_hi(w.x), bf_lo(w.y), bf_hi(w.y)}, qs); q.y = q8x4s((f32x4){bf_lo(w.z), bf_hi(w.z), bf_lo(w.w), bf_hi(w.w)}, qs); *(u32x2*)(qp + 32 * sidx) = q; } }
        f32x4 av;
#pragma unroll
        for (int r = 0; r < 4; ++r) {
            const float lg = acc[r] * __shfl(rstd, 4 * fq + r);
            float mx = lg;
#pragma unroll
            for (int o2 = 1; o2 < 16; o2 <<= 1) mx = fmaxf(mx, __shfl_xor(mx, o2));
            const float pe = __expf(lg - mx); float den = pe;
#pragma unroll
            for (int o2 = 1; o2 < 16; o2 <<= 1) den += __shfl_xor(den, o2);
            av[r] = pe / den;
        }
        *(f32x4*)(AFF + ((size_t)((row0 / SEQ) * NE + fr)) * SEQ + (row0 % SEQ) + 4 * fq) = av;
    }
    __syncthreads();
}

__device__ __forceinline__ void phase7(const Args& a, LAS unsigned char* lds, int G, int cidx) {
    unsigned char* ws = a.ws;
    const float* AFF = (const float*)(ws + WS_AFF); int* IDX = (int*)(ws + WS_IDX); float* VAL = (float*)(ws + WS_VAL); int* INV = (int*)(ws + WS_INV);
    const float* RS1 = (const float*)(ws + WS_RSTD1); float* RSV = (float*)(ws + WS_RSV);
    LAS int* cnt = (LAS int*)lds;
    LAS int* wtot = cnt + 48;
    int tid_ = threadIdx.x; asm volatile("" : "+v"(tid_));
    const int tid = tid_, wave = tid >> 6, lane = tid & 63;
    for (int be = cidx; be < NB * NE; be += G) {
        const int b = be >> 4, e = be & 15;
        __syncthreads();
        unsigned v[4];
        { const f32x4 t4 = *(const f32x4*)(AFF + (size_t)be * SEQ + 4 * tid); v[0] = __float_as_uint(t4.x); v[1] = __float_as_uint(t4.y); v[2] = __float_as_uint(t4.z); v[3] = __float_as_uint(t4.w); }
        unsigned T = 0u;
        {
            const unsigned cand = 1u << 30; int c = 0;
#pragma unroll
            for (int j = 0; j < 4; ++j) c += (int)__popcll(__ballot(v[j] >= cand));
            if (lane == 0) cnt[wave * 3] = c;
            __syncthreads();
            int tot = 0;
#pragma unroll
            for (int w = 0; w < 8; ++w) tot += cnt[w * 3];
            if (tot >= CAP) T = cand;
        }
        for (int step = 0; step < 15; ++step) {
            const int hi = 29 - 2 * step, lo = hi - 1;
            const unsigned c1 = T | (1u << lo), c2 = T | (1u << hi), c3 = c2 | (1u << lo);
            int n1 = 0, n2 = 0, n3 = 0;
#pragma unroll
            for (int j = 0; j < 4; ++j) { n1 += (int)__popcll(__ballot(v[j] >= c1)); n2 += (int)__popcll(__ballot(v[j] >= c2)); n3 += (int)__popcll(__ballot(v[j] >= c3)); }
            LAS int* slot = cnt + 24 * ((step + 1) & 1);
            if (lane == 0) { slot[wave * 3] = n1; slot[wave * 3 + 1] = n2; slot[wave * 3 + 2] = n3; }
            __syncthreads();
            int t1 = 0, t2 = 0, t3 = 0;
#pragma unroll
            for (int w = 0; w < 8; ++w) { t1 += slot[w * 3]; t2 += slot[w * 3 + 1]; t3 += slot[w * 3 + 2]; }
            T = (t3 >= CAP) ? c3 : (t2 >= CAP) ? c2 : (t1 >= CAP) ? c1 : T;
        }
        int mygt = 0, myeq = 0;
#pragma unroll
        for (int j = 0; j < 4; ++j) { mygt += (v[j] > T) ? 1 : 0; myeq += (v[j] == T) ? 1 : 0; }
        const int pk = mygt | (myeq << 16); int inc = pk;
#pragma unroll
        for (int o = 1; o < 64; o <<= 1) { const int t = __shfl_up(inc, o); if (lane >= o) inc += t; }
        __syncthreads();
        if (lane == 63) wtot[wave] = inc;
        __syncthreads();
        int base = 0, total = 0;
#pragma unroll
        for (int w = 0; w < 8; ++w) { const int t = wtot[w]; if (w < wave) base += t; total += t; }
        const int excl = base + inc - pk; int pg = excl & 0xffff, pq = excl >> 16;
        const int ngt = total & 0xffff, need = CAP - ngt;
#pragma unroll
        for (int j = 0; j < 4; ++j) {
            const int tok = 4 * tid + j; int slot = -1;
            if (v[j] > T) { slot = pg + (pq < need ? pq : need); ++pg; }
            else if (v[j] == T) { if (pq < need) slot = pg + pq; ++pq; }
            INV[((size_t)(b * SEQ + tok)) * NE + e] = slot;
            if (slot >= 0) { IDX[be * CAP + slot] = tok; VAL[be * CAP + slot] = __uint_as_float(v[j]) * W8_INV; RSV[be * CAP + slot] = RS1[b * SEQ + tok]; }
        }
    }
    __syncthreads();
}

__device__ __forceinline__ void r16_acc(f32x4 (&v)[4], const u32x4 (&w)[2]) {
#pragma unroll
    for (int j = 0; j < 2; ++j) {
        v[2 * j].x += bf_lo(w[j].x); v[2 * j].y += bf_hi(w[j].x); v[2 * j].z += bf_lo(w[j].y); v[2 * j].w += bf_hi(w[j].y);
        v[2 * j + 1].x += bf_lo(w[j].z); v[2 * j + 1].y += bf_hi(w[j].z); v[2 * j + 1].z += bf_lo(w[j].w); v[2 * j + 1].w += bf_hi(w[j].w);
    }
}
__device__ __forceinline__ void l16_acc_fp8(f32x4 (&v)[4], const u32x4 w) {
    typedef float f2_ __attribute__((ext_vector_type(2)));
    const unsigned wj[4] = {w.x, w.y, w.z, w.w};
#pragma unroll
    for (int j = 0; j < 4; ++j) { const f2_ lo = __builtin_amdgcn_cvt_pk_f32_fp8((int)wj[j], false), hi = __builtin_amdgcn_cvt_pk_f32_fp8((int)wj[j], true);
        v[j].x += lo.x; v[j].y += lo.y; v[j].z += hi.x; v[j].w += hi.y; }
}
__device__ __forceinline__ void phase10(const Args& a, int gw, int NGW, int lane, bf16_t* XO) {
    unsigned char* ws = a.ws;
    const int* INV = (const int*)(ws + WS_INV); const unsigned char* YE = (const unsigned char*)(ws + WS_YE); const bf16_t* X = (const bf16_t*)(ws + WS_X1B); float* RS = (float*)(ws + WS_RSTD2); unsigned char* X2Q = ws + WS_X2Q;
    u32x4 nx[2]; u32x4 ny[4]; int inv1 = -1, inv2 = -1; unsigned msk1 = 0u;
    const int col0 = 256 * (lane >> 4) + 128 * ((lane & 3) >> 1) + 32 * ((lane & 15) >> 2) + 16 * (lane & 1);
#define P10_ISSUE(mrow, invreg, mskout) do { const int b_ = (mrow) / SEQ; \
        mskout = (unsigned)__builtin_amdgcn_readfirstlane((int)(__ballot((invreg) >= 0) & 0xffffull)); \
        _Pragma("unroll") for (int j = 0; j < 2; ++j) nx[j] = *(const u32x4*)(X + (size_t)(mrow) * DM + col0 + 8 * j); \
        unsigned mm_ = mskout; \
        _Pragma("unroll") for (int k = 0; k < 4; ++k) { const bool act_ = mm_ != 0u; const int e_ = act_ ? __builtin_ctz(mm_) : 0; mm_ &= mm_ - 1u; const int sl_ = __builtin_amdgcn_readlane((invreg), e_); \
            const unsigned char* yr_ = (act_ ? YE + ((size_t)(b_ * NE + e_) * CAP + sl_) * DM : (const unsigned char*)(X + (size_t)(mrow) * DM)) + 16 * lane;     \
            ny[k] = *(const u32x4*)yr_; } } while (0)
    if (gw < NT) inv1 = INV[(size_t)gw * NE + (lane & 15)];
    if (gw + NGW < NT) inv2 = INV[(size_t)(gw + NGW) * NE + (lane & 15)];
    if (gw < NT) P10_ISSUE(gw, inv1, msk1);
    for (int m = gw; m < NT; m += NGW) {
        const int b = m / SEQ;
        f32x4 v[4]; u32x4 y[4]; const int inv0 = inv1; const unsigned msk0 = msk1;
        r16_unpack(v, nx);
#pragma unroll
        for (int k = 0; k < 4; ++k) y[k] = ny[k];
        inv1 = inv2;
        if (m + 2 * NGW < NT) inv2 = INV[(size_t)(m + 2 * NGW) * NE + (lane & 15)];
        if (m + NGW < NT) P10_ISSUE(m + NGW, inv1, msk1);
        unsigned mm = msk0;
#pragma unroll
        for (int k = 0; k < 4; ++k) { if (mm) { mm &= mm - 1u; l16_acc_fp8(v, y[k]); } }
        while (mm) {
            const int e = __builtin_ctz(mm); mm &= mm - 1u; const int sl = __builtin_amdgcn_readlane(inv0, e);
            const u32x4 w = *(const u32x4*)(YE + ((size_t)(b * NE + e) * CAP + sl) * DM + 16 * lane); l16_acc_fp8(v, w);
        }
        float s = 0.f, mx = 0.f;
#pragma unroll
        for (int j = 0; j < 4; ++j) { s += (v[j].x * v[j].x + v[j].y * v[j].y) + (v[j].z * v[j].z + v[j].w * v[j].w);
            mx = fmaxf(fmaxf(mx, fmaxf(fabsf(v[j].x), fabsf(v[j].y))), fmaxf(fabsf(v[j].z), fabsf(v[j].w))); }
        const float rstd = rsqrtf(wave_sum(s) * (1.0f / DM) + EPS);
#pragma unroll
        for (int o = 1; o < 64; o <<= 1) mx = fmaxf(mx, __shfl_xor(mx, o));
        mx = fmaxf(mx, 1e-30f); const float qs = 127.0f * __builtin_amdgcn_rcpf(mx);
        if (lane == 0) RS[m] = rstd * (mx * (1.0f / 127.0f)) * WQ_INV;
#pragma unroll
        for (int j = 0; j < 2; ++j) store_bf8(XO + (size_t)m * DM + col0 + 8 * j, v[2 * j], v[2 * j + 1]);
        u32x4 q;
        q.x = q8x4s(v[0], qs); q.y = q8x4s(v[1], qs); q.z = q8x4s(v[2], qs); q.w = q8x4s(v[3], qs);
        *(u32x4*)(X2Q + (size_t)m * DM + col0) = q;
    }
#undef P10_ISSUE
    const f32x4* P = (const f32x4*)a.in[I_P]; u32x2* PB = (u32x2*)(ws + WS_PBF);
    const size_t nq = (size_t)NT * PLE / 4, stride = (size_t)NGW * 64;
    for (size_t q0 = (size_t)gw * 64 + lane; q0 < nq; q0 += 8 * stride) {
        f32x4 t[8];
#pragma unroll
        for (int i = 0; i < 8; ++i) { const size_t q = q0 + i * stride; t[i] = P[q < nq ? q : q0]; }
#pragma unroll
        for (int i = 0; i < 8; ++i) { const size_t q = q0 + i * stride; if (q < nq) { u32x2 w; w.x = pk2(t[i].x, t[i].y); w.y = pk2(t[i].z, t[i].w); PB[q] = w; } }
    }
}

__device__ __forceinline__ void phase12(const Args& a, int gw, int NGW, int lane, float* XO) {
    unsigned char* ws = a.ws;
    const bf16_t* GL = (const bf16_t*)(ws + WS_GL); const bf16_t* ER = (const bf16_t*)(ws + WS_ERAW); const bf16_t* X = (const bf16_t*)(ws + WS_XN);
    f32x4 gp[4], gf[4];
#pragma unroll
    for (int j = 0; j < 2; ++j) { gp[2 * j] = *(const f32x4*)(a.in[I_PNG] + 512 * j + 8 * lane); gp[2 * j + 1] = *(const f32x4*)(a.in[I_PNG] + 512 * j + 8 * lane + 4);
        gf[2 * j] = *(const f32x4*)(a.in[I_FG] + 512 * j + 8 * lane); gf[2 * j + 1] = *(const f32x4*)(a.in[I_FG] + 512 * j + 8 * lane + 4); }
#pragma unroll
    for (int j = 0; j < 4; ++j) asm volatile("" : "+v"(gp[j]), "+v"(gf[j]));
    u32x4 nx[2]; u32x4 ne[2], ng[2];
#define P12_ISSUE(mrow) do { _Pragma("unroll") for (int j = 0; j < 2; ++j) { nx[j] = *(const u32x4*)(X + (size_t)(mrow) * DM + 512 * j + 8 * lane); \
        ne[j] = *(const u32x4*)(ER + (size_t)(mrow) * DM + 512 * j + 8 * lane); ng[j] = *(const u32x4*)(GL + (size_t)(mrow) * DM + 512 * j + 8 * lane); } } while (0)
    if (gw < NT) P12_ISSUE(gw);
    for (int m = gw; m < NT; m += NGW) {
        f32x4 v[4], ev[4], gv[4]; float se = 0.f;
        r16_unpack(v, nx); r16_unpack(ev, ne); r16_unpack(gv, ng);
        if (m + NGW < NT) P12_ISSUE(m + NGW);
#pragma unroll
        for (int j = 0; j < 4; ++j) se += (ev[j].x * ev[j].x + ev[j].y * ev[j].y) + (ev[j].z * ev[j].z + ev[j].w * ev[j].w);
        const float rse = rsqrtf(wave_sum(se) * (1.0f / DM) + EPS); float s = 0.f;
#pragma unroll
        for (int j = 0; j < 4; ++j) { v[j] = v[j] + gv[j] * (ev[j] * rse * gp[j]); s += (v[j].x * v[j].x + v[j].y * v[j].y) + (v[j].z * v[j].z + v[j].w * v[j].w); }
        const float rstd = rsqrtf(wave_sum(s) * (1.0f / DM) + EPS);
#pragma unroll
        for (int j = 0; j < 2; ++j) { *(f32x4*)(XO + (size_t)m * DM + 512 * j + 8 * lane) = v[2 * j] * rstd * gf[2 * j]; *(f32x4*)(XO + (size_t)m * DM + 512 * j + 8 * lane + 4) = v[2 * j + 1] * rstd * gf[2 * j + 1]; }
    }
#undef P12_ISSUE
}

constexpr int N_PHASES = 13;
template <int LO, int HI>
__global__ void __launch_bounds__(NTHREADS, 2) mk_fwd(Args a) {
    extern __shared__ __attribute__((aligned(16))) unsigned char lds_raw[];
    LAS unsigned char* lds = (LAS unsigned char*)lds_raw;
    const int tid = threadIdx.x, wave = __builtin_amdgcn_readfirstlane(tid >> 6);
    const int G = gridDim.x, bx = blockIdx.x;
    const int vcu = (G % 8 == 0) ? (bx % 8) * (G / 8) + bx / 8 : bx;
    const int gw = vcu * NWAVES + wave, NGW = G * NWAVES;
    unsigned char* ws = a.ws;
#ifndef MK_DUP_MASK
#define MK_DUP_MASK 0
#endif
#define REP(k) (((MK_DUP_MASK >> (k)) & 1) ? 2 : 1)
#define IN(k) (LO <= (k) && (k) < HI)
#define BOTH(k) (IN(k) && IN((k) + 1))
    XcdBarrier bar; bar.bar = (unsigned*)(ws + WS_CTL); bar.x = 0; bar.st = nullptr;
    if (HI - LO > 1) {
        if (tid < 16) ((LAS unsigned*)(lds + MISC_OFF))[tid] = 0u;
        __syncthreads();
        bar = xcd_barrier_post((unsigned*)(ws + WS_CTL), (volatile LAS unsigned*)(lds + MISC_OFF));
    }
#define GRID_BAR(k) do { if (BOTH(k)) { xcd_barrier(bar); if (MK_DUP_MASK & 0x10000) xcd_barrier(bar); } } while (0)
    if (IN(0)) for (int rep_ = 0; rep_ < REP(0); ++rep_) { int l_ = threadIdx.x; asm volatile("" : "+v"(l_)); l_ &= 63; const bool split = (G % 64 == 0); phase0(a, lds, gw, NGW, wave, l_, 0, IT_SMALL, IT_SMALL + (split ? IT_P1 : 0), 3 * IT_EXP - (split ? IT_P1 : 0), true); }
    GRID_BAR(0);
    if (IN(1)) for (int rep_ = 0; rep_ < REP(1); ++rep_) {
        const bool split = (G % 64 == 0);
        if (split && ((bx >> 3) & 7) == 7) {
            int l_ = threadIdx.x; asm volatile("" : "+v"(l_)); l_ &= 63;
            const int ci = (bx >> 6) * 8 + (bx & 7), nci = (G >> 6) * 8;
            phase0(a, lds, ci * NWAVES + wave, nci * NWAVES, wave, l_, IT_SMALL, IT_P1, 0, 0, false);
        } else {
            const int cg = split ? ((bx >> 6) * 56 + ((bx >> 3) & 7) * 8 + (bx & 7)) : bx, Gg = split ? (G >> 6) * 56 : G;
            GemmDesc g{(const bf16_t*)(ws + WS_XQ), (const bf16_t*)(ws + WS_WIN), DM / 2, DM / 2, NT / 256, INC / 256, 0, 0, 0, nullptr, nullptr};
            Epi1 E{(bf16_t*)(ws + WS_V), (bf16_t*)(ws + WS_U), (bf16_t*)(ws + WS_G), a.in[I_BGATE], (const float*)(ws + WS_RSTD0)};
            gemm_phase<1>(lds, g, Gg, cg, E);
        }
    }
    GRID_BAR(1);
    if (IN(2)) for (int rep_ = 0; rep_ < REP(2); ++rep_) phase2(a, lds, G, vcu);
    GRID_BAR(2);
    if (IN(4)) for (int rep_ = 0; rep_ < REP(4); ++rep_) {
        GemmDesc g{(const bf16_t*)(ws + WS_PD), (const bf16_t*)(ws + WS_WCAT), PDIM, 640, NT / 256, DM / 256, 128, 0, 0, nullptr, (const bf16_t*)(ws + WS_CS)};
        Epi23 E{(const bf16_t*)(ws + WS_G), a.in[I_PSCALE], (bf16_t*)(ws + WS_MERGED)};
        gemm_phase<3>(lds, g, G, bx, E);
    }
    GRID_BAR(4);
    if (IN(5)) for (int rep_ = 0; rep_ < REP(5); ++rep_) {
        GemmDesc g{(const bf16_t*)(ws + WS_MERGED), (const bf16_t*)(ws + WS_WOUT), DM, DM, NT / 256, DM / 256, 0, 0, 0, nullptr, nullptr};
        Epi4 E{(const bf16_t*)(ws + WS_XN), (bf16_t*)(ws + WS_X1B)};
        gemm_phase<4>(lds, g, G, bx, E);
    }
    GRID_BAR(5);
    if (IN(6)) for (int rep_ = 0; rep_ < REP(6); ++rep_) { int l_ = threadIdx.x; asm volatile("" : "+v"(l_)); l_ &= 63; phase6(a, lds, gw, NGW, l_); }
    GRID_BAR(6);
    if (IN(7)) for (int rep_ = 0; rep_ < REP(7); ++rep_) phase7(a, lds, G, vcu);
    GRID_BAR(7);
    if (IN(8)) for (int rep_ = 0; rep_ < REP(8); ++rep_) {
        GemmDesc g{(const bf16_t*)(ws + WS_X1Q), (const bf16_t*)(ws + WS_WGU), DM / 2, DM / 2, NB * NE, 2048 / 256, 0, 1, (size_t)2048 * DM / 2, (const int*)(ws + WS_IDX), nullptr};
        Epi5 E{ws + WS_HID, (const float*)(ws + WS_RSV)};
        gemm_phase<5>(lds, g, G, bx, E);
    }
    GRID_BAR(8);
    if (IN(9)) for (int rep_ = 0; rep_ < REP(9); ++rep_) {
        GemmDesc g{(const bf16_t*)(ws + WS_HID), (const bf16_t*)(ws + WS_WD), FF / 2, FF / 2, NB * NE, DM / 256, 0, 1, (size_t)DM * FF / 2, nullptr, nullptr};
        Epi6 E{(const float*)(ws + WS_VAL), (unsigned char*)(ws + WS_YE)};
        gemm_phase<6>(lds, g, G, bx, E);
    }
    GRID_BAR(9);
    if (IN(10)) for (int rep_ = 0; rep_ < REP(10); ++rep_) { int l_ = threadIdx.x; asm volatile("" : "+v"(l_)); l_ &= 63; phase10(a, gw, NGW, l_, (bf16_t*)(ws + WS_XN)); }
    GRID_BAR(10);
    if (IN(11)) for (int rep_ = 0; rep_ < REP(11); ++rep_) {
        { GemmDesc g{(const bf16_t*)(ws + WS_X2Q), (const bf16_t*)(ws + WS_WPG), DM / 2, DM / 2, NT / 256, DM / 256, 0, 0, 0, nullptr, nullptr};
          Epi7 E{a.in[I_BPG], (bf16_t*)(ws + WS_GL), (const float*)(ws + WS_RSTD2)};
          gemm_phase<7>(lds, g, G, bx, E); }
        { GemmDesc g{(const bf16_t*)(ws + WS_PBF), (const bf16_t*)(ws + WS_WPLE), PLE, PLE, NT / 256, DM / 256, 0, 0, 0, nullptr, nullptr};
          Epi8 E{(bf16_t*)(ws + WS_ERAW)};
          gemm_phase<8>(lds, g, G, bx, E); }
    }
    GRID_BAR(11);
    if (IN(12)) for (int rep_ = 0; rep_ < REP(12); ++rep_) { int l_ = threadIdx.x; asm volatile("" : "+v"(l_)); l_ &= 63; phase12(a, gw, NGW, l_, a.out); }
#undef IN
#undef BOTH
#undef GRID_BAR
}

#ifndef MK_ONE_LAUNCH
#define MK_ONE_LAUNCH 1
#endif
typedef void (*kern_t)(Args);
#if !MK_ONE_LAUNCH
template <int P> struct PhaseTab { static void fill(kern_t* t) { t[P] = mk_fwd<P, P + 1>; PhaseTab<P - 1>::fill(t); } };
template <> struct PhaseTab<-1> { static void fill(kern_t*) {} };
constexpr int N_KERNELS = N_PHASES;
#else
constexpr int N_KERNELS = 1;
#endif

extern "C" void kernel_launch(void* const* d_in, const int* in_sizes, int n_in, void* d_out, int out_size, void* d_ws, size_t ws_size, hipStream_t stream) {
    static int grid = 0; static kern_t tab[N_KERNELS];
    if (grid == 0) {
        if (n_in != 24 || in_sizes[0] != NT * DM || out_size != NT * DM || ws_size < WS_END) {
            fprintf(stderr, "kernel_launch: unexpected shapes: n_in %d in0 %d out %d ws %zu (need %zu)\n", n_in, n_in > 0 ? in_sizes[0] : -1, out_size, ws_size, (size_t)WS_END); grid = -1; return; }
        int dev = 0, cus = 0;
        if (hipGetDevice(&dev) != hipSuccess || hipDeviceGetAttribute(&cus, hipDeviceAttributeMultiprocessorCount, dev) != hipSuccess) { grid = -1; return; }
#if !MK_ONE_LAUNCH
        PhaseTab<N_PHASES - 1>::fill(tab);
#else
        tab[0] = mk_fwd<0, N_PHASES>;
#endif
        for (int p = 0; p < N_KERNELS; ++p) {
            int per_cu = 0;
            if (hipFuncSetAttribute((const void*)tab[p], hipFuncAttributeMaxDynamicSharedMemorySize, LDS_BYTES) != hipSuccess) { fprintf(stderr, "kernel_launch: hipFuncSetAttribute failed (kernel %d)\n", p); grid = -1; return; }
            if (hipOccupancyMaxActiveBlocksPerMultiprocessor(&per_cu, (const void*)tab[p], NTHREADS, LDS_BYTES) != hipSuccess || per_cu < 1) { fprintf(stderr, "kernel_launch: occupancy query says %d (kernel %d)\n", per_cu, p); grid = -1; (void)hipGetLastError(); return; }
        }
        grid = cus;
    }
    if (grid < 0) return;
    Args a{};
    for (int i = 0; i < 24; ++i) a.in[i] = (const float*)d_in[i];
    a.out = (float*)d_out; a.ws = (unsigned char*)d_ws;
#if MK_ONE_LAUNCH
    if (hipMemsetAsync((char*)d_ws + WS_CTL, 0, CTL_ZERO_BYTES, stream) != hipSuccess) { fprintf(stderr, "kernel_launch: memset failed\n"); return; }
#endif
    for (int p = 0; p < N_KERNELS; ++p) hipLaunchKernelGGL(tab[p], dim3(grid), dim3(NTHREADS), LDS_BYTES, stream, a);
}
```
